# Optimizing an MI355X kernel written in HIP

```python
import jax
import jax.numpy as jnp
from jax import lax
import numpy as np

D_MODEL = 2048
BATCH = 2
SEQ = 4096
DEPTH = 4

N_A_LAYERS = DEPTH // 2
RET_HEADS = 8
RET_DK = D_MODEL // RET_HEADS
RET_DV = 2 * D_MODEL // RET_HEADS
RET_CHUNK = 128
RET_THETA_BASE = 10000.0
NSA_HEADS = 16
NSA_GROUPS = 4
NSA_HPG = NSA_HEADS // NSA_GROUPS
NSA_DV = D_MODEL // NSA_HEADS
NSA_DK = 3 * NSA_DV // 2
CMP_LEN = 32
CMP_STRIDE = 16
CMP_HID = 2 * NSA_DV
SEL_LEN = 64
SEL_TOPK = 16
WINDOW = 512
SEL_QBLOCK = 32
WIN_QBLOCK = 128
N_BRANCH = 3
ALPHA = (2.0 * DEPTH) ** 0.25
BETA = (8.0 * DEPTH) ** -0.25
NEG_INF = -1e30
FORCE_SCORE = 1e9
LN_EPS = 1e-5

kernel_name = 'hybrid_retnet_nsa_yoco_deepnorm'


def layer_norm(x, g, b):
    xf = x.astype(jnp.float32)
    mu = xf.mean(-1, keepdims=True)
    var = jnp.mean(jnp.square(xf - mu), -1, keepdims=True)
    return ((xf - mu) * lax.rsqrt(var + LN_EPS) * g + b).astype(x.dtype)


def rotate_pairs(t, positions):
    d = t.shape[-1]
    inv_freq = 1.0 / (RET_THETA_BASE ** jnp.linspace(0.0, 1.0, d // 2, dtype=jnp.float32))
    ang = positions.astype(jnp.float32)[:, :, None, None] * inv_freq
    cos, sin = jnp.cos(ang), jnp.sin(ang)
    pair = t.reshape(*t.shape[:-1], d // 2, 2)
    even, odd = pair[..., 0], pair[..., 1]
    return jnp.stack([even * cos - odd * sin, even * sin + odd * cos], axis=-1).reshape(t.shape)


def retention_mixer(x, positions, w_in, w_out):
    bsz, seq, _ = x.shape
    h, dk, dv, c = RET_HEADS, RET_DK, RET_DV, RET_CHUNK
    n_chunk = seq // c
    f32 = jnp.float32
    proj = x @ w_in
    q, k, v, z = jnp.split(proj, [h * dk, 2 * h * dk, 2 * h * dk + h * dv], axis=-1)
    q = rotate_pairs(q.reshape(bsz, seq, h, dk).astype(f32), positions)
    k = rotate_pairs(k.reshape(bsz, seq, h, dk).astype(f32), positions) * (dk ** -0.5)
    v = v.reshape(bsz, seq, h, dv).astype(f32)

    def to_chunks(t):
        return t.reshape(bsz, n_chunk, c, h, -1).transpose(1, 0, 3, 2, 4)

    log_gamma = jnp.log1p(-jnp.exp2(-5.0 - jnp.arange(h, dtype=f32)))
    idx = jnp.arange(c, dtype=f32)
    rel = idx[:, None] - idx[None, :]
    decay_intra = jnp.where(rel >= 0, jnp.exp(log_gamma[:, None, None] * jnp.maximum(rel, 0.0)), 0.0)
    decay_q = jnp.exp(log_gamma[:, None] * (idx + 1.0))[None, :, :, None]
    decay_k = jnp.exp(log_gamma[:, None] * (c - 1.0 - idx))[None, :, :, None]
    decay_chunk = jnp.exp(log_gamma * c)[None, :, None, None]

    def step(state, qkv):
        qc, kc, vc = qkv
        scores = jnp.einsum('bhcd,bhmd->bhcm', qc, kc) * decay_intra
        out = (jnp.einsum('bhcm,bhme->bhce', scores, vc)
               + jnp.einsum('bhcd,bhde->bhce', qc, state) * decay_q)
        state = state * decay_chunk + jnp.einsum('bhcd,bhce->bhde', kc * decay_k, vc)
        return state, out

    state0 = jnp.zeros((bsz, h, dk, dv), f32)
    _, o = lax.scan(step, state0, (to_chunks(q), to_chunks(k), to_chunks(v)))
    o = o.transpose(1, 0, 3, 2, 4).reshape(bsz, seq, h, dv)
    mu = o.mean(-1, keepdims=True)
    var = jnp.mean(jnp.square(o - mu), -1, keepdims=True)
    o = ((o - mu) * lax.rsqrt(var + LN_EPS)).reshape(bsz, seq, h * dv).astype(x.dtype)
    return (o * jax.nn.silu(z)) @ w_out


def nsa_shared_kv(hs, w_kv, pe_k, pe_v, w_ck1, w_ck2, w_cv1, w_cv2):
    bsz, seq, _ = hs.shape
    g, dk, dv = NSA_GROUPS, NSA_DK, NSA_DV
    kv = hs @ w_kv
    sizes = [g * dk, g * dv] * N_BRANCH
    parts = jnp.split(kv, np.cumsum(sizes)[:-1].tolist(), axis=-1)
    k_cmp, v_cmp, k_sel, v_sel, k_win, v_win = [p.reshape(bsz, seq, g, -1).transpose(0, 2, 1, 3) for p in parts]
    n_cmp = (seq - CMP_LEN) // CMP_STRIDE + 1
    tok = jnp.arange(n_cmp)[:, None] * CMP_STRIDE + jnp.arange(CMP_LEN)[None, :]

    def compress(t, pe, w1, w2):
        blocks = t[:, :, tok] + pe
        flat = blocks.reshape(bsz, g, n_cmp, -1)
        return jax.nn.silu(flat @ w1) @ w2

    kc = compress(k_cmp, pe_k, w_ck1, w_ck2)
    vc = compress(v_cmp, pe_v, w_cv1, w_cv2)
    return (kc, vc, k_sel, v_sel, k_win, v_win)


def nsa_mixer(x, shared, w_in, w_out):
    kc, vc, ks, vs, kw, vw = shared
    bsz, seq, _ = x.shape
    g, r, dk, dv, h = NSA_GROUPS, NSA_HPG, NSA_DK, NSA_DV, NSA_HEADS
    f32 = jnp.float32
    scale = dk ** -0.5
    proj = x @ w_in
    q, z_cmp, z_sel, z_win, gate = jnp.split(
        proj, [h * dk, h * dk + h * dv, h * dk + 2 * h * dv, h * dk + 3 * h * dv], axis=-1)
    q = q.reshape(bsz, seq, g, r, dk).transpose(0, 2, 3, 1, 4)
    t = jnp.arange(seq)

    n_cmp = kc.shape[2]
    blk_end = jnp.arange(n_cmp) * CMP_STRIDE + CMP_LEN - 1
    cmask = blk_end[None, :] <= t[:, None]
    s_cmp = jnp.einsum('bgrsd,bgnd->bgrsn', q, kc).astype(f32) * scale
    p_cmp = jax.nn.softmax(jnp.where(cmask, s_cmp, NEG_INF), axis=-1) * cmask.any(-1, keepdims=True).astype(f32)
    o_cmp = jnp.einsum('bgrsn,bgne->bgrse', p_cmp.astype(vc.dtype), vc)

    n_sel = seq // SEL_LEN
    a, b = SEL_LEN // CMP_STRIDE, CMP_LEN // CMP_STRIDE
    span = a + b - 2
    diff = jnp.arange(n_cmp)[:, None] - a * jnp.arange(n_sel)[None, :]
    overlap = jnp.where((diff >= 0) & (diff <= span),
                        jnp.minimum(jnp.minimum(diff, span - diff), min(a, b) - 1) + 1, 0).astype(f32)
    p_sel = jnp.einsum('bgrsn,nj->bgsj', p_cmp, overlap)
    blk = jnp.arange(n_sel)[None, :]
    cur = (t // SEL_LEN)[:, None]
    forced = (blk == 0) | (blk == cur) | (blk == cur - 1)
    score = jnp.where(forced, FORCE_SCORE, jnp.where(blk <= cur, p_sel, -1.0))
    n_top = min(SEL_TOPK, n_sel)
    _, sel_idx = lax.top_k(score, n_top)

    ks_blk = ks.reshape(bsz, g, n_sel, SEL_LEN, dk)
    vs_blk = vs.reshape(bsz, g, n_sel, SEL_LEN, dv)
    n_qb = seq // SEL_QBLOCK
    q_blocks = q.reshape(bsz, g, r, n_qb, SEL_QBLOCK, dk).transpose(3, 0, 1, 2, 4, 5)
    idx_blocks = sel_idx.reshape(bsz, g, n_qb, SEL_QBLOCK, n_top).transpose(2, 0, 1, 3, 4)
    q_starts = jnp.arange(n_qb) * SEL_QBLOCK
    bi = jnp.arange(bsz)[:, None, None, None]
    gi = jnp.arange(g)[None, :, None, None]
    tok_in_blk = jnp.arange(SEL_LEN)

    def sel_block(args):
        qb, ib, q0 = args
        kg = ks_blk[bi, gi, ib].reshape(bsz, g, SEL_QBLOCK, n_top * SEL_LEN, dk)
        vg = vs_blk[bi, gi, ib].reshape(bsz, g, SEL_QBLOCK, n_top * SEL_LEN, dv)
        kpos = (ib[..., None] * SEL_LEN + tok_in_blk).reshape(bsz, g, SEL_QBLOCK, n_top * SEL_LEN)
        qpos = q0 + jnp.arange(SEL_QBLOCK)
        mask = (kpos <= qpos[None, None, :, None])[:, :, None]
        s = jnp.einsum('bgrqd,bgqkd->bgrqk', qb, kg).astype(f32) * scale
        p = jax.nn.softmax(jnp.where(mask, s, NEG_INF), axis=-1)
        return jnp.einsum('bgrqk,bgqke->bgrqe', p.astype(vg.dtype), vg)

    o_sel = lax.map(sel_block, (q_blocks, idx_blocks, q_starts))
    o_sel = o_sel.transpose(1, 2, 3, 0, 4, 5).reshape(bsz, g, r, seq, dv)

    kw_pad = jnp.pad(kw, ((0, 0), (0, 0), (WINDOW, 0), (0, 0)))
    vw_pad = jnp.pad(vw, ((0, 0), (0, 0), (WINDOW, 0), (0, 0)))
    span_k = WIN_QBLOCK + WINDOW

    def win_block(q0):
        qb = lax.dynamic_slice_in_dim(q, q0, WIN_QBLOCK, axis=3)
        kb = lax.dynamic_slice_in_dim(kw_pad, q0, span_k, axis=2)
        vb = lax.dynamic_slice_in_dim(vw_pad, q0, span_k, axis=2)
        qpos = q0 + jnp.arange(WIN_QBLOCK)
        kpos = q0 - WINDOW + jnp.arange(span_k)
        dist = qpos[:, None] - kpos[None, :]
        mask = (dist >= 0) & (dist < WINDOW) & (kpos[None, :] >= 0)
        s = jnp.einsum('bgrqd,bgkd->bgrqk', qb, kb).astype(f32) * scale
        p = jax.nn.softmax(jnp.where(mask, s, NEG_INF), axis=-1)
        return jnp.einsum('bgrqk,bgke->bgrqe', p.astype(vb.dtype), vb)

    o_win = lax.map(win_block, jnp.arange(seq // WIN_QBLOCK) * WIN_QBLOCK)
    o_win = o_win.transpose(1, 2, 3, 0, 4, 5).reshape(bsz, g, r, seq, dv)

    def heads(o):
        return o.transpose(0, 3, 1, 2, 4).reshape(bsz, seq, h, dv).astype(x.dtype)

    def gate_path(zz):
        return jax.nn.silu(zz.reshape(bsz, seq, h, dv))

    gates = jax.nn.sigmoid(gate.reshape(bsz, seq, N_BRANCH, h))[..., None]
    mixed = (gates[:, :, 0] * heads(o_cmp) * gate_path(z_cmp)
             + gates[:, :, 1] * heads(o_sel) * gate_path(z_sel)
             + gates[:, :, 2] * heads(o_win) * gate_path(z_win))
    return mixed.reshape(bsz, seq, h * dv) @ w_out


def setup_inputs(seed: int = 0) -> dict:
    key = jax.random.key(seed)
    keys = iter(jax.random.split(key, 64))
    f32 = jnp.float32

    def dense(fan_in, fan_out, scale=1.0):
        return jax.random.normal(next(keys), (fan_in, fan_out), f32) * (scale * fan_in ** -0.5)

    def norm_pair():
        gain = 1.0 + 0.05 * jax.random.normal(next(keys), (D_MODEL,), f32)
        bias = 0.02 * jax.random.normal(next(keys), (D_MODEL,), f32)
        return gain, bias

    inputs = {}
    inputs['x'] = jax.random.normal(next(keys), (BATCH, SEQ, D_MODEL), f32)
    offset = jax.random.randint(next(keys), (BATCH, 1), 0, 1024, dtype=jnp.int32)
    inputs['positions'] = offset + jnp.arange(SEQ, dtype=jnp.int32)[None, :]
    hr = RET_HEADS
    for layer in range(N_A_LAYERS):
        inputs[f'ret_w_in_{layer}'] = jnp.concatenate([
            dense(D_MODEL, hr * RET_DK), dense(D_MODEL, hr * RET_DK),
            dense(D_MODEL, hr * RET_DV, BETA), dense(D_MODEL, hr * RET_DV)], axis=1)
        inputs[f'ret_w_out_{layer}'] = dense(hr * RET_DV, D_MODEL, BETA)
        gain, bias = norm_pair()
        inputs[f'ln_g_{layer}'] = gain
        inputs[f'ln_b_{layer}'] = bias
    cols = []
    for _ in range(N_BRANCH):
        cols += [dense(D_MODEL, NSA_GROUPS * NSA_DK), dense(D_MODEL, NSA_GROUPS * NSA_DV, BETA)]
    inputs['nsa_w_kv'] = jnp.concatenate(cols, axis=1)
    inputs['nsa_pe_k'] = 0.1 * jax.random.normal(next(keys), (CMP_LEN, NSA_DK), f32)
    inputs['nsa_pe_v'] = 0.1 * jax.random.normal(next(keys), (CMP_LEN, NSA_DV), f32)
    inputs['nsa_w_ck1'] = dense(CMP_LEN * NSA_DK, CMP_HID)
    inputs['nsa_w_ck2'] = dense(CMP_HID, NSA_DK)
    inputs['nsa_w_cv1'] = dense(CMP_LEN * NSA_DV, CMP_HID)
    inputs['nsa_w_cv2'] = dense(CMP_HID, NSA_DV)
    hn = NSA_HEADS
    for layer in range(N_A_LAYERS, DEPTH):
        inputs[f'nsa_w_in_{layer}'] = jnp.concatenate([
            dense(D_MODEL, hn * NSA_DK), dense(D_MODEL, hn * NSA_DV), dense(D_MODEL, hn * NSA_DV),
            dense(D_MODEL, hn * NSA_DV), dense(D_MODEL, N_BRANCH * hn)], axis=1)
        inputs[f'nsa_w_out_{layer}'] = dense(hn * NSA_DV, D_MODEL, BETA)
        gain, bias = norm_pair()
        inputs[f'ln_g_{layer}'] = gain
        inputs[f'ln_b_{layer}'] = bias
    return inputs


def reference(x, positions, ret_w_in_0, ret_w_out_0, ln_g_0, ln_b_0, ret_w_in_1, ret_w_out_1, ln_g_1, ln_b_1,
              nsa_w_kv, nsa_pe_k, nsa_pe_v, nsa_w_ck1, nsa_w_ck2, nsa_w_cv1, nsa_w_cv2,
              nsa_w_in_2, nsa_w_out_2, ln_g_2, ln_b_2, nsa_w_in_3, nsa_w_out_3, ln_g_3, ln_b_3):
    mixer_params = [(ret_w_in_0, ret_w_out_0), (ret_w_in_1, ret_w_out_1),
                    (nsa_w_in_2, nsa_w_out_2), (nsa_w_in_3, nsa_w_out_3)]
    norm_params = [(ln_g_0, ln_b_0), (ln_g_1, ln_b_1), (ln_g_2, ln_b_2), (ln_g_3, ln_b_3)]
    shared = None
    for layer in range(DEPTH):
        w_in, w_out = mixer_params[layer]
        if layer < N_A_LAYERS:
            y = retention_mixer(x, positions, w_in, w_out)
        else:
            if layer == N_A_LAYERS:
                shared = nsa_shared_kv(x, nsa_w_kv, nsa_pe_k, nsa_pe_v, nsa_w_ck1, nsa_w_ck2, nsa_w_cv1, nsa_w_cv2)
            y = nsa_mixer(x, shared, w_in, w_out)
        gain, bias = norm_params[layer]
        x = layer_norm(ALPHA * x + y, gain, bias)
    return x
```

```cpp
#include <hip/hip_runtime.h>
#include <hip/hip_cooperative_groups.h>
#include <cstdio>
namespace cg = cooperative_groups;

#ifndef FUSED
#define FUSED 1
#endif

#define LAS __attribute__((address_space(3)))
typedef _Float16 h16;
typedef _Float16 h16x8 __attribute__((ext_vector_type(8)));
typedef _Float16 h16x4 __attribute__((ext_vector_type(4)));
typedef float f32x4 __attribute__((ext_vector_type(4)));
typedef unsigned long long u64;
typedef unsigned u32x4 __attribute__((ext_vector_type(4)));

constexpr int NTHR = 512;
constexpr int SEQ = 4096, NTOK = 8192, DM = 2048;
constexpr int SHM_BYTES = 147456;
constexpr float ALPHA_F = 1.6817928305074290f;
constexpr float LN_EPS_F = 1e-5f;
constexpr float LOG2E = 1.4426950408889634f;
constexpr int NSA_LD = 9472;
constexpr int KV_LD = 3840;

struct Params {
  const float* x; const int* pos;
  const float* ret_w_in[2]; const float* ret_w_out[2];
  const float* ln_g[4]; const float* ln_b[4];
  const float* w_kv; const float* pe_k; const float* pe_v; const float* w_ck1; const float* w_ck2; const float* w_cv1; const float* w_cv2;
  const float* nsa_w_in[2]; const float* nsa_w_out[2];
  float* out;
  h16* wA; h16* wB; float* xres; h16* xh; float* cs; h16* ck1T; h16* cv1T; float* biask; float* biasv; float* biasp;
  h16* qh; h16* kh; h16* kdT; h16* vT; h16* zh; h16* St; h16* Pbuf; h16* Obuf;
  h16* kvh; h16* vselT; h16* vwinT; h16* kc; h16* vcT; float* part; h16* proj; u64* masks; h16* mixed; unsigned* xbar;
};

typedef const __attribute__((address_space(4))) Params* PP;
#define WAIT_V0() asm volatile("s_waitcnt vmcnt(0)" ::: "memory")
__device__ __forceinline__ int opaque_tid() { int t = threadIdx.x; asm volatile("" : "+v"(t)); return t; }

__device__ __forceinline__ int lds_byte(int r, int c) {
  int st = (r >> 4) * 2 + (c >> 5), ob = (r & 15) * 64 + (c & 31) * 2;
  return st * 1024 + (ob ^ (((ob >> 9) & 1) << 5));
}
__device__ __forceinline__ void stage_rc(int b, int& R, int& C) {
  int st = b >> 10, sb = b & 1023, swz = sb ^ (((sb >> 9) & 1) << 5);
  R = (st >> 1) * 16 + swz / 64;
  C = (st & 1) * 32 + (swz % 64) / 2;
}
__device__ __forceinline__ float lg2gamma(int h) { return log1pf(-exp2f(-5.f - (float)h)) * LOG2E; }
__device__ __forceinline__ float sigmoidf_(float v) { return 1.f / (1.f + __expf(-v)); }
__device__ __forceinline__ float siluf_(float v) { return v / (1.f + __expf(-v)); }
__device__ __forceinline__ h16x4 cvt4(f32x4 v) { h16x4 r; r[0] = (h16)v[0]; r[1] = (h16)v[1]; r[2] = (h16)v[2]; r[3] = (h16)v[3]; return r; }

struct GOp { const h16* P; const h16* Q; long ldp, ldq; int nk, kt0, ksegP; long segP; };

__device__ __forceinline__ void gemm256(LAS char* shm, const GOp g, f32x4 (&acc)[8][4], const int tid) {
  const int wid = tid >> 6, lane = tid & 63, wr = wid >> 2, wc = wid & 3, fr = lane & 15, fq = lane >> 4;
  int offP[4], offQ[4];
#pragma unroll
  for (int i = 0; i < 4; ++i) { int R, C; stage_rc(wid * 1024 + i * 8192 + lane * 16, R, C); offP[i] = R * (int)g.ldp + C; offQ[i] = R * (int)g.ldq + C; }
#define G_STAGE(buf, t) do { const int kk_ = g.kt0 + (t); const long kp_ = (long)(kk_ / g.ksegP) * g.segP + (long)(kk_ % g.ksegP) * 64; const long kq_ = (long)kk_ * 64; \
    _Pragma("unroll") for (int i = 0; i < 4; ++i) { \
      __builtin_amdgcn_global_load_lds((const unsigned*)(g.P + offP[i] + kp_), (LAS unsigned*)(shm + (buf) * 65536 + wid * 1024 + i * 8192), 16, 0, 0); \
      __builtin_amdgcn_global_load_lds((const unsigned*)(g.Q + offQ[i] + kq_), (LAS unsigned*)(shm + (buf) * 65536 + 32768 + wid * 1024 + i * 8192), 16, 0, 0); } } while (0)
  G_STAGE(0, 0); WAIT_V0(); __syncthreads();
#pragma unroll 1
  for (int t = 0; t < g.nk; ++t) {
    const int cur = t & 1;
    if (t + 1 < g.nk) G_STAGE(cur ^ 1, t + 1);
#pragma unroll
    for (int ks = 0; ks < 2; ++ks) {
      h16x8 At[8], Bf[4];
#pragma unroll
      for (int m = 0; m < 8; ++m) At[m] = *(const LAS h16x8*)(shm + cur * 65536 + lds_byte(wr * 128 + m * 16 + fr, ks * 32 + fq * 8));
#pragma unroll
      for (int n = 0; n < 4; ++n) Bf[n] = *(const LAS h16x8*)(shm + cur * 65536 + 32768 + lds_byte(wc * 64 + n * 16 + fr, ks * 32 + fq * 8));
#pragma unroll
      for (int m = 0; m < 8; ++m)
#pragma unroll
        for (int n = 0; n < 4; ++n) acc[m][n] = __builtin_amdgcn_mfma_f32_16x16x32_f16(At[m], Bf[n], acc[m][n], 0, 0, 0);
    }
    WAIT_V0(); __syncthreads();
  }
#undef G_STAGE
}
__device__ __forceinline__ void zero_acc(f32x4 (&acc)[8][4]) {
#pragma unroll
  for (int m = 0; m < 8; ++m)
#pragma unroll
    for (int n = 0; n < 4; ++n) acc[m][n] = (f32x4){0.f, 0.f, 0.f, 0.f};
}


__device__ __forceinline__ void gemm8p(LAS char* shm, const h16* __restrict__ A, const int lda, const h16* __restrict__ Bt, const int ldb, const int nt,
                                        f32x4 (&acc)[2][2][4][2], const int tid) {
  constexpr int HTB = 128 * 64 * 2;
#define SA8(b, h) (shm + ((b) * 2 + (h)) * HTB)
#define SB8(b, h) (shm + (4 + (b) * 2 + (h)) * HTB)
  const int wid = tid >> 6, lane = tid & 63, wr = wid >> 2, wc = wid & 3, fr = lane & 15, fq = lane >> 4;
  int oa[2], ob[2];
#pragma unroll
  for (int i = 0; i < 2; ++i) { int R, C; stage_rc((tid & 511) * 16 + i * 8192, R, C); oa[i] = R * lda + C; ob[i] = R * ldb + C; }
#define STAGE8A(P_, half, kt) do { const h16* g_ = A + (long)(half) * 128 * lda + (long)(kt) * 64; \
    _Pragma("unroll") for (int i_ = 0; i_ < 2; ++i_) __builtin_amdgcn_global_load_lds((const unsigned*)(g_ + oa[i_]), (LAS unsigned*)((P_) + wid * 1024 + i_ * 8192), 16, 0, 0); } while (0)
#define STAGE8B(P_, half, kt) do { const h16* g_ = Bt + (long)(half) * 128 * ldb + (long)(kt) * 64; \
    _Pragma("unroll") for (int i_ = 0; i_ < 2; ++i_) __builtin_amdgcn_global_load_lds((const unsigned*)(g_ + ob[i_]), (LAS unsigned*)((P_) + wid * 1024 + i_ * 8192), 16, 0, 0); } while (0)
#define LDA8(dst, b, h) _Pragma("unroll") for (int m = 0; m < 4; ++m) _Pragma("unroll") for (int k = 0; k < 2; ++k) \
    dst[m][k] = *(const LAS h16x8*)(SA8(b, h) + lds_byte(wr * 64 + m * 16 + fr, k * 32 + fq * 8))
#define LDB8(dst, b, h) _Pragma("unroll") for (int n = 0; n < 2; ++n) _Pragma("unroll") for (int k = 0; k < 2; ++k) \
    dst[n][k] = *(const LAS h16x8*)(SB8(b, h) + lds_byte(wc * 32 + n * 16 + fr, k * 32 + fq * 8))
#define MMA8(ai, bj, At_, Bt_) do { __builtin_amdgcn_s_setprio(1); \
    _Pragma("unroll") for (int m = 0; m < 4; ++m) _Pragma("unroll") for (int n = 0; n < 2; ++n) _Pragma("unroll") for (int k = 0; k < 2; ++k) \
      acc[ai][bj][m][n] = __builtin_amdgcn_mfma_f32_16x16x32_f16(At_[m][k], Bt_[n][k], acc[ai][bj][m][n], 0, 0, 0); \
    __builtin_amdgcn_s_setprio(0); } while (0)
#define WAIT_V8(n) asm volatile("s_waitcnt vmcnt(" #n ")" ::: "memory")
#define WAIT_L8(n) asm volatile("s_waitcnt lgkmcnt(" #n ")" ::: "memory")
#define BAR8 __builtin_amdgcn_s_barrier()
#define SCHED8 __builtin_amdgcn_sched_barrier(0)
  h16x8 At[4][2], B0[2][2], B1[2][2];
  WAIT_V8(0);
  STAGE8B(SB8(0, 0), 0, 0); STAGE8A(SA8(0, 0), 0, 0);
  STAGE8B(SB8(0, 1), 1, 0); STAGE8A(SA8(0, 1), 1, 0);
  if (wr == 1) BAR8;
  WAIT_V8(4); BAR8;
  STAGE8B(SB8(1, 0), 0, 1); STAGE8A(SA8(1, 0), 0, 1); STAGE8B(SB8(1, 1), 1, 1);
  WAIT_V8(6); BAR8;
#pragma unroll 1
  for (int t = 0; t < nt - 2; t += 2) {
    LDB8(B0, 0, 0); SCHED8; LDA8(At, 0, 0); STAGE8A(SA8(1, 1), 1, t + 1);
    WAIT_L8(8); BAR8; WAIT_L8(0); MMA8(0, 0, At, B0); BAR8; SCHED8;
    LDB8(B1, 0, 1); STAGE8B(SB8(0, 0), 0, t + 2);
    BAR8; WAIT_L8(0); MMA8(0, 1, At, B1); BAR8;
    LDA8(At, 0, 1); STAGE8A(SA8(0, 0), 0, t + 2);
    BAR8; WAIT_L8(0); MMA8(1, 0, At, B0); BAR8; SCHED8;
    STAGE8B(SB8(0, 1), 1, t + 2);
    WAIT_V8(6); BAR8; MMA8(1, 1, At, B1); BAR8;
    LDB8(B0, 1, 0); SCHED8; LDA8(At, 1, 0); STAGE8A(SA8(0, 1), 1, t + 2);
    WAIT_L8(8); BAR8; WAIT_L8(0); MMA8(0, 0, At, B0); BAR8; SCHED8;
    LDB8(B1, 1, 1); STAGE8B(SB8(1, 0), 0, t + 3);
    BAR8; WAIT_L8(0); MMA8(0, 1, At, B1); BAR8;
    LDA8(At, 1, 1); STAGE8A(SA8(1, 0), 0, t + 3);
    BAR8; WAIT_L8(0); MMA8(1, 0, At, B0); BAR8; SCHED8;
    STAGE8B(SB8(1, 1), 1, t + 3);
    WAIT_V8(6); BAR8; MMA8(1, 1, At, B1); BAR8;
  }
  { LDB8(B0, 0, 0); LDA8(At, 0, 0); STAGE8A(SA8(1, 1), 1, nt - 1);
    BAR8; WAIT_L8(0); MMA8(0, 0, At, B0); BAR8;
    LDB8(B1, 0, 1); BAR8; WAIT_L8(0); MMA8(0, 1, At, B1); BAR8;
    LDA8(At, 0, 1); WAIT_V8(4); BAR8; WAIT_L8(0); MMA8(1, 0, At, B0); MMA8(1, 1, At, B1); BAR8; }
  { LDB8(B0, 1, 0); LDA8(At, 1, 0); WAIT_V8(2); BAR8; WAIT_L8(0); MMA8(0, 0, At, B0); BAR8;
    LDB8(B1, 1, 1); WAIT_V8(0); BAR8; WAIT_L8(0); MMA8(0, 1, At, B1); BAR8;
    LDA8(At, 1, 1); BAR8; WAIT_L8(0); MMA8(1, 0, At, B0); MMA8(1, 1, At, B1); BAR8; }
  if (wr == 0) BAR8;
#undef SA8
#undef SB8
#undef STAGE8A
#undef STAGE8B
#undef LDA8
#undef LDB8
#undef MMA8
}

__device__ __forceinline__ void conv_job(LAS char* shm, const float* __restrict__ src, int K, int N, int Npad, h16* __restrict__ dst, int& tilebase, int bid, int nb) {
  LAS h16* tile = (LAS h16*)shm;
  const int tid = threadIdx.x;
  const int nkt = K / 64, nnt = Npad / 64, ntiles = nkt * nnt;
  int start = (int)((((long)bid - tilebase) % nb + nb) % nb);
  for (int t = start; t < ntiles; t += nb) {
    const int k0 = (t % nkt) * 64, n0 = (t / nkt) * 64;
#pragma unroll
    for (int i = 0; i < 2; ++i) {
      const int e = tid * 4 + i * 2048, k = e >> 6, n = e & 63;
      float4 v = make_float4(0.f, 0.f, 0.f, 0.f);
      if (n0 + n < N) v = *(const float4*)(src + (long)(k0 + k) * N + n0 + n);
      tile[(n + 0) * 72 + k] = (h16)v.x; tile[(n + 1) * 72 + k] = (h16)v.y; tile[(n + 2) * 72 + k] = (h16)v.z; tile[(n + 3) * 72 + k] = (h16)v.w;
    }
    __syncthreads();
    { const int nn = tid >> 3, k8 = (tid & 7) * 8;
      *(u32x4*)(dst + (long)(n0 + nn) * K + k0 + k8) = *(const LAS u32x4*)(tile + nn * 72 + k8); }
    __syncthreads();
  }
  tilebase += ntiles;
}

__device__ __forceinline__ void phase_prep(PP p, LAS char* shm, int bid, int nb) {
  const int tid = threadIdx.x;
  int tb = 0;
  conv_job(shm, p->ret_w_in[0], 2048, 12288, 12288, p->wA, tb, bid, nb);
  conv_job(shm, p->ret_w_out[0], 4096, 2048, 2048, p->wB, tb, bid, nb);
  conv_job(shm, p->w_ck1, 6144, 256, 256, p->ck1T, tb, bid, nb);
  conv_job(shm, p->w_cv1, 4096, 256, 256, p->cv1T, tb, bid, nb);
  for (long i = ((long)bid * NTHR + tid) * 8; i < (long)NTOK * DM; i += (long)nb * NTHR * 8) {
    float4 a = *(const float4*)(p->x + i), b = *(const float4*)(p->x + i + 4);
    h16x8 o; o[0] = (h16)a.x; o[1] = (h16)a.y; o[2] = (h16)a.z; o[3] = (h16)a.w; o[4] = (h16)b.x; o[5] = (h16)b.y; o[6] = (h16)b.z; o[7] = (h16)b.w;
    *(h16x8*)(p->xh + i) = o;
  }
  for (int i = bid * NTHR + tid; i < NTOK * 128; i += nb * NTHR) {
    const int tok = i >> 7, f = i & 127;
    const double invf = exp2(-((double)f / 127.0) * 13.287712379549449);
    const float invf32 = (float)invf;
    const float ang = (float)p->pos[tok] * invf32;
    double a = (double)ang;
    const double k = rint(a * 0.63661977236758134308);
    const double r = (a - k * 1.5707963267948966192) - k * 6.123233995736766e-17;
    const double r2 = r * r;
    double sn = r * (1.0 + r2 * (-1.0 / 6 + r2 * (1.0 / 120 + r2 * (-1.0 / 5040 + r2 * (1.0 / 362880 + r2 * (-1.0 / 39916800 + r2 * (1.0 / 6227020800.0)))))));
    double cn = 1.0 + r2 * (-0.5 + r2 * (1.0 / 24 + r2 * (-1.0 / 720 + r2 * (1.0 / 40320 + r2 * (-1.0 / 3628800 + r2 * (1.0 / 479001600.0 + r2 * (-1.0 / 87178291200.0)))))));
    const int q = ((int)k) & 3;
    double c, s;
    if (q == 0) { c = cn; s = sn; } else if (q == 1) { c = -sn; s = cn; } else if (q == 2) { c = -cn; s = -sn; } else { c = sn; s = -cn; }
    p->cs[(long)i * 2] = (float)c; p->cs[(long)i * 2 + 1] = (float)s;
  }
  if (bid < 64) {
    const bool isk = (bid < 32); const int part = bid & 31;
    const float* pe = isk ? p->pe_k : p->pe_v; const float* w1 = isk ? p->w_ck1 : p->w_cv1; const int rng = isk ? 192 : 128;
    LAS float* red = (LAS float*)(shm + 16384);
    const int j = tid & 255, half = tid >> 8;
    float s = 0.f;
    const int i0 = part * rng + half * (rng / 2);
    for (int i = i0; i < i0 + rng / 2; ++i) s += pe[i] * w1[(long)i * 256 + j];
    red[tid] = s;
    __syncthreads();
    if (tid < 256) p->biasp[(bid) * 256 + tid] = red[tid] + red[tid + 256];
    __syncthreads();
  }
}

__device__ __forceinline__ void st_pair16(h16* p0, h16* p1, h16x4 v0, h16x4 v1, int fq) {
  typedef unsigned u32x2_t __attribute__((ext_vector_type(2)));
  const u32x2_t a = __builtin_bit_cast(u32x2_t, v0), b = __builtin_bit_cast(u32x2_t, v1);
  auto lo = __builtin_amdgcn_permlane16_swap(a[0], b[0], false, false);
  auto hi = __builtin_amdgcn_permlane16_swap(a[1], b[1], false, false);
  u32x4 o; o[0] = lo[0]; o[1] = hi[0]; o[2] = lo[1]; o[3] = hi[1];
  h16* dst = (fq & 1) ? (p1 - 4) : p0;
  *(u32x4*)dst = o;
}
template <int WHICH, bool tr>
__device__ __forceinline__ void proj_epi(PP p, int layer, const f32x4 (&acc)[2][2][4][2], const int tn, const int tm) {
  const int K = (WHICH == 1 && layer < 2) ? 4096 : 2048;
  const h16* Wt = (WHICH == 1) ? p->wB : (WHICH == 2) ? (p->wA + (long)3840 * 2048) : p->wA;
  const h16* A = (WHICH == 1) ? (layer < 2 ? p->Obuf : p->mixed) : p->xh;
  const long lda = K;
  {
    const int tid = opaque_tid(), wid = tid >> 6, lane = tid & 63, wr = wid >> 2, wc = wid & 3, fr = lane & 15, fq = lane >> 4;
    const int b = tm >> 4;
    if (tr) {
      h16* outT; long nf; int col0;
      if (WHICH == 0) { outT = p->vT; nf = 4096; col0 = (tn - 16) * 256; }
      else { outT = (tn < 10) ? p->vselT : p->vwinT; nf = 512; col0 = (tn < 10) ? (tn - 8) * 256 : (tn - 13) * 256; }
#pragma unroll
      for (int m = 0; m < 8; ++m)
#pragma unroll
        for (int n2 = 0; n2 < 2; ++n2) {
          const int feat0 = col0 + n2 * 128 + wc * 32 + fr;
          const int tl = (tm & 15) * 256 + (m >> 2) * 128 + wr * 64 + (m & 3) * 16 + fq * 4;
          h16* p0 = outT + ((long)b * nf + feat0) * SEQ + tl;
          st_pair16(p0, p0 + (long)16 * SEQ, cvt4(acc[m >> 2][n2][m & 3][0]), cvt4(acc[m >> 2][n2][m & 3][1]), fq); __builtin_amdgcn_sched_barrier(0);
        }
    } else {
      if (WHICH == 1) {
        const float* xin = (layer == 0) ? p->x : p->xres;
#pragma unroll
        for (int m = 0; m < 8; ++m)
#pragma unroll
          for (int n = 0; n < 4; ++n) {
            const long tok = tm * 256 + (n >> 1) * 128 + wc * 32 + (n & 1) * 16 + fr;
            const long o = tok * DM + tn * 256 + (m >> 2) * 128 + wr * 64 + (m & 3) * 16 + fq * 4;
            float4 xv = *(const float4*)(xin + o);
            float4 r; r.x = ALPHA_F * xv.x + acc[m >> 2][n >> 1][m & 3][n & 1][0]; r.y = ALPHA_F * xv.y + acc[m >> 2][n >> 1][m & 3][n & 1][1]; r.z = ALPHA_F * xv.z + acc[m >> 2][n >> 1][m & 3][n & 1][2]; r.w = ALPHA_F * xv.w + acc[m >> 2][n >> 1][m & 3][n & 1][3];
            *(float4*)(p->xres + o) = r; __builtin_amdgcn_sched_barrier(0);
          }
      } else if (WHICH == 0 && tn < 16) {
        const bool isk = tn >= 8; const int h = tn & 7;
        const float lg = lg2gamma(h);
        h16* outn = isk ? p->kh : p->qh;
        const float sc = isk ? 0.0625f : 1.0f;
#pragma unroll
        for (int m = 0; m < 8; ++m)
#pragma unroll
          for (int n2 = 0; n2 < 2; ++n2) {
            const int f0 = (m >> 2) * 128 + wr * 64 + (m & 3) * 16 + fq * 4;
            f32x4 rr[2];
#pragma unroll
            for (int q = 0; q < 2; ++q) {
              const int idx = n2 * 128 + wc * 32 + q * 16 + fr;
              const long tok = tm * 256 + idx;
              const float4 c = *(const float4*)(p->cs + tok * 256 + f0);
              const f32x4 a = acc[m >> 2][n2][m & 3][q];
              f32x4 r;
              r[0] = (a[0] * c.x - a[1] * c.y) * sc; r[1] = (a[0] * c.y + a[1] * c.x) * sc;
              r[2] = (a[2] * c.z - a[3] * c.w) * sc; r[3] = (a[2] * c.w + a[3] * c.z) * sc;
              rr[q] = r;
              if (isk) {
                const float dk = exp2f(lg * (float)(255 - idx));
                const long tl = (tm & 15) * 256 + idx;
                h16* kd = p->kdT + ((long)b * 2048 + h * 256 + f0) * SEQ + tl;
                kd[0] = (h16)(r[0] * dk); kd[SEQ] = (h16)(r[1] * dk); kd[2 * SEQ] = (h16)(r[2] * dk); kd[3 * SEQ] = (h16)(r[3] * dk);
              }
            }
            h16* p0 = outn + ((long)tm * 256 + n2 * 128 + wc * 32 + fr) * 2048 + h * 256 + f0;
            st_pair16(p0, p0 + 16 * 2048, cvt4(rr[0]), cvt4(rr[1]), fq);
          }
      } else {
        h16* outn; long ldo; int col0; float sc = 1.f;
        if (WHICH == 0) { outn = p->zh; ldo = 4096; col0 = (tn - 32) * 256; }
        else if (WHICH == 2) { outn = p->proj; ldo = NSA_LD; col0 = tn * 256; if (tn < 12) sc = 0.07216878364870322f * LOG2E; }
        else { outn = p->kvh; ldo = KV_LD; col0 = tn * 256; }
#pragma unroll
        for (int m = 0; m < 8; ++m)
#pragma unroll
          for (int n2 = 0; n2 < 2; ++n2) {
            const long tok0 = tm * 256 + n2 * 128 + wc * 32 + fr;
            const int f0 = col0 + (m >> 2) * 128 + wr * 64 + (m & 3) * 16 + fq * 4;
            h16* p0 = outn + tok0 * ldo + f0;
            st_pair16(p0, p0 + 16 * ldo, cvt4(acc[m >> 2][n2][m & 3][0] * sc), cvt4(acc[m >> 2][n2][m & 3][1] * sc), fq); __builtin_amdgcn_sched_barrier(0);
          }
      }
    }
  }
}

template <int WHICH>
__device__ __forceinline__ void proj_unit(PP p, int layer, int i, int& tn, int& tm, bool& tr, const h16*& Pp, const h16*& Qp) {
  const int K = (WHICH == 1 && layer < 2) ? 4096 : 2048;
  const h16* Wt = (WHICH == 1) ? p->wB : (WHICH == 2) ? (p->wA + (long)3840 * 2048) : p->wA;
  const h16* A = (WHICH == 1) ? (layer < 2 ? p->Obuf : p->mixed) : p->xh;
  tm = i % 32;
  if (WHICH == 0) { tn = i / 32; tr = (tn >= 16 && tn < 32); }
  else if (WHICH == 3) { if (i < 352) { const int j = i / 32; tn = j < 8 ? j : j + 2; tr = false; } else { const int j = (i - 352) / 32; tn = j < 2 ? 8 + j : 11 + j; tr = true; } }
  else { tn = i / 32; tr = false; }
  const h16* wt = Wt + (long)tn * 256 * K; const h16* at = A + (long)tm * 256 * K;
  Pp = tr ? at : wt; Qp = tr ? wt : at;
}
template <int WHICH>
__device__ __forceinline__ void phase_proj(PP p, int layer, LAS char* shm, int bid, int nb) {
  constexpr int NU = ((WHICH == 0) ? 48 : (WHICH == 1) ? 8 : (WHICH == 2) ? 37 : 15) * 32;
  const int K = (WHICH == 1 && layer < 2) ? 4096 : 2048;
  const int nt = K / 64;
  if (bid >= NU) return;
  constexpr int HTB = 128 * 64 * 2;
#define SA8(b, h) (shm + ((b) * 2 + (h)) * HTB)
#define SB8(b, h) (shm + (4 + (b) * 2 + (h)) * HTB)
  const int tid = opaque_tid();
  const int wid = tid >> 6, lane = tid & 63, wr = wid >> 2, wc = wid & 3, fr = lane & 15, fq = lane >> 4;
  int oo[2];
#pragma unroll
  for (int i = 0; i < 2; ++i) { int R, C; stage_rc(tid * 16 + i * 8192, R, C); oo[i] = R * K + C; }
  const h16 *cP, *cQ, *nP, *nQ; int tn, tm, ntn, ntm; bool tr, ntr;
  proj_unit<WHICH>(p, layer, bid, tn, tm, tr, cP, cQ);
#define STG(P_, base_c, base_n, half, kt) do { const h16* g_ = (((kt) < nt) ? (base_c) + (long)(kt) * 64 : (base_n) + (long)((kt) - nt) * 64) + (long)(half) * 128 * K; \
    _Pragma("unroll") for (int i_ = 0; i_ < 2; ++i_) __builtin_amdgcn_global_load_lds((const unsigned*)(g_ + oo[i_]), (LAS unsigned*)((P_) + wid * 1024 + i_ * 8192), 16, 0, 0); } while (0)
#define STAGE8A(P_, half, kt) STG(P_, cP, nP, half, kt)
#define STAGE8B(P_, half, kt) STG(P_, cQ, nQ, half, kt)
#define LDA8(dst, b, h) _Pragma("unroll") for (int m = 0; m < 4; ++m) _Pragma("unroll") for (int k = 0; k < 2; ++k) \
    dst[m][k] = *(const LAS h16x8*)(SA8(b, h) + lds_byte(wr * 64 + m * 16 + fr, k * 32 + fq * 8))
#define LDB8(dst, b, h) _Pragma("unroll") for (int n = 0; n < 2; ++n) _Pragma("unroll") for (int k = 0; k < 2; ++k) \
    dst[n][k] = *(const LAS h16x8*)(SB8(b, h) + lds_byte(wc * 32 + n * 16 + fr, k * 32 + fq * 8))
#define MMA8(ai, bj, At_, Bt_) do { __builtin_amdgcn_s_setprio(1); \
    _Pragma("unroll") for (int m = 0; m < 4; ++m) _Pragma("unroll") for (int n = 0; n < 2; ++n) _Pragma("unroll") for (int k = 0; k < 2; ++k) \
      acc[ai][bj][m][n] = __builtin_amdgcn_mfma_f32_16x16x32_f16(At_[m][k], Bt_[n][k], acc[ai][bj][m][n], 0, 0, 0); \
    __builtin_amdgcn_s_setprio(0); } while (0)
#define ZACC() do { _Pragma("unroll") for (int a_ = 0; a_ < 2; ++a_) _Pragma("unroll") for (int b_ = 0; b_ < 2; ++b_) _Pragma("unroll") for (int m_ = 0; m_ < 4; ++m_) { \
    acc[a_][b_][m_][0] = (f32x4){0.f, 0.f, 0.f, 0.f}; acc[a_][b_][m_][1] = (f32x4){0.f, 0.f, 0.f, 0.f}; } } while (0)
  f32x4 acc[2][2][4][2];
  h16x8 At[4][2], B0[2][2], B1[2][2];
  ZACC();
  nP = cP; nQ = cQ;
  WAIT_V8(0);
  STAGE8B(SB8(0, 0), 0, 0); STAGE8A(SA8(0, 0), 0, 0);
  STAGE8B(SB8(0, 1), 1, 0); STAGE8A(SA8(0, 1), 1, 0);
  if (wr == 1) BAR8;
  WAIT_V8(4); BAR8;
  STAGE8B(SB8(1, 0), 0, 1); STAGE8A(SA8(1, 0), 0, 1); STAGE8B(SB8(1, 1), 1, 1);
  WAIT_V8(6); BAR8;
#pragma unroll 1
  for (int u = bid; u < NU; u += nb) {
    if (u + nb < NU) proj_unit<WHICH>(p, layer, u + nb, ntn, ntm, ntr, nP, nQ);
    else { nP = cP; nQ = cQ; ntn = tn; ntm = tm; ntr = tr; }
#pragma unroll 1
    for (int t = 0; t < nt; t += 2) {
      LDB8(B0, 0, 0); SCHED8; LDA8(At, 0, 0); STAGE8A(SA8(1, 1), 1, t + 1);
      WAIT_L8(8); BAR8; WAIT_L8(0); MMA8(0, 0, At, B0); BAR8; SCHED8;
      LDB8(B1, 0, 1); STAGE8B(SB8(0, 0), 0, t + 2);
      BAR8; WAIT_L8(0); MMA8(0, 1, At, B1); BAR8;
      LDA8(At, 0, 1); STAGE8A(SA8(0, 0), 0, t + 2);
      BAR8; WAIT_L8(0); MMA8(1, 0, At, B0); BAR8; SCHED8;
      STAGE8B(SB8(0, 1), 1, t + 2);
      WAIT_V8(6); BAR8; MMA8(1, 1, At, B1); BAR8;
      LDB8(B0, 1, 0); SCHED8; LDA8(At, 1, 0); STAGE8A(SA8(0, 1), 1, t + 2);
      WAIT_L8(8); BAR8; WAIT_L8(0); MMA8(0, 0, At, B0); BAR8; SCHED8;
      LDB8(B1, 1, 1); STAGE8B(SB8(1, 0), 0, t + 3);
      BAR8; WAIT_L8(0); MMA8(0, 1, At, B1); BAR8;
      LDA8(At, 1, 1); STAGE8A(SA8(1, 0), 0, t + 3);
      BAR8; WAIT_L8(0); MMA8(1, 0, At, B0); BAR8; SCHED8;
      STAGE8B(SB8(1, 1), 1, t + 3);
      WAIT_V8(6); BAR8; MMA8(1, 1, At, B1); BAR8;
    }
    if (tr) proj_epi<WHICH, true>(p, layer, acc, tn, tm); else proj_epi<WHICH, false>(p, layer, acc, tn, tm);
    ZACC();
    cP = nP; cQ = nQ; tn = ntn; tm = ntm; tr = ntr;
  }
  WAIT_V8(0);
  if (wr == 0) BAR8;
  __syncthreads();
#undef SA8
#undef SB8
#undef STG
#undef STAGE8A
#undef STAGE8B
#undef LDA8
#undef LDB8
#undef MMA8
#undef ZACC
}

__device__ __forceinline__ void phase_retB(PP p, LAS char* shm, int bid, int nb) {
  for (int t = bid; t < 768; t += nb) {
    const int tid = opaque_tid(), wid = tid >> 6, lane = tid & 63, wr = wid >> 2, wc = wid & 3, fr = lane & 15, fq = lane >> 4;
    f32x4 acc[8][4];
    zero_acc(acc);
    GOp g; g.nk = 4; g.kt0 = 0; g.ksegP = 1 << 28; g.segP = 0;
    if (t < 512) {
      const int et = t & 1, c = (t >> 1) & 15, bh = t >> 5, b = bh >> 3, h = bh & 7;
      g.P = p->kdT + ((long)b * 2048 + h * 256) * SEQ + c * 256; g.ldp = SEQ;
      g.Q = p->vT + ((long)b * 4096 + h * 512 + et * 256) * SEQ + c * 256; g.ldq = SEQ;
      gemm256(shm, g, acc, tid);
      h16* st = p->St + ((long)(bh * 16 + c) * 512 + et * 256) * 256;
#pragma unroll
      for (int m = 0; m < 8; ++m)
#pragma unroll
        for (int n = 0; n < 4; ++n) {
          const int e = wc * 64 + n * 16 + fr, d0 = wr * 128 + m * 16 + fq * 4;
          *(h16x4*)(st + (long)e * 256 + d0) = cvt4(acc[m][n]); __builtin_amdgcn_sched_barrier(0);
        }
    } else {
      const int u = t - 512, c = u & 15, bh = u >> 4, b = bh >> 3, h = bh & 7;
      const float lg = lg2gamma(h);
      g.P = p->kh + ((long)b * SEQ + c * 256) * 2048 + h * 256; g.ldp = 2048;
      g.Q = p->qh + ((long)b * SEQ + c * 256) * 2048 + h * 256; g.ldq = 2048;
      gemm256(shm, g, acc, tid);
      h16* pb = p->Pbuf + ((long)bh * SEQ + c * 256) * 256;
#pragma unroll
      for (int m = 0; m < 8; ++m)
#pragma unroll
        for (int n = 0; n < 4; ++n) {
          const int qi = wc * 64 + n * 16 + fr, k0 = wr * 128 + m * 16 + fq * 4;
          f32x4 r;
#pragma unroll
          for (int j = 0; j < 4; ++j) { const int rel = qi - (k0 + j); r[j] = rel >= 0 ? acc[m][n][j] * exp2f(lg * (float)rel) : 0.f; }
          *(h16x4*)(pb + (long)qi * 256 + k0) = cvt4(r); __builtin_amdgcn_sched_barrier(0);
        }
    }
  }
}

__device__ __forceinline__ void phase_retC(PP p, int bid, int nb) {
  const int tid = threadIdx.x;
  for (int it = bid * NTHR + tid; it < 16 * 16384; it += nb * NTHR) {
    const int bh = it >> 14, idx = (it & 16383) * 8, h = bh & 7;
    const float dc = exp2f(lg2gamma(h) * 256.f);
    h16* base = p->St + (long)bh * 16 * 131072 + idx;
    h16x8 u[16];
#pragma unroll
    for (int c = 0; c < 16; ++c) u[c] = *(const h16x8*)(base + (long)c * 131072);
    float s[8];
#pragma unroll
    for (int j = 0; j < 8; ++j) s[j] = 0.f;
#pragma unroll
    for (int c = 0; c < 16; ++c) {
      h16x8 o;
#pragma unroll
      for (int j = 0; j < 8; ++j) { o[j] = (h16)s[j]; s[j] = s[j] * dc + (float)u[c][j]; }
      *(h16x8*)(base + (long)c * 131072) = o;
    }
  }
}

__device__ __forceinline__ float wave_sum(float v);
__device__ __forceinline__ void phase_retD(PP p, LAS char* shm, int bid, int nb) {
  for (int u = bid; u < 256; u += nb) {
    const int c = u & 15, bh = u >> 4, b = bh >> 3, h = bh & 7;
    const float lg = lg2gamma(h);
    for (int et = 0; et < 2; ++et) {
      const int tid = opaque_tid(), wid = tid >> 6, lane = tid & 63, wr = wid >> 2, wc = wid & 3, fr = lane & 15, fq = lane >> 4;
      f32x4 acc[8][4];
      zero_acc(acc);
      GOp g; g.nk = 4; g.kt0 = 0; g.ksegP = 1 << 28; g.segP = 0;
      g.P = p->St + ((long)(bh * 16 + c) * 512 + et * 256) * 256; g.ldp = 256;
      g.Q = p->qh + ((long)b * SEQ + c * 256) * 2048 + h * 256; g.ldq = 2048;
      gemm256(shm, g, acc, tid);
#pragma unroll
      for (int n = 0; n < 4; ++n) {
        const float dq = exp2f(lg * (float)(wc * 64 + n * 16 + fr + 1));
#pragma unroll
        for (int m = 0; m < 8; ++m) acc[m][n] = acc[m][n] * dq;
      }
      g.P = p->vT + ((long)b * 4096 + h * 512 + et * 256) * SEQ + c * 256; g.ldp = SEQ;
      g.Q = p->Pbuf + ((long)bh * SEQ + c * 256) * 256; g.ldq = 256;
      gemm256(shm, g, acc, tid);
#pragma unroll
      for (int m = 0; m < 8; ++m)
#pragma unroll
        for (int n = 0; n < 4; ++n) {
          const long tok = (long)b * SEQ + c * 256 + wc * 64 + n * 16 + fr;
          const int e0 = h * 512 + et * 256 + wr * 128 + m * 16 + fq * 4;
          *(h16x4*)(p->Obuf + tok * 4096 + e0) = cvt4(acc[m][n]); __builtin_amdgcn_sched_barrier(0);
        }
    }
    asm volatile("s_waitcnt vmcnt(0)" ::: "memory");
    __syncthreads();
    {
      const int tid = opaque_tid(), wid = tid >> 6, lane = tid & 63;
      for (int r = wid; r < 256; r += 8) {
        const long off = ((long)b * SEQ + c * 256 + r) * 4096 + h * 512 + lane * 8;
        h16x8 ov = *(const h16x8*)(p->Obuf + off), zv = *(const h16x8*)(p->zh + off);
        float o[8]; float s = 0.f;
#pragma unroll
        for (int j = 0; j < 8; ++j) { o[j] = (float)ov[j]; s += o[j]; }
        const float mu = wave_sum(s) * (1.f / 512.f);
        float q = 0.f;
#pragma unroll
        for (int j = 0; j < 8; ++j) { const float d = o[j] - mu; q += d * d; }
        const float rstd = rsqrtf(wave_sum(q) * (1.f / 512.f) + LN_EPS_F);
        h16x8 rr;
#pragma unroll
        for (int j = 0; j < 8; ++j) rr[j] = (h16)((o[j] - mu) * rstd * siluf_((float)zv[j]));
        *(h16x8*)(p->Obuf + off) = rr;
      }
    }
    __syncthreads();
  }
}

__device__ __forceinline__ float wave_sum(float v) {
#pragma unroll
  for (int o = 32; o >= 1; o >>= 1) v += __shfl_xor(v, o);
  return v;
}

__device__ __forceinline__ void phase_retE(PP p, int bid, int nb) {
  const int tid = threadIdx.x, wid = tid >> 6, lane = tid & 63;
  for (int row = bid * 8 + wid; row < NTOK * 8; row += nb * 8) {
    const long off = (long)row * 512 + lane * 8;
    h16x8 ov = *(const h16x8*)(p->Obuf + off), zv = *(const h16x8*)(p->zh + off);
    float o[8]; float s = 0.f;
#pragma unroll
    for (int j = 0; j < 8; ++j) { o[j] = (float)ov[j]; s += o[j]; }
    const float mu = wave_sum(s) * (1.f / 512.f);
    float q = 0.f;
#pragma unroll
    for (int j = 0; j < 8; ++j) { const float d = o[j] - mu; q += d * d; }
    const float rstd = rsqrtf(wave_sum(q) * (1.f / 512.f) + LN_EPS_F);
    h16x8 r;
#pragma unroll
    for (int j = 0; j < 8; ++j) r[j] = (h16)((o[j] - mu) * rstd * siluf_((float)zv[j]));
    *(h16x8*)(p->Obuf + off) = r;
  }
}

__device__ __forceinline__ void phase_ln(PP p, int layer, LAS char* shm, int bid, int nb) {
  const int tid = threadIdx.x, wid = tid >> 6, lane = tid & 63;
  const float* gw = p->ln_g[layer]; const float* bw = p->ln_b[layer];
  float* dst = (layer == 3) ? p->out : p->xres;
  for (int row = bid * 8 + wid; row < NTOK; row += nb * 8) {
    const float* src = p->xres + (long)row * DM;
    float4 v[8]; float s = 0.f;
#pragma unroll
    for (int i = 0; i < 8; ++i) { v[i] = *(const float4*)(src + i * 256 + lane * 4); s += v[i].x + v[i].y + v[i].z + v[i].w; }
    const float mu = wave_sum(s) * (1.f / 2048.f);
    float q = 0.f;
#pragma unroll
    for (int i = 0; i < 8; ++i) { float a = v[i].x - mu, b = v[i].y - mu, c = v[i].z - mu, d = v[i].w - mu; q += a * a + b * b + c * c + d * d; }
    const float rstd = rsqrtf(wave_sum(q) * (1.f / 2048.f) + LN_EPS_F);
#pragma unroll
    for (int i = 0; i < 8; ++i) {
      const int col = i * 256 + lane * 4;
      const float4 gg = *(const float4*)(gw + col), bb = *(const float4*)(bw + col);
      float4 r; r.x = (v[i].x - mu) * rstd * gg.x + bb.x; r.y = (v[i].y - mu) * rstd * gg.y + bb.y; r.z = (v[i].z - mu) * rstd * gg.z + bb.z; r.w = (v[i].w - mu) * rstd * gg.w + bb.w;
      *(float4*)(dst + (long)row * DM + col) = r;
      h16x4 hv; hv[0] = (h16)r.x; hv[1] = (h16)r.y; hv[2] = (h16)r.z; hv[3] = (h16)r.w;
      *(h16x4*)(p->xh + (long)row * DM + col) = hv;
    }
  }
  __syncthreads();
  int tb = 0;
  if (layer == 0) {
    conv_job(shm, p->ret_w_in[1], 2048, 12288, 12288, p->wA, tb, bid, nb);
    conv_job(shm, p->ret_w_out[1], 4096, 2048, 2048, p->wB, tb, bid, nb);
  } else if (layer == 1) {
    conv_job(shm, p->w_kv, 2048, 3840, 3840, p->wA, tb, bid, nb);
    conv_job(shm, p->nsa_w_in[0], 2048, 9264, 9472, p->wA + (long)3840 * 2048, tb, bid, nb);
    conv_job(shm, p->nsa_w_out[0], 2048, 2048, 2048, p->wB, tb, bid, nb);
  } else if (layer == 2) {
    conv_job(shm, p->nsa_w_in[1], 2048, 9264, 9472, p->wA + (long)3840 * 2048, tb, bid, nb);
    conv_job(shm, p->nsa_w_out[1], 2048, 2048, 2048, p->wB, tb, bid, nb);
  }
}

__device__ __forceinline__ void phase_cmp1(PP p, LAS char* shm, int bid, int nb) {
  for (int t = bid; t < 256; t += nb) {
    const int tid = opaque_tid(), wid = tid >> 6, lane = tid & 63, wr = wid >> 2, wc = wid & 3, fr = lane & 15, fq = lane >> 4;
    const int kv = t >> 7, bg = (t >> 4) & 7, sp = t & 15, b = bg >> 2, gq = bg & 3;
    f32x4 acc[8][4];
    zero_acc(acc);
    GOp g;
    g.ldp = 16 * KV_LD; g.segP = KV_LD;
    if (kv == 0) { g.P = p->kvh + (long)b * SEQ * KV_LD + gq * 192; g.ksegP = 3; g.nk = 6; g.kt0 = 6 * sp; g.Q = p->ck1T; g.ldq = 6144; }
    else { g.P = p->kvh + (long)b * SEQ * KV_LD + 768 + gq * 128; g.ksegP = 2; g.nk = 4; g.kt0 = 4 * sp; g.Q = p->cv1T; g.ldq = 4096; }
    gemm256(shm, g, acc, tid);
    float* pt = p->part + (long)t * 65536;
#pragma unroll
    for (int m = 0; m < 8; ++m)
#pragma unroll
      for (int n = 0; n < 4; ++n) {
        *(f32x4*)(pt + (long)(wc * 64 + n * 16 + fr) * 256 + wr * 128 + m * 16 + fq * 4) = acc[m][n]; __builtin_amdgcn_sched_barrier(0);
      }
  }
}

__device__ __forceinline__ void phase_cmp2(PP p, LAS char* shm, int bid, int nb) {
  const int tid = threadIdx.x;
  LAS float* hid = (LAS float*)shm;
  for (int t = bid; t < 512; t += nb) {
    const int kv = t >> 8, bg = (t >> 5) & 7, ng = t & 31;
    const float* pt = p->part + (long)(kv * 128 + bg * 16) * 65536;
    const float* bias = p->biasp + (kv ? 32 * 256 : 0);
#pragma unroll
    for (int i = 0; i < 4; ++i) {
      const int e = tid + i * 512, nl = e & 7, hh = e >> 3;
      float s = 0.f;
      for (int pp = 0; pp < 32; ++pp) s += bias[pp * 256 + hh];
      for (int sp = 0; sp < 16; ++sp) s += pt[(long)sp * 65536 + (long)hh * 256 + ng * 8 + nl];
      hid[nl * 256 + hh] = siluf_(s);
    }
    __syncthreads();
    if (kv == 0) {
#pragma unroll
      for (int i = 0; i < 3; ++i) {
        const int o = tid + i * 512, nl = o / 192, j = o % 192, n = ng * 8 + nl;
        float s = 0.f;
        for (int hh = 0; hh < 256; ++hh) s += hid[nl * 256 + hh] * p->w_ck2[hh * 192 + j];
        p->kc[((long)bg * 256 + n) * 192 + j] = (n < 255) ? (h16)s : (h16)0.f;
      }
    } else {
#pragma unroll
      for (int i = 0; i < 2; ++i) {
        const int o = tid + i * 512, nl = o >> 7, j = o & 127, n = ng * 8 + nl;
        float s = 0.f;
        for (int hh = 0; hh < 256; ++hh) s += hid[nl * 256 + hh] * p->w_cv2[hh * 128 + j];
        p->vcT[((long)bg * 128 + j) * 256 + n] = (n < 255) ? (h16)s : (h16)0.f;
      }
    }
    __syncthreads();
  }
}

__device__ __forceinline__ void phase_select(PP p, LAS char* shm, int bid, int nb) {
  LAS float* psel = (LAS float*)(shm + 102400);
  for (int u = bid; u < 1024; u += nb) {
    const int tid = opaque_tid(), wid = tid >> 6, lane = tid & 63, fr = lane & 15, fq = lane >> 4;
    const int r = wid >> 1, th = wid & 1;
    const int bg = u >> 7, tile = u & 127, b = bg >> 2, gq = bg & 3, t0 = tile * 32;
    const h16* kcb = p->kc + (long)bg * 256 * 192;
    { const int row = tid >> 1, c0 = (tid & 1) * 12;
      const h16* src = kcb + row * 192 + c0 * 8; LAS char* dl = shm + row * 400 + c0 * 16;
#pragma unroll
      for (int i = 0; i < 12; ++i) *(LAS u32x4*)(dl + i * 16) = *(const u32x4*)(src + i * 8); }
    const int tq = t0 + th * 16 + fr;
    const h16* qrow = p->proj + ((long)b * SEQ + tq) * NSA_LD + (gq * 4 + r) * 192 + fq * 8;
    h16x8 qf[6];
#pragma unroll
    for (int ks = 0; ks < 6; ++ks) qf[ks] = *(const h16x8*)(qrow + ks * 32);
    __syncthreads();
    f32x4 s[16];
#pragma unroll
    for (int mt = 0; mt < 16; ++mt) s[mt] = (f32x4){0.f, 0.f, 0.f, 0.f};
#pragma unroll
    for (int ks = 0; ks < 6; ++ks)
#pragma unroll
      for (int mt = 0; mt < 16; ++mt) {
        const h16x8 kf = *(const LAS h16x8*)(shm + (mt * 16 + fr) * 400 + (ks * 32 + fq * 8) * 2);
        s[mt] = __builtin_amdgcn_mfma_f32_16x16x32_f16(kf, qf[ks], s[mt], 0, 0, 0);
      }
    float mx = -1e30f;
#pragma unroll
    for (int mt = 0; mt < 16; ++mt)
#pragma unroll
      for (int j = 0; j < 4; ++j) {
        const int n = mt * 16 + fq * 4 + j;
        const bool valid = (n < 255) && (16 * n + 31 <= tq);
        const float v = valid ? s[mt][j] : -1e30f;
        s[mt][j] = v; mx = fmaxf(mx, v);
      }
    mx = fmaxf(mx, __shfl_xor(mx, 16)); mx = fmaxf(mx, __shfl_xor(mx, 32));
    float l = 0.f;
#pragma unroll
    for (int mt = 0; mt < 16; ++mt)
#pragma unroll
      for (int j = 0; j < 4; ++j) { const float pv = (s[mt][j] > -1e29f) ? __builtin_amdgcn_exp2f(s[mt][j] - mx) : 0.f; s[mt][j] = pv; l += pv; }
    l += __shfl_xor(l, 16); l += __shfl_xor(l, 32);
    const float inv = l > 0.f ? 1.f / l : 0.f;
#pragma unroll
    for (int mt = 0; mt < 16; ++mt) {
      const float own = s[mt][0] + 2.f * (s[mt][1] + s[mt][2] + s[mt][3]);
      const float x1 = __shfl(s[mt][0], (lane + 16) & 63);
      const float nx = (mt < 15) ? s[(mt + 1) & 15][0] : 0.f;
      const float x2 = __shfl(nx, (lane + 16) & 63);
      const float val = (own + (fq < 3 ? x1 : x2)) * inv;
      psel[(r * 32 + th * 16 + fr) * 64 + mt * 4 + fq] = val;
    }
    __syncthreads();
#pragma unroll
    for (int i = 0; i < 4; ++i) {
      const int tl = wid * 4 + i, t = t0 + tl, cur = t >> 6, j = lane;
      const float ps = psel[(0 * 32 + tl) * 64 + j] + psel[(1 * 32 + tl) * 64 + j] + psel[(2 * 32 + tl) * 64 + j] + psel[(3 * 32 + tl) * 64 + j];
      const bool forced = (j == 0) || (j == cur) || (j == cur - 1);
      const float score = forced ? 1e9f : (j <= cur ? ps : -1.0f);
      int rank = 0;
      for (int k = 0; k < 64; ++k) { const float sk = __shfl(score, k); rank += (sk > score || (sk == score && k < j)) ? 1 : 0; }
      const u64 mk = __ballot(rank < 16);
      if (lane == 0) p->masks[(long)bg * SEQ + t] = mk;
    }
    __syncthreads();
  }
}


__device__ __forceinline__ float xr_max(float v) {
  const unsigned u = __float_as_uint(v);
  auto r = __builtin_amdgcn_permlane16_swap(u, u, false, false);
  const float a = fmaxf(__uint_as_float(r[0]), __uint_as_float(r[1]));
  const unsigned ua = __float_as_uint(a);
  auto r2 = __builtin_amdgcn_permlane32_swap(ua, ua, false, false);
  return fmaxf(__uint_as_float(r2[0]), __uint_as_float(r2[1]));
}
__device__ __forceinline__ float xr_sum(float v) {
  const unsigned u = __float_as_uint(v);
  auto r = __builtin_amdgcn_permlane16_swap(u, u, false, false);
  const float a = __uint_as_float(r[0]) + __uint_as_float(r[1]);
  const unsigned ua = __float_as_uint(a);
  auto r2 = __builtin_amdgcn_permlane32_swap(ua, ua, false, false);
  return __uint_as_float(r2[0]) + __uint_as_float(r2[1]);
}
constexpr int FK_OFF = 0, FV_OFF = 25600, FQ_OFF = 44032;
__device__ __forceinline__ void flash_branch(PP p, LAS char* shm, int branch, int b, int gq, int t0, const h16x8 (&qf)[2][6]) {
  const int tid = opaque_tid(), wid = tid >> 6, lane = tid & 63, fr = lane & 15, fq = lane >> 4;
  const int r = wid >> 1, th = wid & 1, bg = b * 4 + gq, hd = gq * 4 + r;
  const int cur = t0 >> 6;
  const h16* Kb; long ldk; const h16* VTb; long ldvt; int jlo, jhi;
  if (branch == 0) { Kb = p->kc + (long)bg * 256 * 192; ldk = 192; VTb = p->vcT + (long)bg * 128 * 256; ldvt = 256; jlo = 0; jhi = (t0 + 32) >> 10; if (jhi > 3) jhi = 3; }
  else if (branch == 1) { Kb = p->kvh + (long)b * SEQ * KV_LD + 1280 + gq * 192; ldk = KV_LD; VTb = p->vselT + ((long)b * 512 + gq * 128) * SEQ; ldvt = SEQ; jlo = 0; jhi = cur; }
  else { Kb = p->kvh + (long)b * SEQ * KV_LD + 2560 + gq * 192; ldk = KV_LD; VTb = p->vwinT + ((long)b * 512 + gq * 128) * SEQ; ldvt = SEQ; jlo = cur - 8 > 0 ? cur - 8 : 0; jhi = cur; }
  int tq[2]; u64 mk[2];
#pragma unroll
  for (int nt = 0; nt < 2; ++nt) { tq[nt] = t0 + th * 32 + nt * 16 + fr; mk[nt] = (branch == 1) ? p->masks[(long)bg * SEQ + tq[nt]] : 0ull; }
  f32x4 O[8][2];
#pragma unroll
  for (int et = 0; et < 8; ++et) { O[et][0] = (f32x4){0.f, 0.f, 0.f, 0.f}; O[et][1] = (f32x4){0.f, 0.f, 0.f, 0.f}; }
  float mrun[2] = {-1e30f, -1e30f}, lrun[2] = {0.f, 0.f};
  int koff[4], voff[3];
#pragma unroll
  for (int i = 0; i < 4; ++i) { const int c = (wid + 8 * i) * 64 + lane, row = c / 25, ch = c % 25; koff[i] = row * (int)ldk + (ch < 24 ? ch : 23) * 8; }
#pragma unroll
  for (int i = 0; i < 3; ++i) { const int c = (wid + 8 * i) * 64 + lane, e = c / 9, ch = c % 9; voff[i] = e * (int)ldvt + (ch < 8 ? ch : 7) * 8; }
#define F_STAGE(j, buf) do { \
    const h16* kb_ = Kb + (long)(j) * 64 * ldk; const h16* vb_ = VTb + (long)(j) * 64; LAS char* lb_ = shm + (buf) * 44032; \
    _Pragma("unroll") for (int i = 0; i < 4; ++i) if (wid + 8 * i < 25) __builtin_amdgcn_global_load_lds((const unsigned*)(kb_ + koff[i]), (LAS unsigned*)(lb_ + FK_OFF + (wid + 8 * i) * 1024), 16, 0, 0); \
    _Pragma("unroll") for (int i = 0; i < 3; ++i) if (wid + 8 * i < 18) __builtin_amdgcn_global_load_lds((const unsigned*)(vb_ + voff[i]), (LAS unsigned*)(lb_ + FV_OFF + (wid + 8 * i) * 1024), 16, 0, 0); } while (0)
  F_STAGE(jlo, 0);
  asm volatile("s_waitcnt vmcnt(0)" ::: "memory");
  __syncthreads();
  for (int j = jlo; j <= jhi; ++j) {
    const int cb = (j - jlo) & 1;
    LAS char* lb = shm + cb * 44032;
    if (j + 1 <= jhi) F_STAGE(j + 1, cb ^ 1);
    f32x4 s[4][2];
#pragma unroll
    for (int mt = 0; mt < 4; ++mt) { s[mt][0] = (f32x4){0.f, 0.f, 0.f, 0.f}; s[mt][1] = (f32x4){0.f, 0.f, 0.f, 0.f}; }
#pragma unroll
    for (int ks = 0; ks < 6; ++ks) {
      const h16x8 q0 = qf[0][ks], q1 = qf[1][ks];
#pragma unroll
      for (int mt = 0; mt < 4; ++mt) {
        const h16x8 kf = *(const LAS h16x8*)(lb + FK_OFF + (mt * 16 + fr) * 400 + (ks * 32 + fq * 8) * 2);
        s[mt][0] = __builtin_amdgcn_mfma_f32_16x16x32_f16(kf, q0, s[mt][0], 0, 0, 0);
        s[mt][1] = __builtin_amdgcn_mfma_f32_16x16x32_f16(kf, q1, s[mt][1], 0, 0, 0);
      }
    }
    __builtin_amdgcn_sched_group_barrier(0x100, 4, 0);
#pragma unroll
    for (int i = 0; i < 20; ++i) { __builtin_amdgcn_sched_group_barrier(0x100, 1, 0); __builtin_amdgcn_sched_group_barrier(0x008, 2, 0); }
    __builtin_amdgcn_sched_group_barrier(0x008, 8, 0);
    h16x8 pf[2][2];
    const bool full = (branch == 0) || (branch == 1 && j == cur) || (branch == 2 && (j == cur || j == cur - 8));
#pragma unroll
    for (int nt = 0; nt < 2; ++nt) {
      if (full) {
#pragma unroll
        for (int mt = 0; mt < 4; ++mt)
#pragma unroll
          for (int jj = 0; jj < 4; ++jj) {
            const int key = j * 64 + mt * 16 + fq * 4 + jj;
            bool valid;
            if (branch == 0) valid = (key < 255) && (16 * key + 31 <= tq[nt]);
            else if (branch == 1) valid = ((mk[nt] >> j) & 1ull) && (key <= tq[nt]);
            else valid = (key <= tq[nt]) && (tq[nt] - key < 512);
            s[mt][nt][jj] = valid ? s[mt][nt][jj] : -1e30f;
          }
      } else if (branch == 1) {
        const bool selb = (mk[nt] >> j) & 1ull;
#pragma unroll
        for (int mt = 0; mt < 4; ++mt)
#pragma unroll
          for (int jj = 0; jj < 4; ++jj) s[mt][nt][jj] = selb ? s[mt][nt][jj] : -1e30f;
      }
      float mx = fmaxf(fmaxf(s[0][nt][0], s[0][nt][1]), fmaxf(s[0][nt][2], s[0][nt][3]));
#pragma unroll
      for (int mt = 1; mt < 4; ++mt) mx = fmaxf(mx, fmaxf(fmaxf(s[mt][nt][0], s[mt][nt][1]), fmaxf(s[mt][nt][2], s[mt][nt][3])));
      mx = xr_max(mx);
      const float mold = mrun[nt];
      const float mnew = fmaxf(mold, mx);
      const float msafe = fmaxf(mnew, -1e29f);
      mrun[nt] = mnew;
      float rs = 0.f;
#pragma unroll
      for (int mt = 0; mt < 4; ++mt)
#pragma unroll
        for (int jj = 0; jj < 4; ++jj) { const float pv = __builtin_amdgcn_exp2f(s[mt][nt][jj] - msafe); s[mt][nt][jj] = pv; rs += pv; }
      rs = xr_sum(rs);
      if (__builtin_amdgcn_ballot_w64(mnew > mold) != 0ull) {
        const float alpha = __builtin_amdgcn_exp2f(mold - mnew);
        lrun[nt] = lrun[nt] * alpha + rs;
#pragma unroll
        for (int et = 0; et < 8; ++et) O[et][nt] = O[et][nt] * alpha;
      } else {
        lrun[nt] += rs;
      }
#pragma unroll
      for (int k2 = 0; k2 < 2; ++k2)
#pragma unroll
        for (int jj = 0; jj < 4; ++jj) { pf[nt][k2][jj] = (h16)s[2 * k2][nt][jj]; pf[nt][k2][4 + jj] = (h16)s[2 * k2 + 1][nt][jj]; }
    }
#pragma unroll
    for (int et = 0; et < 8; ++et)
#pragma unroll
      for (int k2 = 0; k2 < 2; ++k2) {
        const LAS char* va = lb + FV_OFF + (et * 16 + fr) * 144 + (k2 * 32 + fq * 4) * 2;
        const h16x4 lo = *(const LAS h16x4*)va, hi = *(const LAS h16x4*)(va + 32);
        h16x8 vf; vf[0] = lo[0]; vf[1] = lo[1]; vf[2] = lo[2]; vf[3] = lo[3]; vf[4] = hi[0]; vf[5] = hi[1]; vf[6] = hi[2]; vf[7] = hi[3];
        O[et][0] = __builtin_amdgcn_mfma_f32_16x16x32_f16(vf, pf[0][k2], O[et][0], 0, 0, 0);
        O[et][1] = __builtin_amdgcn_mfma_f32_16x16x32_f16(vf, pf[1][k2], O[et][1], 0, 0, 0);
      }
    __builtin_amdgcn_sched_group_barrier(0x100, 4, 0);
#pragma unroll
    for (int i = 0; i < 14; ++i) { __builtin_amdgcn_sched_group_barrier(0x100, 2, 0); __builtin_amdgcn_sched_group_barrier(0x008, 2, 0); }
    __builtin_amdgcn_sched_group_barrier(0x008, 4, 0);
    asm volatile("s_waitcnt vmcnt(0)" ::: "memory");
    __syncthreads();
  }
#undef F_STAGE
#pragma unroll
  for (int nt = 0; nt < 2; ++nt) {
    const long tok = (long)b * SEQ + tq[nt];
    const h16* pr = p->proj + tok * NSA_LD;
    const float gt = sigmoidf_((float)pr[9216 + branch * 16 + hd]);
    const float inv = lrun[nt] > 0.f ? gt / lrun[nt] : 0.f;
#pragma unroll
    for (int et = 0; et < 8; ++et) {
      const int e0 = hd * 128 + et * 16 + fq * 4;
      const h16x4 zv = *(const h16x4*)(pr + 3072 + branch * 2048 + e0);
      h16* mp = p->mixed + tok * DM + e0;
      f32x4 r;
#pragma unroll
      for (int jj = 0; jj < 4; ++jj) r[jj] = O[et][nt][jj] * inv * siluf_((float)zv[jj]);
      if (branch != 0) { const h16x4 old = *(const h16x4*)mp; r[0] += (float)old[0]; r[1] += (float)old[1]; r[2] += (float)old[2]; r[3] += (float)old[3]; }
      *(h16x4*)mp = cvt4(r);
    }
  }
}

__device__ __forceinline__ void phase_attn(PP p, LAS char* shm, int bid, int nb) {
  for (int u0 = bid; u0 < 256; u0 += nb) {
    const int u = (nb == 256) ? ((u0 & 7) << 5 | (u0 >> 3)) : u0;
    const int bg = u >> 5, pr = u & 31, b = bg >> 2, gq = bg & 3;
    for (int half = 0; half < 2; ++half) {
      const int tile = half ? 63 - pr : pr, t0 = tile * 64;
      h16x8 qf[2][6];
      { const int tid = opaque_tid(), wid = tid >> 6, lane = tid & 63, fr = lane & 15, fq = lane >> 4, r = wid >> 1, th = wid & 1;
#pragma unroll
        for (int nt = 0; nt < 2; ++nt) {
          const h16* qrow = p->proj + ((long)b * SEQ + t0 + th * 32 + nt * 16 + fr) * NSA_LD + (gq * 4 + r) * 192 + fq * 8;
#pragma unroll
          for (int ks = 0; ks < 6; ++ks) qf[nt][ks] = *(const h16x8*)(qrow + ks * 32);
        } }
      flash_branch(p, shm, 0, b, gq, t0, qf);
      flash_branch(p, shm, 1, b, gq, t0, qf);
      flash_branch(p, shm, 2, b, gq, t0, qf);
    }
  }
}


#define XB_TMO      128
#define XB_XCNT(j)  (256  + 64 * (j))
#define XB_XSUB(j)  (1280 + 64 * (j))
#define XB_XGEN(j)  (2304 + 64 * (j))
#define XB_TOP      3328
#define XB_TOPGEN   3392
#define XCD_BAR_WORDS 3456
#define XB_SPIN_CAP (1u << 18)
__device__ __forceinline__ unsigned xb_ld(unsigned* p)              { return __hip_atomic_load(p, __ATOMIC_RELAXED, __HIP_MEMORY_SCOPE_AGENT); }
__device__ __forceinline__ unsigned xb_add(unsigned* p, unsigned v) { return __hip_atomic_fetch_add(p, v, __ATOMIC_RELAXED, __HIP_MEMORY_SCOPE_AGENT); }
__device__ __forceinline__ unsigned xb_xcc_id() { return (unsigned)__builtin_amdgcn_s_getreg((3 << 11) | 20) & 0xFu; }
#define XB_SPIN(cond, bar) do { unsigned _sp = 0; while (cond) { __builtin_amdgcn_s_sleep(1); \
    if ((++_sp & 255u) == 0u) { if (xb_ld(&(bar)[XB_TMO])) break; if (_sp > XB_SPIN_CAP) { atomicAdd(&(bar)[XB_TMO], 1u); break; } } } } while (0)
struct XcdBarrier { unsigned* bar; unsigned x; volatile LAS unsigned* st; };
__device__ __forceinline__ XcdBarrier xcd_barrier_post(unsigned* bar, volatile LAS unsigned* st) {
  XcdBarrier b; b.bar = bar; b.x = xb_xcc_id(); b.st = st;
  if (threadIdx.x == 0) (void)xb_add(&bar[XB_XCNT(b.x)], 1u);
  return b;
}
__device__ __forceinline__ void xcd_barrier_complete(unsigned* bar, unsigned x, unsigned& nloc, unsigned& nx) {
  const unsigned G = gridDim.x * gridDim.y * gridDim.z;
  unsigned sum, cnt, mine, sp = 0u;
  for (;;) {
    sum = 0u; cnt = 0u; mine = 0u;
#pragma unroll
    for (unsigned j = 0; j < 16; ++j) { const unsigned c = xb_ld(&bar[XB_XCNT(j)]); sum += c; cnt += (c > 0u) ? 1u : 0u; mine = (j == x) ? c : mine; }
    if (sum == G) break;
    __builtin_amdgcn_s_sleep(1);
    if ((++sp & 255u) == 0u) { if (xb_ld(&bar[XB_TMO])) break; if (sp > XB_SPIN_CAP) { atomicAdd(&bar[XB_TMO], 1u); break; } }
  }
  nloc = mine > 0u ? mine : 1u; nx = cnt > 0u ? cnt : 1u;
}
__device__ __forceinline__ void xcd_barrier(const XcdBarrier& b) {
  asm volatile("s_waitcnt vmcnt(0)" ::: "memory");
  __syncthreads();
  if (threadIdx.x == 0) {
    unsigned* bar = b.bar;
    __builtin_amdgcn_s_waitcnt(0);
    unsigned nloc = b.st[0], nx = b.st[1];
    if (nloc == 0u) { xcd_barrier_complete(bar, b.x, nloc, nx); b.st[0] = nloc; b.st[1] = nx; }
    const unsigned old = xb_add(&bar[XB_XSUB(b.x)], 1u);
    const unsigned gen = old / nloc;
    if (old + 1u == (gen + 1u) * nloc) {
      __builtin_amdgcn_fence(__ATOMIC_RELEASE, "agent");
      asm volatile("s_waitcnt vmcnt(0)" ::: "memory");
      const unsigned og = xb_add(&bar[XB_TOP], 1u);
      const unsigned tg = og / nx;
      if (og + 1u == (tg + 1u) * nx) xb_add(&bar[XB_TOPGEN], 1u);
      else XB_SPIN(xb_ld(&bar[XB_TOPGEN]) == tg, bar);
      __builtin_amdgcn_fence(__ATOMIC_ACQUIRE, "agent");
      xb_add(&bar[XB_XGEN(b.x)], 1u);
      asm volatile("s_waitcnt vmcnt(0)" ::: "memory");
    } else {
      XB_SPIN(xb_ld(&bar[XB_XGEN(b.x)]) == gen, bar);
      __builtin_amdgcn_fence(__ATOMIC_ACQUIRE, "agent");
      asm volatile("s_waitcnt vmcnt(0)" ::: "memory");
    }
  }
  __syncthreads();
}

__global__ void __launch_bounds__(NTHR) mega_kernel(Params pk, int ph_lo, int ph_hi) {
  __shared__ __attribute__((aligned(1024))) char shm_raw[SHM_BYTES];
  LAS char* shm = (LAS char*)shm_raw;
  cg::grid_group grid = cg::this_grid();
  const int bid = blockIdx.x, nb = gridDim.x;
  if (threadIdx.x < 4) ((LAS unsigned*)(shm + SHM_BYTES - 16))[threadIdx.x] = 0u;
  __syncthreads();
  XcdBarrier xb;
  { PP p0 = (PP)__builtin_amdgcn_kernarg_segment_ptr(); xb = xcd_barrier_post(p0->xbar, (volatile LAS unsigned*)(shm + SHM_BYTES - 16)); }
#define PH(k, call) if (ph_lo <= (k) && (k) < ph_hi) { PP p = (PP)__builtin_amdgcn_kernarg_segment_ptr(); asm volatile("" : "+s"(p)); call; if ((k) + 1 < ph_hi) xcd_barrier(xb); }
  if (ph_lo < 0) { asm volatile("s_waitcnt vmcnt(0)" ::: "memory"); __syncthreads(); grid.sync(); }
  PH(0, phase_prep(p, shm, bid, nb))
  PH(1, phase_proj<0>(p, 0, shm, bid, nb))
  PH(2, phase_retB(p, shm, bid, nb))
  PH(3, phase_retC(p, bid, nb))
  PH(4, phase_retD(p, shm, bid, nb))
  PH(6, phase_proj<1>(p, 0, shm, bid, nb))
  PH(7, phase_ln(p, 0, shm, bid, nb))
  PH(8, phase_proj<0>(p, 1, shm, bid, nb))
  PH(9, phase_retB(p, shm, bid, nb))
  PH(10, phase_retC(p, bid, nb))
  PH(11, phase_retD(p, shm, bid, nb))
  PH(13, phase_proj<1>(p, 1, shm, bid, nb))
  PH(14, phase_ln(p, 1, shm, bid, nb))
  PH(15, (phase_proj<3>(p, 2, shm, bid, nb), phase_proj<2>(p, 2, shm, bid, nb)))
  PH(16, phase_cmp1(p, shm, bid, nb))
  PH(17, phase_cmp2(p, shm, bid, nb))
  PH(19, phase_select(p, shm, bid, nb))
  PH(20, phase_attn(p, shm, bid, nb))
  PH(21, phase_proj<1>(p, 2, shm, bid, nb))
  PH(22, phase_ln(p, 2, shm, bid, nb))
  PH(23, phase_proj<2>(p, 3, shm, bid, nb))
  PH(24, phase_select(p, shm, bid, nb))
  PH(25, phase_attn(p, shm, bid, nb))
  PH(26, phase_proj<1>(p, 3, shm, bid, nb))
  PH(27, phase_ln(p, 3, shm, bid, nb))
#undef PH
}

extern "C" void kernel_launch(void* const* d_in, const int* in_sizes, int n_in, void* d_out, int out_size, void* d_ws, size_t ws_size, hipStream_t stream) {
  Params p{};
  p.x = (const float*)d_in[0]; p.pos = (const int*)d_in[1];
  p.ret_w_in[0] = (const float*)d_in[2]; p.ret_w_out[0] = (const float*)d_in[3]; p.ln_g[0] = (const float*)d_in[4]; p.ln_b[0] = (const float*)d_in[5];
  p.ret_w_in[1] = (const float*)d_in[6]; p.ret_w_out[1] = (const float*)d_in[7]; p.ln_g[1] = (const float*)d_in[8]; p.ln_b[1] = (const float*)d_in[9];
  p.w_kv = (const float*)d_in[10]; p.pe_k = (const float*)d_in[11]; p.pe_v = (const float*)d_in[12];
  p.w_ck1 = (const float*)d_in[13]; p.w_ck2 = (const float*)d_in[14]; p.w_cv1 = (const float*)d_in[15]; p.w_cv2 = (const float*)d_in[16];
  p.nsa_w_in[0] = (const float*)d_in[17]; p.nsa_w_out[0] = (const float*)d_in[18]; p.ln_g[2] = (const float*)d_in[19]; p.ln_b[2] = (const float*)d_in[20];
  p.nsa_w_in[1] = (const float*)d_in[21]; p.nsa_w_out[1] = (const float*)d_in[22]; p.ln_g[3] = (const float*)d_in[23]; p.ln_b[3] = (const float*)d_in[24];
  p.out = (float*)d_out;
  char* ws = (char*)d_ws; size_t off = 0;
  auto take = [&](size_t bytes) { char* r = ws + off; off += (bytes + 4095) & ~(size_t)4095; return r; };
  p.wA = (h16*)take((size_t)13312 * 2048 * 2);
  p.wB = (h16*)take((size_t)4096 * 2048 * 2);
  p.xres = (float*)take((size_t)NTOK * DM * 4);
  p.xh = (h16*)take((size_t)NTOK * DM * 2);
  p.cs = (float*)take((size_t)NTOK * 256 * 4);
  p.ck1T = (h16*)take((size_t)256 * 6144 * 2);
  p.cv1T = (h16*)take((size_t)256 * 4096 * 2);
  p.biask = (float*)take(1024); p.biasv = (float*)take(1024); p.biasp = (float*)take(65536);
  p.kc = (h16*)take((size_t)8 * 256 * 192 * 2);
  p.vcT = (h16*)take((size_t)8 * 128 * 256 * 2);
  p.masks = (u64*)take((size_t)8 * SEQ * 8);
  const size_t region = off;
  p.kh = (h16*)take((size_t)NTOK * 2048 * 2);
  p.kdT = (h16*)take((size_t)NTOK * 2048 * 2);
  p.Obuf = p.kh;
  p.qh = (h16*)take((size_t)NTOK * 2048 * 2);
  p.vT = (h16*)take((size_t)NTOK * 4096 * 2);
  p.zh = (h16*)take((size_t)NTOK * 4096 * 2);
  p.St = (h16*)take((size_t)16 * 16 * 131072 * 2);
  p.Pbuf = (h16*)take((size_t)16 * SEQ * 256 * 2);
  off = region;
  p.kvh = (h16*)take((size_t)NTOK * KV_LD * 2 + 65536 * 4);
  p.vselT = (h16*)take((size_t)2 * 512 * SEQ * 2);
  p.vwinT = (h16*)take((size_t)2 * 512 * SEQ * 2);
  p.mixed = (h16*)take((size_t)NTOK * DM * 2);
  p.proj = (h16*)take((size_t)NTOK * NSA_LD * 2);
  p.part = (float*)take((size_t)256 * 65536 * 4);
  p.xbar = (unsigned*)take(XCD_BAR_WORDS * 4);

  if (off > ws_size) fprintf(stderr, "workspace too small: need %zu have %zu\n", off, ws_size);
  static int grid_blocks = 0;
  if (!grid_blocks) {
    int dev = 0, cus = 0, per_cu = 0;
    (void)hipGetDevice(&dev);
    (void)hipDeviceGetAttribute(&cus, hipDeviceAttributeMultiprocessorCount, dev);
    (void)hipOccupancyMaxActiveBlocksPerMultiprocessor(&per_cu, mega_kernel, NTHR, 0);
    if (per_cu < 1) per_cu = 1;
    grid_blocks = cus * per_cu;
    if (grid_blocks > 256) grid_blocks = 256;
  }
  (void)hipMemsetAsync(p.xbar, 0, XCD_BAR_WORDS * 4, stream);
#if FUSED
  int lo = 0, hi = 28;
  void* args[] = {&p, &lo, &hi};
  hipError_t e = hipLaunchCooperativeKernel((void*)mega_kernel, dim3(grid_blocks), dim3(NTHR), args, 0, stream);
  if (e != hipSuccess) fprintf(stderr, "cooperative launch failed: %s (grid %d)\n", hipGetErrorString(e), grid_blocks);
#else
  for (int ph = 0; ph < 28; ++ph) hipLaunchKernelGGL(mega_kernel, dim3(256), dim3(NTHR), 0, stream, p, ph, ph + 1);
#endif
}
```

```cpp
#include <hip/hip_runtime.h>
#include <hip/hip_cooperative_groups.h>
#include <cstdio>
namespace cg = cooperative_groups;

#ifndef FUSED
#define FUSED 1
#endif

#define LAS __attribute__((address_space(3)))
typedef _Float16 h16;
typedef _Float16 h16x8 __attribute__((ext_vector_type(8)));
typedef _Float16 h16x4 __attribute__((ext_vector_type(4)));
typedef float f32x4 __attribute__((ext_vector_type(4)));
typedef unsigned long long u64;
typedef unsigned u32x4 __attribute__((ext_vector_type(4)));

constexpr int NTHR = 512;
constexpr int SEQ = 4096, NTOK = 8192, DM = 2048;
constexpr int SHM_BYTES = 147456;
constexpr float ALPHA_F = 1.6817928305074290f;
constexpr float LN_EPS_F = 1e-5f;
constexpr float LOG2E = 1.4426950408889634f;
constexpr int NSA_LD = 9472;
constexpr int KV_LD = 3840;

struct Params {
  const float* x; const int* pos;
  const float* ret_w_in[2]; const float* ret_w_out[2];
  const float* ln_g[4]; const float* ln_b[4];
  const float* w_kv; const float* pe_k; const float* pe_v; const float* w_ck1; const float* w_ck2; const float* w_cv1; const float* w_cv2;
  const float* nsa_w_in[2]; const float* nsa_w_out[2];
  float* out;
  h16* wA; h16* wB; float* xres; h16* xh; float* cs; h16* ck1T; h16* cv1T; float* biask; float* biasv; float* biasp;
  h16* qh; h16* kh; h16* kdT; h16* vT; h16* zh; h16* St; h16* Pbuf; h16* Obuf;
  h16* kvh; h16* vselT; h16* vwinT; h16* kc; h16* vcT; float* part; h16* proj; u64* masks; h16* mixed; unsigned* xbar;
};

typedef const __attribute__((address_space(4))) Params* PP;
#define WAIT_V0() asm volatile("s_waitcnt vmcnt(0)" ::: "memory")
__device__ __forceinline__ int opaque_tid() { int t = threadIdx.x; asm volatile("" : "+v"(t)); return t; }

__device__ __forceinline__ int lds_byte(int r, int c) {
  int st = (r >> 4) * 2 + (c >> 5), ob = (r & 15) * 64 + (c & 31) * 2;
  return st * 1024 + (ob ^ (((ob >> 9) & 1) << 5));
}
__device__ __forceinline__ void stage_rc(int b, int& R, int& C) {
  int st = b >> 10, sb = b & 1023, swz = sb ^ (((sb >> 9) & 1) << 5);
  R = (st >> 1) * 16 + swz / 64;
  C = (st & 1) * 32 + (swz % 64) / 2;
}
__device__ __forceinline__ float lg2gamma(int h) { return log1pf(-exp2f(-5.f - (float)h)) * LOG2E; }
__device__ __forceinline__ float sigmoidf_(float v) { return 1.f / (1.f + __expf(-v)); }
__device__ __forceinline__ float siluf_(float v) { return v / (1.f + __expf(-v)); }
__device__ __forceinline__ h16x4 cvt4(f32x4 v) { h16x4 r; r[0] = (h16)v[0]; r[1] = (h16)v[1]; r[2] = (h16)v[2]; r[3] = (h16)v[3]; return r; }

struct GOp { const h16* P; const h16* Q; long ldp, ldq; int nk, kt0, ksegP; long segP; };

__device__ __forceinline__ void gemm256(LAS char* shm, const GOp g, f32x4 (&acc)[8][4], const int tid) {
  const int wid = tid >> 6, lane = tid & 63, wr = wid >> 2, wc = wid & 3, fr = lane & 15, fq = lane >> 4;
  int offP[4], offQ[4];
#pragma unroll
  for (int i = 0; i < 4; ++i) { int R, C; stage_rc(wid * 1024 + i * 8192 + lane * 16, R, C); offP[i] = R * (int)g.ldp + C; offQ[i] = R * (int)g.ldq + C; }
#define G_STAGE(buf, t) do { const int kk_ = g.kt0 + (t); const long kp_ = (long)(kk_ / g.ksegP) * g.segP + (long)(kk_ % g.ksegP) * 64; const long kq_ = (long)kk_ * 64; \
    _Pragma("unroll") for (int i = 0; i < 4; ++i) { \
      __builtin_amdgcn_global_load_lds((const unsigned*)(g.P + offP[i] + kp_), (LAS unsigned*)(shm + (buf) * 65536 + wid * 1024 + i * 8192), 16, 0, 0); \
      __builtin_amdgcn_global_load_lds((const unsigned*)(g.Q + offQ[i] + kq_), (LAS unsigned*)(shm + (buf) * 65536 + 32768 + wid * 1024 + i * 8192), 16, 0, 0); } } while (0)
  G_STAGE(0, 0); WAIT_V0(); __syncthreads();
#pragma unroll 1
  for (int t = 0; t < g.nk; ++t) {
    const int cur = t & 1;
    if (t + 1 < g.nk) G_STAGE(cur ^ 1, t + 1);
#pragma unroll
    for (int ks = 0; ks < 2; ++ks) {
      h16x8 At[8], Bf[4];
#pragma unroll
      for (int m = 0; m < 8; ++m) At[m] = *(const LAS h16x8*)(shm + cur * 65536 + lds_byte(wr * 128 + m * 16 + fr, ks * 32 + fq * 8));
#pragma unroll
      for (int n = 0; n < 4; ++n) Bf[n] = *(const LAS h16x8*)(shm + cur * 65536 + 32768 + lds_byte(wc * 64 + n * 16 + fr, ks * 32 + fq * 8));
#pragma unroll
      for (int m = 0; m < 8; ++m)
#pragma unroll
        for (int n = 0; n < 4; ++n) acc[m][n] = __builtin_amdgcn_mfma_f32_16x16x32_f16(At[m], Bf[n], acc[m][n], 0, 0, 0);
    }
    WAIT_V0(); __syncthreads();
  }
#undef G_STAGE
}
__device__ __forceinline__ void zero_acc(f32x4 (&acc)[8][4]) {
#pragma unroll
  for (int m = 0; m < 8; ++m)
#pragma unroll
    for (int n = 0; n < 4; ++n) acc[m][n] = (f32x4){0.f, 0.f, 0.f, 0.f};
}


__device__ __forceinline__ void gemm8p(LAS char* shm, const h16* __restrict__ A, const int lda, const h16* __restrict__ Bt, const int ldb, const int nt,
                                        f32x4 (&acc)[2][2][4][2], const int tid) {
  constexpr int HTB = 128 * 64 * 2;
#define SA8(b, h) (shm + ((b) * 2 + (h)) * HTB)
#define SB8(b, h) (shm + (4 + (b) * 2 + (h)) * HTB)
  const int wid = tid >> 6, lane = tid & 63, wr = wid >> 2, wc = wid & 3, fr = lane & 15, fq = lane >> 4;
  int oa[2], ob[2];
#pragma unroll
  for (int i = 0; i < 2; ++i) { int R, C; stage_rc((tid & 511) * 16 + i * 8192, R, C); oa[i] = R * lda + C; ob[i] = R * ldb + C; }
#define STAGE8A(P_, half, kt) do { const h16* g_ = A + (long)(half) * 128 * lda + (long)(kt) * 64; \
    _Pragma("unroll") for (int i_ = 0; i_ < 2; ++i_) __builtin_amdgcn_global_load_lds((const unsigned*)(g_ + oa[i_]), (LAS unsigned*)((P_) + wid * 1024 + i_ * 8192), 16, 0, 0); } while (0)
#define STAGE8B(P_, half, kt) do { const h16* g_ = Bt + (long)(half) * 128 * ldb + (long)(kt) * 64; \
    _Pragma("unroll") for (int i_ = 0; i_ < 2; ++i_) __builtin_amdgcn_global_load_lds((const unsigned*)(g_ + ob[i_]), (LAS unsigned*)((P_) + wid * 1024 + i_ * 8192), 16, 0, 0); } while (0)
#define LDA8(dst, b, h) _Pragma("unroll") for (int m = 0; m < 4; ++m) _Pragma("unroll") for (int k = 0; k < 2; ++k) \
    dst[m][k] = *(const LAS h16x8*)(SA8(b, h) + lds_byte(wr * 64 + m * 16 + fr, k * 32 + fq * 8))
#define LDB8(dst, b, h) _Pragma("unroll") for (int n = 0; n < 2; ++n) _Pragma("unroll") for (int k = 0; k < 2; ++k) \
    dst[n][k] = *(const LAS h16x8*)(SB8(b, h) + lds_byte(wc * 32 + n * 16 + fr, k * 32 + fq * 8))
#define MMA8(ai, bj, At_, Bt_) do { __builtin_amdgcn_s_setprio(1); \
    _Pragma("unroll") for (int m = 0; m < 4; ++m) _Pragma("unroll") for (int n = 0; n < 2; ++n) _Pragma("unroll") for (int k = 0; k < 2; ++k) \
      acc[ai][bj][m][n] = __builtin_amdgcn_mfma_f32_16x16x32_f16(At_[m][k], Bt_[n][k], acc[ai][bj][m][n], 0, 0, 0); \
    __builtin_amdgcn_s_setprio(0); } while (0)
#define WAIT_V8(n) asm volatile("s_waitcnt vmcnt(" #n ")" ::: "memory")
#define WAIT_L8(n) asm volatile("s_waitcnt lgkmcnt(" #n ")" ::: "memory")
#define BAR8 __builtin_amdgcn_s_barrier()
#define SCHED8 __builtin_amdgcn_sched_barrier(0)
  h16x8 At[4][2], B0[2][2], B1[2][2];
  WAIT_V8(0);
  STAGE8B(SB8(0, 0), 0, 0); STAGE8A(SA8(0, 0), 0, 0);
  STAGE8B(SB8(0, 1), 1, 0); STAGE8A(SA8(0, 1), 1, 0);
  if (wr == 1) BAR8;
  WAIT_V8(4); BAR8;
  STAGE8B(SB8(1, 0), 0, 1); STAGE8A(SA8(1, 0), 0, 1); STAGE8B(SB8(1, 1), 1, 1);
  WAIT_V8(6); BAR8;
#pragma unroll 1
  for (int t = 0; t < nt - 2; t += 2) {
    LDB8(B0, 0, 0); SCHED8; LDA8(At, 0, 0); STAGE8A(SA8(1, 1), 1, t + 1);
    WAIT_L8(8); BAR8; WAIT_L8(0); MMA8(0, 0, At, B0); BAR8; SCHED8;
    LDB8(B1, 0, 1); STAGE8B(SB8(0, 0), 0, t + 2);
    BAR8; WAIT_L8(0); MMA8(0, 1, At, B1); BAR8;
    LDA8(At, 0, 1); STAGE8A(SA8(0, 0), 0, t + 2);
    BAR8; WAIT_L8(0); MMA8(1, 0, At, B0); BAR8; SCHED8;
    STAGE8B(SB8(0, 1), 1, t + 2);
    WAIT_V8(6); BAR8; MMA8(1, 1, At, B1); BAR8;
    LDB8(B0, 1, 0); SCHED8; LDA8(At, 1, 0); STAGE8A(SA8(0, 1), 1, t + 2);
    WAIT_L8(8); BAR8; WAIT_L8(0); MMA8(0, 0, At, B0); BAR8; SCHED8;
    LDB8(B1, 1, 1); STAGE8B(SB8(1, 0), 0, t + 3);
    BAR8; WAIT_L8(0); MMA8(0, 1, At, B1); BAR8;
    LDA8(At, 1, 1); STAGE8A(SA8(1, 0), 0, t + 3);
    BAR8; WAIT_L8(0); MMA8(1, 0, At, B0); BAR8; SCHED8;
    STAGE8B(SB8(1, 1), 1, t + 3);
    WAIT_V8(6); BAR8; MMA8(1, 1, At, B1); BAR8;
  }
  { LDB8(B0, 0, 0); LDA8(At, 0, 0); STAGE8A(SA8(1, 1), 1, nt - 1);
    BAR8; WAIT_L8(0); MMA8(0, 0, At, B0); BAR8;
    LDB8(B1, 0, 1); BAR8; WAIT_L8(0); MMA8(0, 1, At, B1); BAR8;
    LDA8(At, 0, 1); WAIT_V8(4); BAR8; WAIT_L8(0); MMA8(1, 0, At, B0); MMA8(1, 1, At, B1); BAR8; }
  { LDB8(B0, 1, 0); LDA8(At, 1, 0); WAIT_V8(2); BAR8; WAIT_L8(0); MMA8(0, 0, At, B0); BAR8;
    LDB8(B1, 1, 1); WAIT_V8(0); BAR8; WAIT_L8(0); MMA8(0, 1, At, B1); BAR8;
    LDA8(At, 1, 1); BAR8; WAIT_L8(0); MMA8(1, 0, At, B0); MMA8(1, 1, At, B1); BAR8; }
  if (wr == 0) BAR8;
#undef SA8
#undef SB8
#undef STAGE8A
#undef STAGE8B
#undef LDA8
#undef LDB8
#undef MMA8
}

__device__ __forceinline__ void conv_job(LAS char* shm, const float* __restrict__ src, int K, int N, int Npad, h16* __restrict__ dst, int& tilebase, int bid, int nb) {
  LAS h16* tile = (LAS h16*)shm;
  const int tid = threadIdx.x;
  const int nkt = K / 64, nnt = Npad / 64, ntiles = nkt * nnt;
  int start = (int)((((long)bid - tilebase) % nb + nb) % nb);
  for (int t = start; t < ntiles; t += nb) {
    const int k0 = (t % nkt) * 64, n0 = (t / nkt) * 64;
#pragma unroll
    for (int i = 0; i < 2; ++i) {
      const int e = tid * 4 + i * 2048, k = e >> 6, n = e & 63;
      float4 v = make_float4(0.f, 0.f, 0.f, 0.f);
      if (n0 + n < N) v = *(const float4*)(src + (long)(k0 + k) * N + n0 + n);
      tile[(n + 0) * 72 + k] = (h16)v.x; tile[(n + 1) * 72 + k] = (h16)v.y; tile[(n + 2) * 72 + k] = (h16)v.z; tile[(n + 3) * 72 + k] = (h16)v.w;
    }
    __syncthreads();
    { const int nn = tid >> 3, k8 = (tid & 7) * 8;
      *(u32x4*)(dst + (long)(n0 + nn) * K + k0 + k8) = *(const LAS u32x4*)(tile + nn * 72 + k8); }
    __syncthreads();
  }
  tilebase += ntiles;
}

__device__ __forceinline__ void phase_prep(PP p, LAS char* shm, int bid, int nb) {
  const int tid = threadIdx.x;
  int tb = 0;
  conv_job(shm, p->ret_w_in[0], 2048, 12288, 12288, p->wA, tb, bid, nb);
  conv_job(shm, p->ret_w_out[0], 4096, 2048, 2048, p->wB, tb, bid, nb);
  conv_job(shm, p->w_ck1, 6144, 256, 256, p->ck1T, tb, bid, nb);
  conv_job(shm, p->w_cv1, 4096, 256, 256, p->cv1T, tb, bid, nb);
  for (long i = ((long)bid * NTHR + tid) * 8; i < (long)NTOK * DM; i += (long)nb * NTHR * 8) {
    float4 a = *(const float4*)(p->x + i), b = *(const float4*)(p->x + i + 4);
    h16x8 o; o[0] = (h16)a.x; o[1] = (h16)a.y; o[2] = (h16)a.z; o[3] = (h16)a.w; o[4] = (h16)b.x; o[5] = (h16)b.y; o[6] = (h16)b.z; o[7] = (h16)b.w;
    *(h16x8*)(p->xh + i) = o;
  }
  for (int i = bid * NTHR + tid; i < NTOK * 128; i += nb * NTHR) {
    const int tok = i >> 7, f = i & 127;
    const double invf = exp2(-((double)f / 127.0) * 13.287712379549449);
    const float invf32 = (float)invf;
    const float ang = (float)p->pos[tok] * invf32;
    double a = (double)ang;
    const double k = rint(a * 0.63661977236758134308);
    const double r = (a - k * 1.5707963267948966192) - k * 6.123233995736766e-17;
    const double r2 = r * r;
    double sn = r * (1.0 + r2 * (-1.0 / 6 + r2 * (1.0 / 120 + r2 * (-1.0 / 5040 + r2 * (1.0 / 362880 + r2 * (-1.0 / 39916800 + r2 * (1.0 / 6227020800.0)))))));
    double cn = 1.0 + r2 * (-0.5 + r2 * (1.0 / 24 + r2 * (-1.0 / 720 + r2 * (1.0 / 40320 + r2 * (-1.0 / 3628800 + r2 * (1.0 / 479001600.0 + r2 * (-1.0 / 87178291200.0)))))));
    const int q = ((int)k) & 3;
    double c, s;
    if (q == 0) { c = cn; s = sn; } else if (q == 1) { c = -sn; s = cn; } else if (q == 2) { c = -cn; s = -sn; } else { c = sn; s = -cn; }
    p->cs[(long)i * 2] = (float)c; p->cs[(long)i * 2 + 1] = (float)s;
  }
  if (bid < 64) {
    const bool isk = (bid < 32); const int part = bid & 31;
    const float* pe = isk ? p->pe_k : p->pe_v; const float* w1 = isk ? p->w_ck1 : p->w_cv1; const int rng = isk ? 192 : 128;
    LAS float* red = (LAS float*)(shm + 16384);
    const int j = tid & 255, half = tid >> 8;
    float s = 0.f;
    const int i0 = part * rng + half * (rng / 2);
    for (int i = i0; i < i0 + rng / 2; ++i) s += pe[i] * w1[(long)i * 256 + j];
    red[tid] = s;
    __syncthreads();
    if (tid < 256) p->biasp[(bid) * 256 + tid] = red[tid] + red[tid + 256];
    __syncthreads();
  }
}

__device__ __forceinline__ void st_pair16(h16* p0, h16* p1, h16x4 v0, h16x4 v1, int fq) {
  typedef unsigned u32x2_t __attribute__((ext_vector_type(2)));
  const u32x2_t a = __builtin_bit_cast(u32x2_t, v0), b = __builtin_bit_cast(u32x2_t, v1);
  auto lo = __builtin_amdgcn_permlane16_swap(a[0], b[0], false, false);
  auto hi = __builtin_amdgcn_permlane16_swap(a[1], b[1], false, false);
  u32x4 o; o[0] = lo[0]; o[1] = hi[0]; o[2] = lo[1]; o[3] = hi[1];
  h16* dst = (fq & 1) ? (p1 - 4) : p0;
  *(u32x4*)dst = o;
}
template <int WHICH, bool tr>
__device__ __forceinline__ void proj_epi(PP p, int layer, const f32x4 (&acc)[2][2][4][2], const int tn, const int tm) {
  const int K = (WHICH == 1 && layer < 2) ? 4096 : 2048;
  const h16* Wt = (WHICH == 1) ? p->wB : (WHICH == 2) ? (p->wA + (long)3840 * 2048) : p->wA;
  const h16* A = (WHICH == 1) ? (layer < 2 ? p->Obuf : p->mixed) : p->xh;
  const long lda = K;
  {
    const int tid = opaque_tid(), wid = tid >> 6, lane = tid & 63, wr = wid >> 2, wc = wid & 3, fr = lane & 15, fq = lane >> 4;
    const int b = tm >> 4;
    if (tr) {
      h16* outT; long nf; int col0;
      if (WHICH == 0) { outT = p->vT; nf = 4096; col0 = (tn - 16) * 256; }
      else { outT = (tn < 10) ? p->vselT : p->vwinT; nf = 512; col0 = (tn < 10) ? (tn - 8) * 256 : (tn - 13) * 256; }
#pragma unroll
      for (int m = 0; m < 8; ++m)
#pragma unroll
        for (int n2 = 0; n2 < 2; ++n2) {
          const int feat0 = col0 + n2 * 128 + wc * 32 + fr;
          const int tl = (tm & 15) * 256 + (m >> 2) * 128 + wr * 64 + (m & 3) * 16 + fq * 4;
          h16* p0 = outT + ((long)b * nf + feat0) * SEQ + tl;
          st_pair16(p0, p0 + (long)16 * SEQ, cvt4(acc[m >> 2][n2][m & 3][0]), cvt4(acc[m >> 2][n2][m & 3][1]), fq); __builtin_amdgcn_sched_barrier(0);
        }
    } else {
      if (WHICH == 1) {
        const float* xin = (layer == 0) ? p->x : p->xres;
#pragma unroll
        for (int mp = 0; mp < 4; ++mp) {
          float4 xv[2][4];
#pragma unroll
          for (int mi = 0; mi < 2; ++mi)
#pragma unroll
            for (int n = 0; n < 4; ++n) {
              const int m = mp * 2 + mi;
              const long tok = tm * 256 + (n >> 1) * 128 + wc * 32 + (n & 1) * 16 + fr;
              xv[mi][n] = *(const float4*)(xin + tok * DM + tn * 256 + (m >> 2) * 128 + wr * 64 + (m & 3) * 16 + fq * 4);
            }
#pragma unroll
          for (int mi = 0; mi < 2; ++mi)
#pragma unroll
            for (int n = 0; n < 4; ++n) {
              const int m = mp * 2 + mi;
              const long tok = tm * 256 + (n >> 1) * 128 + wc * 32 + (n & 1) * 16 + fr;
              const long o = tok * DM + tn * 256 + (m >> 2) * 128 + wr * 64 + (m & 3) * 16 + fq * 4;
              const f32x4 a = acc[m >> 2][n >> 1][m & 3][n & 1];
              float4 r; r.x = ALPHA_F * xv[mi][n].x + a[0]; r.y = ALPHA_F * xv[mi][n].y + a[1]; r.z = ALPHA_F * xv[mi][n].z + a[2]; r.w = ALPHA_F * xv[mi][n].w + a[3];
              *(float4*)(p->xres + o) = r;
            }
          __builtin_amdgcn_sched_barrier(0);
        }
      } else if (WHICH == 0 && tn < 16) {
        const bool isk = tn >= 8; const int h = tn & 7;
        const float lg = lg2gamma(h);
        h16* outn = isk ? p->kh : p->qh;
        const float sc = isk ? 0.0625f : 1.0f;
#pragma unroll
        for (int m = 0; m < 8; ++m)
#pragma unroll
          for (int n2 = 0; n2 < 2; ++n2) {
            const int f0 = (m >> 2) * 128 + wr * 64 + (m & 3) * 16 + fq * 4;
            f32x4 rr[2];
#pragma unroll
            for (int q = 0; q < 2; ++q) {
              const int idx = n2 * 128 + wc * 32 + q * 16 + fr;
              const long tok = tm * 256 + idx;
              const float4 c = *(const float4*)(p->cs + tok * 256 + f0);
              const f32x4 a = acc[m >> 2][n2][m & 3][q];
              f32x4 r;
              r[0] = (a[0] * c.x - a[1] * c.y) * sc; r[1] = (a[0] * c.y + a[1] * c.x) * sc;
              r[2] = (a[2] * c.z - a[3] * c.w) * sc; r[3] = (a[2] * c.w + a[3] * c.z) * sc;
              rr[q] = r;
              if (isk) {
                const float dk = exp2f(lg * (float)(255 - idx));
                const long tl = (tm & 15) * 256 + idx;
                h16* kd = p->kdT + ((long)b * 2048 + h * 256 + f0) * SEQ + tl;
                kd[0] = (h16)(r[0] * dk); kd[SEQ] = (h16)(r[1] * dk); kd[2 * SEQ] = (h16)(r[2] * dk); kd[3 * SEQ] = (h16)(r[3] * dk);
              }
            }
            h16* p0 = outn + ((long)tm * 256 + n2 * 128 + wc * 32 + fr) * 2048 + h * 256 + f0;
            st_pair16(p0, p0 + 16 * 2048, cvt4(rr[0]), cvt4(rr[1]), fq);
          }
      } else {
        h16* outn; long ldo; int col0; float sc = 1.f;
        if (WHICH == 0) { outn = p->zh; ldo = 4096; col0 = (tn - 32) * 256; }
        else if (WHICH == 2) { outn = p->proj; ldo = NSA_LD; col0 = tn * 256; if (tn < 12) sc = 0.07216878364870322f * LOG2E; }
        else { outn = p->kvh; ldo = KV_LD; col0 = tn * 256; }
#pragma unroll
        for (int m = 0; m < 8; ++m)
#pragma unroll
          for (int n2 = 0; n2 < 2; ++n2) {
            const long tok0 = tm * 256 + n2 * 128 + wc * 32 + fr;
            const int f0 = col0 + (m >> 2) * 128 + wr * 64 + (m & 3) * 16 + fq * 4;
            h16* p0 = outn + tok0 * ldo + f0;
            st_pair16(p0, p0 + 16 * ldo, cvt4(acc[m >> 2][n2][m & 3][0] * sc), cvt4(acc[m >> 2][n2][m & 3][1] * sc), fq); __builtin_amdgcn_sched_barrier(0);
          }
      }
    }
  }
}

template <int WHICH>
__device__ __forceinline__ void proj_unit(PP p, int layer, int i, int& tn, int& tm, bool& tr, const h16*& Pp, const h16*& Qp) {
  const int K = (WHICH == 1 && layer < 2) ? 4096 : 2048;
  const h16* Wt = (WHICH == 1) ? p->wB : (WHICH == 2) ? (p->wA + (long)3840 * 2048) : p->wA;
  const h16* A = (WHICH == 1) ? (layer < 2 ? p->Obuf : p->mixed) : p->xh;
  tm = i % 32;
  if (WHICH == 0) { tn = i / 32; tr = (tn >= 16 && tn < 32); }
  else if (WHICH == 3) { if (i < 352) { const int j = i / 32; tn = j < 8 ? j : j + 2; tr = false; } else { const int j = (i - 352) / 32; tn = j < 2 ? 8 + j : 11 + j; tr = true; } }
  else { tn = i / 32; tr = false; }
  const h16* wt = Wt + (long)tn * 256 * K; const h16* at = A + (long)tm * 256 * K;
  Pp = tr ? at : wt; Qp = tr ? wt : at;
}
template <int WHICH>
__device__ __forceinline__ void phase_proj(PP p, int layer, LAS char* shm, int bid, int nb) {
  constexpr int NU = ((WHICH == 0) ? 48 : (WHICH == 1) ? 8 : (WHICH == 2) ? 37 : 15) * 32;
  const int K = (WHICH == 1 && layer < 2) ? 4096 : 2048;
  const int nt = K / 64;
  if (bid >= NU) return;
  constexpr int HTB = 128 * 64 * 2;
#define SA8(b, h) (shm + ((b) * 2 + (h)) * HTB)
#define SB8(b, h) (shm + (4 + (b) * 2 + (h)) * HTB)
  const int tid = opaque_tid();
  const int wid = tid >> 6, lane = tid & 63, wr = wid >> 2, wc = wid & 3, fr = lane & 15, fq = lane >> 4;
  int oo[2];
#pragma unroll
  for (int i = 0; i < 2; ++i) { int R, C; stage_rc(tid * 16 + i * 8192, R, C); oo[i] = R * K + C; }
  const h16 *cP, *cQ, *nP, *nQ; int tn, tm, ntn, ntm; bool tr, ntr;
  proj_unit<WHICH>(p, layer, bid, tn, tm, tr, cP, cQ);
#define STG(P_, base_c, base_n, half, kt) do { const h16* g_ = (((kt) < nt) ? (base_c) + (long)(kt) * 64 : (base_n) + (long)((kt) - nt) * 64) + (long)(half) * 128 * K; \
    _Pragma("unroll") for (int i_ = 0; i_ < 2; ++i_) __builtin_amdgcn_global_load_lds((const unsigned*)(g_ + oo[i_]), (LAS unsigned*)((P_) + wid * 1024 + i_ * 8192), 16, 0, 0); } while (0)
#define STAGE8A(P_, half, kt) STG(P_, cP, nP, half, kt)
#define STAGE8B(P_, half, kt) STG(P_, cQ, nQ, half, kt)
#define LDA8(dst, b, h) _Pragma("unroll") for (int m = 0; m < 4; ++m) _Pragma("unroll") for (int k = 0; k < 2; ++k) \
    dst[m][k] = *(const LAS h16x8*)(SA8(b, h) + lds_byte(wr * 64 + m * 16 + fr, k * 32 + fq * 8))
#define LDB8(dst, b, h) _Pragma("unroll") for (int n = 0; n < 2; ++n) _Pragma("unroll") for (int k = 0; k < 2; ++k) \
    dst[n][k] = *(const LAS h16x8*)(SB8(b, h) + lds_byte(wc * 32 + n * 16 + fr, k * 32 + fq * 8))
#define MMA8(ai, bj, At_, Bt_) do { __builtin_amdgcn_s_setprio(1); \
    _Pragma("unroll") for (int m = 0; m < 4; ++m) _Pragma("unroll") for (int n = 0; n < 2; ++n) _Pragma("unroll") for (int k = 0; k < 2; ++k) \
      acc[ai][bj][m][n] = __builtin_amdgcn_mfma_f32_16x16x32_f16(At_[m][k], Bt_[n][k], acc[ai][bj][m][n], 0, 0, 0); \
    __builtin_amdgcn_s_setprio(0); } while (0)
#define ZACC() do { _Pragma("unroll") for (int a_ = 0; a_ < 2; ++a_) _Pragma("unroll") for (int b_ = 0; b_ < 2; ++b_) _Pragma("unroll") for (int m_ = 0; m_ < 4; ++m_) { \
    acc[a_][b_][m_][0] = (f32x4){0.f, 0.f, 0.f, 0.f}; acc[a_][b_][m_][1] = (f32x4){0.f, 0.f, 0.f, 0.f}; } } while (0)
  f32x4 acc[2][2][4][2];
  h16x8 At[4][2], B0[2][2], B1[2][2];
  ZACC();
  nP = cP; nQ = cQ;
  WAIT_V8(0);
  STAGE8B(SB8(0, 0), 0, 0); STAGE8A(SA8(0, 0), 0, 0);
  STAGE8B(SB8(0, 1), 1, 0); STAGE8A(SA8(0, 1), 1, 0);
  if (wr == 1) BAR8;
  WAIT_V8(4); BAR8;
  STAGE8B(SB8(1, 0), 0, 1); STAGE8A(SA8(1, 0), 0, 1); STAGE8B(SB8(1, 1), 1, 1);
  WAIT_V8(6); BAR8;
#pragma unroll 1
  for (int u = bid; u < NU; u += nb) {
    if (u + nb < NU) proj_unit<WHICH>(p, layer, u + nb, ntn, ntm, ntr, nP, nQ);
    else { nP = cP; nQ = cQ; ntn = tn; ntm = tm; ntr = tr; }
#pragma unroll 1
    for (int t = 0; t < nt; t += 2) {
      LDB8(B0, 0, 0); SCHED8; LDA8(At, 0, 0); STAGE8A(SA8(1, 1), 1, t + 1);
      WAIT_L8(8); BAR8; WAIT_L8(0); MMA8(0, 0, At, B0); BAR8; SCHED8;
      LDB8(B1, 0, 1); STAGE8B(SB8(0, 0), 0, t + 2);
      BAR8; WAIT_L8(0); MMA8(0, 1, At, B1); BAR8;
      LDA8(At, 0, 1); STAGE8A(SA8(0, 0), 0, t + 2);
      BAR8; WAIT_L8(0); MMA8(1, 0, At, B0); BAR8; SCHED8;
      STAGE8B(SB8(0, 1), 1, t + 2);
      WAIT_V8(6); BAR8; MMA8(1, 1, At, B1); BAR8;
      LDB8(B0, 1, 0); SCHED8; LDA8(At, 1, 0); STAGE8A(SA8(0, 1), 1, t + 2);
      WAIT_L8(8); BAR8; WAIT_L8(0); MMA8(0, 0, At, B0); BAR8; SCHED8;
      LDB8(B1, 1, 1); STAGE8B(SB8(1, 0), 0, t + 3);
      BAR8; WAIT_L8(0); MMA8(0, 1, At, B1); BAR8;
      LDA8(At, 1, 1); STAGE8A(SA8(1, 0), 0, t + 3);
      BAR8; WAIT_L8(0); MMA8(1, 0, At, B0); BAR8; SCHED8;
      STAGE8B(SB8(1, 1), 1, t + 3);
      WAIT_V8(6); BAR8; MMA8(1, 1, At, B1); BAR8;
    }
    if (tr) proj_epi<WHICH, true>(p, layer, acc, tn, tm); else proj_epi<WHICH, false>(p, layer, acc, tn, tm);
    ZACC();
    cP = nP; cQ = nQ; tn = ntn; tm = ntm; tr = ntr;
  }
  WAIT_V8(0);
  if (wr == 0) BAR8;
  __syncthreads();
#undef SA8
#undef SB8
#undef STG
#undef STAGE8A
#undef STAGE8B
#undef LDA8
#undef LDB8
#undef MMA8
#undef ZACC
}

__device__ __forceinline__ void phase_retB(PP p, LAS char* shm, int bid, int nb) {
  for (int t = bid; t < 768; t += nb) {
    const int tid = opaque_tid(), wid = tid >> 6, lane = tid & 63, wr = wid >> 2, wc = wid & 3, fr = lane & 15, fq = lane >> 4;
    f32x4 acc[8][4];
    zero_acc(acc);
    GOp g; g.nk = 4; g.kt0 = 0; g.ksegP = 1 << 28; g.segP = 0;
    if (t < 512) {
      const int et = t & 1, c = (t >> 1) & 15, bh = t >> 5, b = bh >> 3, h = bh & 7;
      g.P = p->kdT + ((long)b * 2048 + h * 256) * SEQ + c * 256; g.ldp = SEQ;
      g.Q = p->vT + ((long)b * 4096 + h * 512 + et * 256) * SEQ + c * 256; g.ldq = SEQ;
      gemm256(shm, g, acc, tid);
      h16* st = p->St + ((long)(bh * 16 + c) * 512 + et * 256) * 256;
#pragma unroll
      for (int m = 0; m < 8; ++m)
#pragma unroll
        for (int n = 0; n < 4; ++n) {
          const int e = wc * 64 + n * 16 + fr, d0 = wr * 128 + m * 16 + fq * 4;
          *(h16x4*)(st + (long)e * 256 + d0) = cvt4(acc[m][n]); __builtin_amdgcn_sched_barrier(0);
        }
    } else {
      const int u = t - 512, c = u & 15, bh = u >> 4, b = bh >> 3, h = bh & 7;
      const float lg = lg2gamma(h);
      g.P = p->kh + ((long)b * SEQ + c * 256) * 2048 + h * 256; g.ldp = 2048;
      g.Q = p->qh + ((long)b * SEQ + c * 256) * 2048 + h * 256; g.ldq = 2048;
      gemm256(shm, g, acc, tid);
      h16* pb = p->Pbuf + ((long)bh * SEQ + c * 256) * 256;
#pragma unroll
      for (int m = 0; m < 8; ++m)
#pragma unroll
        for (int n = 0; n < 4; ++n) {
          const int qi = wc * 64 + n * 16 + fr, k0 = wr * 128 + m * 16 + fq * 4;
          f32x4 r;
#pragma unroll
          for (int j = 0; j < 4; ++j) { const int rel = qi - (k0 + j); r[j] = rel >= 0 ? acc[m][n][j] * exp2f(lg * (float)rel) : 0.f; }
          *(h16x4*)(pb + (long)qi * 256 + k0) = cvt4(r); __builtin_amdgcn_sched_barrier(0);
        }
    }
  }
}

__device__ __forceinline__ void phase_retC(PP p, int bid, int nb) {
  const int tid = threadIdx.x;
  for (int it = bid * NTHR + tid; it < 16 * 16384; it += nb * NTHR) {
    const int bh = it >> 14, idx = (it & 16383) * 8, h = bh & 7;
    const float dc = exp2f(lg2gamma(h) * 256.f);
    h16* base = p->St + (long)bh * 16 * 131072 + idx;
    h16x8 u[16];
#pragma unroll
    for (int c = 0; c < 16; ++c) u[c] = *(const h16x8*)(base + (long)c * 131072);
    float s[8];
#pragma unroll
    for (int j = 0; j < 8; ++j) s[j] = 0.f;
#pragma unroll
    for (int c = 0; c < 16; ++c) {
      h16x8 o;
#pragma unroll
      for (int j = 0; j < 8; ++j) { o[j] = (h16)s[j]; s[j] = s[j] * dc + (float)u[c][j]; }
      *(h16x8*)(base + (long)c * 131072) = o;
    }
  }
}

__device__ __forceinline__ float wave_sum(float v);
__device__ __forceinline__ void phase_retD(PP p, LAS char* shm, int bid, int nb) {
  for (int u = bid; u < 256; u += nb) {
    const int c = u & 15, bh = u >> 4, b = bh >> 3, h = bh & 7;
    const float lg = lg2gamma(h);
    for (int et = 0; et < 2; ++et) {
      const int tid = opaque_tid(), wid = tid >> 6, lane = tid & 63, wr = wid >> 2, wc = wid & 3, fr = lane & 15, fq = lane >> 4;
      f32x4 acc[8][4];
      zero_acc(acc);
      GOp g; g.nk = 4; g.kt0 = 0; g.ksegP = 1 << 28; g.segP = 0;
      g.P = p->St + ((long)(bh * 16 + c) * 512 + et * 256) * 256; g.ldp = 256;
      g.Q = p->qh + ((long)b * SEQ + c * 256) * 2048 + h * 256; g.ldq = 2048;
      gemm256(shm, g, acc, tid);
#pragma unroll
      for (int n = 0; n < 4; ++n) {
        const float dq = exp2f(lg * (float)(wc * 64 + n * 16 + fr + 1));
#pragma unroll
        for (int m = 0; m < 8; ++m) acc[m][n] = acc[m][n] * dq;
      }
      g.P = p->vT + ((long)b * 4096 + h * 512 + et * 256) * SEQ + c * 256; g.ldp = SEQ;
      g.Q = p->Pbuf + ((long)bh * SEQ + c * 256) * 256; g.ldq = 256;
      gemm256(shm, g, acc, tid);
#pragma unroll
      for (int m = 0; m < 8; ++m)
#pragma unroll
        for (int n = 0; n < 4; ++n) {
          const long tok = (long)b * SEQ + c * 256 + wc * 64 + n * 16 + fr;
          const int e0 = h * 512 + et * 256 + wr * 128 + m * 16 + fq * 4;
          *(h16x4*)(p->Obuf + tok * 4096 + e0) = cvt4(acc[m][n]); __builtin_amdgcn_sched_barrier(0);
        }
    }
    asm volatile("s_waitcnt vmcnt(0)" ::: "memory");
    __syncthreads();
    {
      const int tid = opaque_tid(), wid = tid >> 6, lane = tid & 63;
      for (int r = wid; r < 256; r += 8) {
        const long off = ((long)b * SEQ + c * 256 + r) * 4096 + h * 512 + lane * 8;
        h16x8 ov = *(const h16x8*)(p->Obuf + off), zv = *(const h16x8*)(p->zh + off);
        float o[8]; float s = 0.f;
#pragma unroll
        for (int j = 0; j < 8; ++j) { o[j] = (float)ov[j]; s += o[j]; }
        const float mu = wave_sum(s) * (1.f / 512.f);
        float q = 0.f;
#pragma unroll
        for (int j = 0; j < 8; ++j) { const float d = o[j] - mu; q += d * d; }
        const float rstd = rsqrtf(wave_sum(q) * (1.f / 512.f) + LN_EPS_F);
        h16x8 rr;
#pragma unroll
        for (int j = 0; j < 8; ++j) rr[j] = (h16)((o[j] - mu) * rstd * siluf_((float)zv[j]));
        *(h16x8*)(p->Obuf + off) = rr;
      }
    }
    __syncthreads();
  }
}

__device__ __forceinline__ float wave_sum(float v) {
#pragma unroll
  for (int o = 32; o >= 1; o >>= 1) v += __shfl_xor(v, o);
  return v;
}

__device__ __forceinline__ void phase_retE(PP p, int bid, int nb) {
  const int tid = threadIdx.x, wid = tid >> 6, lane = tid & 63;
  for (int row = bid * 8 + wid; row < NTOK * 8; row += nb * 8) {
    const long off = (long)row * 512 + lane * 8;
    h16x8 ov = *(const h16x8*)(p->Obuf + off), zv = *(const h16x8*)(p->zh + off);
    float o[8]; float s = 0.f;
#pragma unroll
    for (int j = 0; j < 8; ++j) { o[j] = (float)ov[j]; s += o[j]; }
    const float mu = wave_sum(s) * (1.f / 512.f);
    float q = 0.f;
#pragma unroll
    for (int j = 0; j < 8; ++j) { const float d = o[j] - mu; q += d * d; }
    const float rstd = rsqrtf(wave_sum(q) * (1.f / 512.f) + LN_EPS_F);
    h16x8 r;
#pragma unroll
    for (int j = 0; j < 8; ++j) r[j] = (h16)((o[j] - mu) * rstd * siluf_((float)zv[j]));
    *(h16x8*)(p->Obuf + off) = r;
  }
}

__device__ __forceinline__ void phase_ln(PP p, int layer, LAS char* shm, int bid, int nb) {
  const int tid = threadIdx.x, wid = tid >> 6, lane = tid & 63;
  const float* gw = p->ln_g[layer]; const float* bw = p->ln_b[layer];
  float* dst = (layer == 3) ? p->out : p->xres;
  for (int row = bid * 8 + wid; row < NTOK; row += nb * 8) {
    const float* src = p->xres + (long)row * DM;
    float4 v[8]; float s = 0.f;
#pragma unroll
    for (int i = 0; i < 8; ++i) { v[i] = *(const float4*)(src + i * 256 + lane * 4); s += v[i].x + v[i].y + v[i].z + v[i].w; }
    const float mu = wave_sum(s) * (1.f / 2048.f);
    float q = 0.f;
#pragma unroll
    for (int i = 0; i < 8; ++i) { float a = v[i].x - mu, b = v[i].y - mu, c = v[i].z - mu, d = v[i].w - mu; q += a * a + b * b + c * c + d * d; }
    const float rstd = rsqrtf(wave_sum(q) * (1.f / 2048.f) + LN_EPS_F);
#pragma unroll
    for (int i = 0; i < 8; ++i) {
      const int col = i * 256 + lane * 4;
      const float4 gg = *(const float4*)(gw + col), bb = *(const float4*)(bw + col);
      float4 r; r.x = (v[i].x - mu) * rstd * gg.x + bb.x; r.y = (v[i].y - mu) * rstd * gg.y + bb.y; r.z = (v[i].z - mu) * rstd * gg.z + bb.z; r.w = (v[i].w - mu) * rstd * gg.w + bb.w;
      *(float4*)(dst + (long)row * DM + col) = r;
      h16x4 hv; hv[0] = (h16)r.x; hv[1] = (h16)r.y; hv[2] = (h16)r.z; hv[3] = (h16)r.w;
      *(h16x4*)(p->xh + (long)row * DM + col) = hv;
    }
  }
  __syncthreads();
  int tb = 0;
  if (layer == 0) {
    conv_job(shm, p->ret_w_in[1], 2048, 12288, 12288, p->wA, tb, bid, nb);
    conv_job(shm, p->ret_w_out[1], 4096, 2048, 2048, p->wB, tb, bid, nb);
  } else if (layer == 1) {
    conv_job(shm, p->w_kv, 2048, 3840, 3840, p->wA, tb, bid, nb);
    conv_job(shm, p->nsa_w_in[0], 2048, 9264, 9472, p->wA + (long)3840 * 2048, tb, bid, nb);
    conv_job(shm, p->nsa_w_out[0], 2048, 2048, 2048, p->wB, tb, bid, nb);
  } else if (layer == 2) {
    conv_job(shm, p->nsa_w_in[1], 2048, 9264, 9472, p->wA + (long)3840 * 2048, tb, bid, nb);
    conv_job(shm, p->nsa_w_out[1], 2048, 2048, 2048, p->wB, tb, bid, nb);
  }
}

__device__ __forceinline__ void phase_cmp1(PP p, LAS char* shm, int bid, int nb) {
  for (int t = bid; t < 256; t += nb) {
    const int tid = opaque_tid(), wid = tid >> 6, lane = tid & 63, wr = wid >> 2, wc = wid & 3, fr = lane & 15, fq = lane >> 4;
    const int kv = t >> 7, bg = (t >> 4) & 7, sp = t & 15, b = bg >> 2, gq = bg & 3;
    f32x4 acc[8][4];
    zero_acc(acc);
    GOp g;
    g.ldp = 16 * KV_LD; g.segP = KV_LD;
    if (kv == 0) { g.P = p->kvh + (long)b * SEQ * KV_LD + gq * 192; g.ksegP = 3; g.nk = 6; g.kt0 = 6 * sp; g.Q = p->ck1T; g.ldq = 6144; }
    else { g.P = p->kvh + (long)b * SEQ * KV_LD + 768 + gq * 128; g.ksegP = 2; g.nk = 4; g.kt0 = 4 * sp; g.Q = p->cv1T; g.ldq = 4096; }
    gemm256(shm, g, acc, tid);
    float* pt = p->part + (long)t * 65536;
#pragma unroll
    for (int m = 0; m < 8; ++m)
#pragma unroll
      for (int n = 0; n < 4; ++n) {
        *(f32x4*)(pt + (long)(wc * 64 + n * 16 + fr) * 256 + wr * 128 + m * 16 + fq * 4) = acc[m][n]; __builtin_amdgcn_sched_barrier(0);
      }
  }
}

__device__ __forceinline__ void phase_cmp2(PP p, LAS char* shm, int bid, int nb) {
  const int tid = threadIdx.x;
  LAS float* hid = (LAS float*)shm;
  for (int t = bid; t < 512; t += nb) {
    const int kv = t >> 8, bg = (t >> 5) & 7, ng = t & 31;
    const float* pt = p->part + (long)(kv * 128 + bg * 16) * 65536;
    const float* bias = p->biasp + (kv ? 32 * 256 : 0);
#pragma unroll
    for (int i = 0; i < 4; ++i) {
      const int e = tid + i * 512, nl = e & 7, hh = e >> 3;
      float s = 0.f;
      for (int pp = 0; pp < 32; ++pp) s += bias[pp * 256 + hh];
      for (int sp = 0; sp < 16; ++sp) s += pt[(long)sp * 65536 + (long)hh * 256 + ng * 8 + nl];
      hid[nl * 256 + hh] = siluf_(s);
    }
    __syncthreads();
    if (kv == 0) {
#pragma unroll
      for (int i = 0; i < 3; ++i) {
        const int o = tid + i * 512, nl = o / 192, j = o % 192, n = ng * 8 + nl;
        float s = 0.f;
        for (int hh = 0; hh < 256; ++hh) s += hid[nl * 256 + hh] * p->w_ck2[hh * 192 + j];
        p->kc[((long)bg * 256 + n) * 192 + j] = (n < 255) ? (h16)s : (h16)0.f;
      }
    } else {
#pragma unroll
      for (int i = 0; i < 2; ++i) {
        const int o = tid + i * 512, nl = o >> 7, j = o & 127, n = ng * 8 + nl;
        float s = 0.f;
        for (int hh = 0; hh < 256; ++hh) s += hid[nl * 256 + hh] * p->w_cv2[hh * 128 + j];
        p->vcT[((long)bg * 128 + j) * 256 + n] = (n < 255) ? (h16)s : (h16)0.f;
      }
    }
    __syncthreads();
  }
}

__device__ __forceinline__ void phase_select(PP p, LAS char* shm, int bid, int nb) {
  LAS float* psel = (LAS float*)(shm + 102400);
  for (int u = bid; u < 1024; u += nb) {
    const int tid = opaque_tid(), wid = tid >> 6, lane = tid & 63, fr = lane & 15, fq = lane >> 4;
    const int r = wid >> 1, th = wid & 1;
    const int bg = u >> 7, tile = u & 127, b = bg >> 2, gq = bg & 3, t0 = tile * 32;
    const h16* kcb = p->kc + (long)bg * 256 * 192;
    { const int row = tid >> 1, c0 = (tid & 1) * 12;
      const h16* src = kcb + row * 192 + c0 * 8; LAS char* dl = shm + row * 400 + c0 * 16;
#pragma unroll
      for (int i = 0; i < 12; ++i) *(LAS u32x4*)(dl + i * 16) = *(const u32x4*)(src + i * 8); }
    const int tq = t0 + th * 16 + fr;
    const h16* qrow = p->proj + ((long)b * SEQ + tq) * NSA_LD + (gq * 4 + r) * 192 + fq * 8;
    h16x8 qf[6];
#pragma unroll
    for (int ks = 0; ks < 6; ++ks) qf[ks] = *(const h16x8*)(qrow + ks * 32);
    __syncthreads();
    f32x4 s[16];
#pragma unroll
    for (int mt = 0; mt < 16; ++mt) s[mt] = (f32x4){0.f, 0.f, 0.f, 0.f};
#pragma unroll
    for (int ks = 0; ks < 6; ++ks)
#pragma unroll
      for (int mt = 0; mt < 16; ++mt) {
        const h16x8 kf = *(const LAS h16x8*)(shm + (mt * 16 + fr) * 400 + (ks * 32 + fq * 8) * 2);
        s[mt] = __builtin_amdgcn_mfma_f32_16x16x32_f16(kf, qf[ks], s[mt], 0, 0, 0);
      }
    float mx = -1e30f;
#pragma unroll
    for (int mt = 0; mt < 16; ++mt)
#pragma unroll
      for (int j = 0; j < 4; ++j) {
        const int n = mt * 16 + fq * 4 + j;
        const bool valid = (n < 255) && (16 * n + 31 <= tq);
        const float v = valid ? s[mt][j] : -1e30f;
        s[mt][j] = v; mx = fmaxf(mx, v);
      }
    mx = fmaxf(mx, __shfl_xor(mx, 16)); mx = fmaxf(mx, __shfl_xor(mx, 32));
    float l = 0.f;
#pragma unroll
    for (int mt = 0; mt < 16; ++mt)
#pragma unroll
      for (int j = 0; j < 4; ++j) { const float pv = (s[mt][j] > -1e29f) ? __builtin_amdgcn_exp2f(s[mt][j] - mx) : 0.f; s[mt][j] = pv; l += pv; }
    l += __shfl_xor(l, 16); l += __shfl_xor(l, 32);
    const float inv = l > 0.f ? 1.f / l : 0.f;
#pragma unroll
    for (int mt = 0; mt < 16; ++mt) {
      const float own = s[mt][0] + 2.f * (s[mt][1] + s[mt][2] + s[mt][3]);
      const float x1 = __shfl(s[mt][0], (lane + 16) & 63);
      const float nx = (mt < 15) ? s[(mt + 1) & 15][0] : 0.f;
      const float x2 = __shfl(nx, (lane + 16) & 63);
      const float val = (own + (fq < 3 ? x1 : x2)) * inv;
      psel[(r * 32 + th * 16 + fr) * 64 + mt * 4 + fq] = val;
    }
    __syncthreads();
#pragma unroll
    for (int i = 0; i < 4; ++i) {
      const int tl = wid * 4 + i, t = t0 + tl, cur = t >> 6, j = lane;
      const float ps = psel[(0 * 32 + tl) * 64 + j] + psel[(1 * 32 + tl) * 64 + j] + psel[(2 * 32 + tl) * 64 + j] + psel[(3 * 32 + tl) * 64 + j];
      const bool forced = (j == 0) || (j == cur) || (j == cur - 1);
      const float score = forced ? 1e9f : (j <= cur ? ps : -1.0f);
      int rank = 0;
      for (int k = 0; k < 64; ++k) { const float sk = __shfl(score, k); rank += (sk > score || (sk == score && k < j)) ? 1 : 0; }
      const u64 mk = __ballot(rank < 16);
      if (lane == 0) p->masks[(long)bg * SEQ + t] = mk;
    }
    __syncthreads();
  }
}


__device__ __forceinline__ float xr_max(float v) {
  const unsigned u = __float_as_uint(v);
  auto r = __builtin_amdgcn_permlane16_swap(u, u, false, false);
  const float a = fmaxf(__uint_as_float(r[0]), __uint_as_float(r[1]));
  const unsigned ua = __float_as_uint(a);
  auto r2 = __builtin_amdgcn_permlane32_swap(ua, ua, false, false);
  return fmaxf(__uint_as_float(r2[0]), __uint_as_float(r2[1]));
}
__device__ __forceinline__ float xr_sum(float v) {
  const unsigned u = __float_as_uint(v);
  auto r = __builtin_amdgcn_permlane16_swap(u, u, false, false);
  const float a = __uint_as_float(r[0]) + __uint_as_float(r[1]);
  const unsigned ua = __float_as_uint(a);
  auto r2 = __builtin_amdgcn_permlane32_swap(ua, ua, false, false);
  return __uint_as_float(r2[0]) + __uint_as_float(r2[1]);
}
constexpr int FK_OFF = 0, FV_OFF = 25600, FQ_OFF = 44032;
__device__ __forceinline__ void flash_branch(PP p, LAS char* shm, int branch, int b, int gq, int t0, const h16x8 (&qf)[2][6]) {
  const int tid = opaque_tid(), wid = tid >> 6, lane = tid & 63, fr = lane & 15, fq = lane >> 4;
  const int r = wid >> 1, th = wid & 1, bg = b * 4 + gq, hd = gq * 4 + r;
  const int cur = t0 >> 6;
  const h16* Kb; long ldk; const h16* VTb; long ldvt; int jlo, jhi;
  if (branch == 0) { Kb = p->kc + (long)bg * 256 * 192; ldk = 192; VTb = p->vcT + (long)bg * 128 * 256; ldvt = 256; jlo = 0; jhi = (t0 + 32) >> 10; if (jhi > 3) jhi = 3; }
  else if (branch == 1) { Kb = p->kvh + (long)b * SEQ * KV_LD + 1280 + gq * 192; ldk = KV_LD; VTb = p->vselT + ((long)b * 512 + gq * 128) * SEQ; ldvt = SEQ; jlo = 0; jhi = cur; }
  else { Kb = p->kvh + (long)b * SEQ * KV_LD + 2560 + gq * 192; ldk = KV_LD; VTb = p->vwinT + ((long)b * 512 + gq * 128) * SEQ; ldvt = SEQ; jlo = cur - 8 > 0 ? cur - 8 : 0; jhi = cur; }
  int tq[2]; u64 mk[2];
#pragma unroll
  for (int nt = 0; nt < 2; ++nt) { tq[nt] = t0 + th * 32 + nt * 16 + fr; mk[nt] = (branch == 1) ? p->masks[(long)bg * SEQ + tq[nt]] : 0ull; }
  f32x4 O[8][2];
#pragma unroll
  for (int et = 0; et < 8; ++et) { O[et][0] = (f32x4){0.f, 0.f, 0.f, 0.f}; O[et][1] = (f32x4){0.f, 0.f, 0.f, 0.f}; }
  float mrun[2] = {-1e30f, -1e30f}, lrun[2] = {0.f, 0.f};
  int koff[4], voff[3];
#pragma unroll
  for (int i = 0; i < 4; ++i) { const int c = (wid + 8 * i) * 64 + lane, row = c / 25, ch = c % 25; koff[i] = row * (int)ldk + (ch < 24 ? ch : 23) * 8; }
#pragma unroll
  for (int i = 0; i < 3; ++i) { const int c = (wid + 8 * i) * 64 + lane, e = c / 9, ch = c % 9; voff[i] = e * (int)ldvt + (ch < 8 ? ch : 7) * 8; }
#define F_STAGE(j, buf) do { \
    const h16* kb_ = Kb + (long)(j) * 64 * ldk; const h16* vb_ = VTb + (long)(j) * 64; LAS char* lb_ = shm + (buf) * 44032; \
    _Pragma("unroll") for (int i = 0; i < 4; ++i) if (wid + 8 * i < 25) __builtin_amdgcn_global_load_lds((const unsigned*)(kb_ + koff[i]), (LAS unsigned*)(lb_ + FK_OFF + (wid + 8 * i) * 1024), 16, 0, 0); \
    _Pragma("unroll") for (int i = 0; i < 3; ++i) if (wid + 8 * i < 18) __builtin_amdgcn_global_load_lds((const unsigned*)(vb_ + voff[i]), (LAS unsigned*)(lb_ + FV_OFF + (wid + 8 * i) * 1024), 16, 0, 0); } while (0)
  F_STAGE(jlo, 0);
  asm volatile("s_waitcnt vmcnt(0)" ::: "memory");
  __syncthreads();
  for (int j = jlo; j <= jhi; ++j) {
    const int cb = (j - jlo) & 1;
    LAS char* lb = shm + cb * 44032;
    if (j + 1 <= jhi) F_STAGE(j + 1, cb ^ 1);
    f32x4 s[4][2];
#pragma unroll
    for (int mt = 0; mt < 4; ++mt) { s[mt][0] = (f32x4){0.f, 0.f, 0.f, 0.f}; s[mt][1] = (f32x4){0.f, 0.f, 0.f, 0.f}; }
#pragma unroll
    for (int ks = 0; ks < 6; ++ks) {
      const h16x8 q0 = qf[0][ks], q1 = qf[1][ks];
#pragma unroll
      for (int mt = 0; mt < 4; ++mt) {
        const h16x8 kf = *(const LAS h16x8*)(lb + FK_OFF + (mt * 16 + fr) * 400 + (ks * 32 + fq * 8) * 2);
        s[mt][0] = __builtin_amdgcn_mfma_f32_16x16x32_f16(kf, q0, s[mt][0], 0, 0, 0);
        s[mt][1] = __builtin_amdgcn_mfma_f32_16x16x32_f16(kf, q1, s[mt][1], 0, 0, 0);
      }
    }
    __builtin_amdgcn_sched_group_barrier(0x100, 4, 0);
#pragma unroll
    for (int i = 0; i < 20; ++i) { __builtin_amdgcn_sched_group_barrier(0x100, 1, 0); __builtin_amdgcn_sched_group_barrier(0x008, 2, 0); }
    __builtin_amdgcn_sched_group_barrier(0x008, 8, 0);
    h16x8 pf[2][2];
    const bool full = (branch == 0) || (branch == 1 && j == cur) || (branch == 2 && (j == cur || j == cur - 8));
#pragma unroll
    for (int nt = 0; nt < 2; ++nt) {
      if (full) {
#pragma unroll
        for (int mt = 0; mt < 4; ++mt)
#pragma unroll
          for (int jj = 0; jj < 4; ++jj) {
            const int key = j * 64 + mt * 16 + fq * 4 + jj;
            bool valid;
            if (branch == 0) valid = (key < 255) && (16 * key + 31 <= tq[nt]);
            else if (branch == 1) valid = ((mk[nt] >> j) & 1ull) && (key <= tq[nt]);
            else valid = (key <= tq[nt]) && (tq[nt] - key < 512);
            s[mt][nt][jj] = valid ? s[mt][nt][jj] : -1e30f;
          }
      } else if (branch == 1) {
        const bool selb = (mk[nt] >> j) & 1ull;
#pragma unroll
        for (int mt = 0; mt < 4; ++mt)
#pragma unroll
          for (int jj = 0; jj < 4; ++jj) s[mt][nt][jj] = selb ? s[mt][nt][jj] : -1e30f;
      }
      float mx = fmaxf(fmaxf(s[0][nt][0], s[0][nt][1]), fmaxf(s[0][nt][2], s[0][nt][3]));
#pragma unroll
      for (int mt = 1; mt < 4; ++mt) mx = fmaxf(mx, fmaxf(fmaxf(s[mt][nt][0], s[mt][nt][1]), fmaxf(s[mt][nt][2], s[mt][nt][3])));
      mx = xr_max(mx);
      const float mold = mrun[nt];
      const float mnew = fmaxf(mold, mx);
      const float msafe = fmaxf(mnew, -1e29f);
      mrun[nt] = mnew;
      float rs = 0.f;
#pragma unroll
      for (int mt = 0; mt < 4; ++mt)
#pragma unroll
        for (int jj = 0; jj < 4; ++jj) { const float pv = __builtin_amdgcn_exp2f(s[mt][nt][jj] - msafe); s[mt][nt][jj] = pv; rs += pv; }
      rs = xr_sum(rs);
      if (__builtin_amdgcn_ballot_w64(mnew > mold) != 0ull) {
        const float alpha = __builtin_amdgcn_exp2f(mold - mnew);
        lrun[nt] = lrun[nt] * alpha + rs;
#pragma unroll
        for (int et = 0; et < 8; ++et) O[et][nt] = O[et][nt] * alpha;
      } else {
        lrun[nt] += rs;
      }
#pragma unroll
      for (int k2 = 0; k2 < 2; ++k2)
#pragma unroll
        for (int jj = 0; jj < 4; ++jj) { pf[nt][k2][jj] = (h16)s[2 * k2][nt][jj]; pf[nt][k2][4 + jj] = (h16)s[2 * k2 + 1][nt][jj]; }
    }
#pragma unroll
    for (int et = 0; et < 8; ++et)
#pragma unroll
      for (int k2 = 0; k2 < 2; ++k2) {
        const LAS char* va = lb + FV_OFF + (et * 16 + fr) * 144 + (k2 * 32 + fq * 4) * 2;
        const h16x4 lo = *(const LAS h16x4*)va, hi = *(const LAS h16x4*)(va + 32);
        h16x8 vf; vf[0] = lo[0]; vf[1] = lo[1]; vf[2] = lo[2]; vf[3] = lo[3]; vf[4] = hi[0]; vf[5] = hi[1]; vf[6] = hi[2]; vf[7] = hi[3];
        O[et][0] = __builtin_amdgcn_mfma_f32_16x16x32_f16(vf, pf[0][k2], O[et][0], 0, 0, 0);
        O[et][1] = __builtin_amdgcn_mfma_f32_16x16x32_f16(vf, pf[1][k2], O[et][1], 0, 0, 0);
      }
    __builtin_amdgcn_sched_group_barrier(0x100, 4, 0);
#pragma unroll
    for (int i = 0; i < 14; ++i) { __builtin_amdgcn_sched_group_barrier(0x100, 2, 0); __builtin_amdgcn_sched_group_barrier(0x008, 2, 0); }
    __builtin_amdgcn_sched_group_barrier(0x008, 4, 0);
    asm volatile("s_waitcnt vmcnt(0)" ::: "memory");
    __syncthreads();
  }
#undef F_STAGE
#pragma unroll
  for (int nt = 0; nt < 2; ++nt) {
    const long tok = (long)b * SEQ + tq[nt];
    const h16* pr = p->proj + tok * NSA_LD;
    const float gt = sigmoidf_((float)pr[9216 + branch * 16 + hd]);
    const float inv = lrun[nt] > 0.f ? gt / lrun[nt] : 0.f;
#pragma unroll
    for (int et = 0; et < 8; ++et) {
      const int e0 = hd * 128 + et * 16 + fq * 4;
      const h16x4 zv = *(const h16x4*)(pr + 3072 + branch * 2048 + e0);
      h16* mp = p->mixed + tok * DM + e0;
      f32x4 r;
#pragma unroll
      for (int jj = 0; jj < 4; ++jj) r[jj] = O[et][nt][jj] * inv * siluf_((float)zv[jj]);
      if (branch != 0) { const h16x4 old = *(const h16x4*)mp; r[0] += (float)old[0]; r[1] += (float)old[1]; r[2] += (float)old[2]; r[3] += (float)old[3]; }
      *(h16x4*)mp = cvt4(r);
    }
  }
}

__device__ __forceinline__ void phase_attn(PP p, LAS char* shm, int bid, int nb) {
  for (int u0 = bid; u0 < 256; u0 += nb) {
    const int u = (nb == 256) ? ((u0 & 7) << 5 | (u0 >> 3)) : u0;
    const int bg = u >> 5, pr = u & 31, b = bg >> 2, gq = bg & 3;
    for (int half = 0; half < 2; ++half) {
      const int tile = half ? 63 - pr : pr, t0 = tile * 64;
      h16x8 qf[2][6];
      { const int tid = opaque_tid(), wid = tid >> 6, lane = tid & 63, fr = lane & 15, fq = lane >> 4, r = wid >> 1, th = wid & 1;
#pragma unroll
        for (int nt = 0; nt < 2; ++nt) {
          const h16* qrow = p->proj + ((long)b * SEQ + t0 + th * 32 + nt * 16 + fr) * NSA_LD + (gq * 4 + r) * 192 + fq * 8;
#pragma unroll
          for (int ks = 0; ks < 6; ++ks) qf[nt][ks] = *(const h16x8*)(qrow + ks * 32);
        } }
      flash_branch(p, shm, 0, b, gq, t0, qf);
      flash_branch(p, shm, 1, b, gq, t0, qf);
      flash_branch(p, shm, 2, b, gq, t0, qf);
    }
  }
}


#define XB_TMO      128
#define XB_XCNT(j)  (256  + 64 * (j))
#define XB_XSUB(j)  (1280 + 64 * (j))
#define XB_XGEN(j)  (2304 + 64 * (j))
#define XB_TOP      3328
#define XB_TOPGEN   3392
#define XCD_BAR_WORDS 3456
#define XB_SPIN_CAP (1u << 18)
__device__ __forceinline__ unsigned xb_ld(unsigned* p)              { return __hip_atomic_load(p, __ATOMIC_RELAXED, __HIP_MEMORY_SCOPE_AGENT); }
__device__ __forceinline__ unsigned xb_add(unsigned* p, unsigned v) { return __hip_atomic_fetch_add(p, v, __ATOMIC_RELAXED, __HIP_MEMORY_SCOPE_AGENT); }
__device__ __forceinline__ unsigned xb_xcc_id() { return (unsigned)__builtin_amdgcn_s_getreg((3 << 11) | 20) & 0xFu; }
#define XB_SPIN(cond, bar) do { unsigned _sp = 0; while (cond) { __builtin_amdgcn_s_sleep(1); \
    if ((++_sp & 255u) == 0u) { if (xb_ld(&(bar)[XB_TMO])) break; if (_sp > XB_SPIN_CAP) { atomicAdd(&(bar)[XB_TMO], 1u); break; } } } } while (0)
struct XcdBarrier { unsigned* bar; unsigned x; volatile LAS unsigned* st; };
__device__ __forceinline__ XcdBarrier xcd_barrier_post(unsigned* bar, volatile LAS unsigned* st) {
  XcdBarrier b; b.bar = bar; b.x = xb_xcc_id(); b.st = st;
  if (threadIdx.x == 0) (void)xb_add(&bar[XB_XCNT(b.x)], 1u);
  return b;
}
__device__ __forceinline__ void xcd_barrier_complete(unsigned* bar, unsigned x, unsigned& nloc, unsigned& nx) {
  const unsigned G = gridDim.x * gridDim.y * gridDim.z;
  unsigned sum, cnt, mine, sp = 0u;
  for (;;) {
    sum = 0u; cnt = 0u; mine = 0u;
#pragma unroll
    for (unsigned j = 0; j < 16; ++j) { const unsigned c = xb_ld(&bar[XB_XCNT(j)]); sum += c; cnt += (c > 0u) ? 1u : 0u; mine = (j == x) ? c : mine; }
    if (sum == G) break;
    __builtin_amdgcn_s_sleep(1);
    if ((++sp & 255u) == 0u) { if (xb_ld(&bar[XB_TMO])) break; if (sp > XB_SPIN_CAP) { atomicAdd(&bar[XB_TMO], 1u); break; } }
  }
  nloc = mine > 0u ? mine : 1u; nx = cnt > 0u ? cnt : 1u;
}
__device__ __forceinline__ void xcd_barrier(const XcdBarrier& b) {
  asm volatile("s_waitcnt vmcnt(0)" ::: "memory");
  __syncthreads();
  if (threadIdx.x == 0) {
    unsigned* bar = b.bar;
    __builtin_amdgcn_s_waitcnt(0);
    unsigned nloc = b.st[0], nx = b.st[1];
    if (nloc == 0u) { xcd_barrier_complete(bar, b.x, nloc, nx); b.st[0] = nloc; b.st[1] = nx; }
    const unsigned old = xb_add(&bar[XB_XSUB(b.x)], 1u);
    const unsigned gen = old / nloc;
    if (old + 1u == (gen + 1u) * nloc) {
      __builtin_amdgcn_fence(__ATOMIC_RELEASE, "agent");
      asm volatile("s_waitcnt vmcnt(0)" ::: "memory");
      const unsigned og = xb_add(&bar[XB_TOP], 1u);
      const unsigned tg = og / nx;
      if (og + 1u == (tg + 1u) * nx) xb_add(&bar[XB_TOPGEN], 1u);
      else XB_SPIN(xb_ld(&bar[XB_TOPGEN]) == tg, bar);
      __builtin_amdgcn_fence(__ATOMIC_ACQUIRE, "agent");
      xb_add(&bar[XB_XGEN(b.x)], 1u);
      asm volatile("s_waitcnt vmcnt(0)" ::: "memory");
    } else {
      XB_SPIN(xb_ld(&bar[XB_XGEN(b.x)]) == gen, bar);
      __builtin_amdgcn_fence(__ATOMIC_ACQUIRE, "agent");
      asm volatile("s_waitcnt vmcnt(0)" ::: "memory");
    }
  }
  __syncthreads();
}

__global__ void __launch_bounds__(NTHR) mega_kernel(Params pk, int ph_lo, int ph_hi) {
  __shared__ __attribute__((aligned(1024))) char shm_raw[SHM_BYTES];
  LAS char* shm = (LAS char*)shm_raw;
  cg::grid_group grid = cg::this_grid();
  const int bid = blockIdx.x, nb = gridDim.x;
  if (threadIdx.x < 4) ((LAS unsigned*)(shm + SHM_BYTES - 16))[threadIdx.x] = 0u;
  __syncthreads();
  XcdBarrier xb;
  { PP p0 = (PP)__builtin_amdgcn_kernarg_segment_ptr(); xb = xcd_barrier_post(p0->xbar, (volatile LAS unsigned*)(shm + SHM_BYTES - 16)); }
#define PH(k, call) if (ph_lo <= (k) && (k) < ph_hi) { PP p = (PP)__builtin_amdgcn_kernarg_segment_ptr(); asm volatile("" : "+s"(p)); call; if ((k) + 1 < ph_hi) xcd_barrier(xb); }
  if (ph_lo < 0) { asm volatile("s_waitcnt vmcnt(0)" ::: "memory"); __syncthreads(); grid.sync(); }
  PH(0, phase_prep(p, shm, bid, nb))
  PH(1, phase_proj<0>(p, 0, shm, bid, nb))
  PH(2, phase_retB(p, shm, bid, nb))
  PH(3, phase_retC(p, bid, nb))
  PH(4, phase_retD(p, shm, bid, nb))
  PH(6, phase_proj<1>(p, 0, shm, bid, nb))
  PH(7, phase_ln(p, 0, shm, bid, nb))
  PH(8, phase_proj<0>(p, 1, shm, bid, nb))
  PH(9, phase_retB(p, shm, bid, nb))
  PH(10, phase_retC(p, bid, nb))
  PH(11, phase_retD(p, shm, bid, nb))
  PH(13, phase_proj<1>(p, 1, shm, bid, nb))
  PH(14, phase_ln(p, 1, shm, bid, nb))
  PH(15, (phase_proj<3>(p, 2, shm, bid, nb), phase_proj<2>(p, 2, shm, bid, nb)))
  PH(16, phase_cmp1(p, shm, bid, nb))
  PH(17, phase_cmp2(p, shm, bid, nb))
  PH(19, phase_select(p, shm, bid, nb))
  PH(20, phase_attn(p, shm, bid, nb))
  PH(21, phase_proj<1>(p, 2, shm, bid, nb))
  PH(22, phase_ln(p, 2, shm, bid, nb))
  PH(23, phase_proj<2>(p, 3, shm, bid, nb))
  PH(24, phase_select(p, shm, bid, nb))
  PH(25, phase_attn(p, shm, bid, nb))
  PH(26, phase_proj<1>(p, 3, shm, bid, nb))
  PH(27, phase_ln(p, 3, shm, bid, nb))
#undef PH
}

extern "C" void kernel_launch(void* const* d_in, const int* in_sizes, int n_in, void* d_out, int out_size, void* d_ws, size_t ws_size, hipStream_t stream) {
  Params p{};
  p.x = (const float*)d_in[0]; p.pos = (const int*)d_in[1];
  p.ret_w_in[0] = (const float*)d_in[2]; p.ret_w_out[0] = (const float*)d_in[3]; p.ln_g[0] = (const float*)d_in[4]; p.ln_b[0] = (const float*)d_in[5];
  p.ret_w_in[1] = (const float*)d_in[6]; p.ret_w_out[1] = (const float*)d_in[7]; p.ln_g[1] = (const float*)d_in[8]; p.ln_b[1] = (const float*)d_in[9];
  p.w_kv = (const float*)d_in[10]; p.pe_k = (const float*)d_in[11]; p.pe_v = (const float*)d_in[12];
  p.w_ck1 = (const float*)d_in[13]; p.w_ck2 = (const float*)d_in[14]; p.w_cv1 = (const float*)d_in[15]; p.w_cv2 = (const float*)d_in[16];
  p.nsa_w_in[0] = (const float*)d_in[17]; p.nsa_w_out[0] = (const float*)d_in[18]; p.ln_g[2] = (const float*)d_in[19]; p.ln_b[2] = (const float*)d_in[20];
  p.nsa_w_in[1] = (const float*)d_in[21]; p.nsa_w_out[1] = (const float*)d_in[22]; p.ln_g[3] = (const float*)d_in[23]; p.ln_b[3] = (const float*)d_in[24];
  p.out = (float*)d_out;
  char* ws = (char*)d_ws; size_t off = 0;
  auto take = [&](size_t bytes) { char* r = ws + off; off += (bytes + 4095) & ~(size_t)4095; return r; };
  p.wA = (h16*)take((size_t)13312 * 2048 * 2);
  p.wB = (h16*)take((size_t)4096 * 2048 * 2);
  p.xres = (float*)take((size_t)NTOK * DM * 4);
  p.xh = (h16*)take((size_t)NTOK * DM * 2);
  p.cs = (float*)take((size_t)NTOK * 256 * 4);
  p.ck1T = (h16*)take((size_t)256 * 6144 * 2);
  p.cv1T = (h16*)take((size_t)256 * 4096 * 2);
  p.biask = (float*)take(1024); p.biasv = (float*)take(1024); p.biasp = (float*)take(65536);
  p.kc = (h16*)take((size_t)8 * 256 * 192 * 2);
  p.vcT = (h16*)take((size_t)8 * 128 * 256 * 2);
  p.masks = (u64*)take((size_t)8 * SEQ * 8);
  const size_t region = off;
  p.kh = (h16*)take((size_t)NTOK * 2048 * 2);
  p.kdT = (h16*)take((size_t)NTOK * 2048 * 2);
  p.Obuf = p.kh;
  p.qh = (h16*)take((size_t)NTOK * 2048 * 2);
  p.vT = (h16*)take((size_t)NTOK * 4096 * 2);
  p.zh = (h16*)take((size_t)NTOK * 4096 * 2);
  p.St = (h16*)take((size_t)16 * 16 * 131072 * 2);
  p.Pbuf = (h16*)take((size_t)16 * SEQ * 256 * 2);
  off = region;
  p.kvh = (h16*)take((size_t)NTOK * KV_LD * 2 + 65536 * 4);
  p.vselT = (h16*)take((size_t)2 * 512 * SEQ * 2);
  p.vwinT = (h16*)take((size_t)2 * 512 * SEQ * 2);
  p.mixed = (h16*)take((size_t)NTOK * DM * 2);
  p.proj = (h16*)take((size_t)NTOK * NSA_LD * 2);
  p.part = (float*)take((size_t)256 * 65536 * 4);
  p.xbar = (unsigned*)take(XCD_BAR_WORDS * 4);

  if (off > ws_size) fprintf(stderr, "workspace too small: need %zu have %zu\n", off, ws_size);
  static int grid_blocks = 0;
  if (!grid_blocks) {
    int dev = 0, cus = 0, per_cu = 0;
    (void)hipGetDevice(&dev);
    (void)hipDeviceGetAttribute(&cus, hipDeviceAttributeMultiprocessorCount, dev);
    (void)hipOccupancyMaxActiveBlocksPerMultiprocessor(&per_cu, mega_kernel, NTHR, 0);
    if (per_cu < 1) per_cu = 1;
    grid_blocks = cus * per_cu;
    if (grid_blocks > 256) grid_blocks = 256;
  }
  (void)hipMemsetAsync(p.xbar, 0, XCD_BAR_WORDS * 4, stream);
#if FUSED
  int lo = 0, hi = 28;
  void* args[] = {&p, &lo, &hi};
  hipError_t e = hipLaunchCooperativeKernel((void*)mega_kernel, dim3(grid_blocks), dim3(NTHR), args, 0, stream);
  if (e != hipSuccess) fprintf(stderr, "cooperative launch failed: %s (grid %d)\n", hipGetErrorString(e), grid_blocks);
#else
  for (int ph = 0; ph < 28; ++ph) hipLaunchKernelGGL(mega_kernel, dim3(256), dim3(NTHR), 0, stream, p, ph, ph + 1);
#endif
}
```

```cpp
#include <hip/hip_runtime.h>
#include <hip/hip_cooperative_groups.h>
#include <cstdio>
namespace cg = cooperative_groups;

#ifndef FUSED
#define FUSED 1
#endif

#define LAS __attribute__((address_space(3)))
typedef _Float16 h16;
typedef _Float16 h16x8 __attribute__((ext_vector_type(8)));
typedef _Float16 h16x4 __attribute__((ext_vector_type(4)));
typedef float f32x4 __attribute__((ext_vector_type(4)));
typedef unsigned long long u64;
typedef unsigned u32x4 __attribute__((ext_vector_type(4)));

constexpr int NTHR = 512;
constexpr int SEQ = 4096, NTOK = 8192, DM = 2048;
constexpr int SHM_BYTES = 147456;
constexpr float ALPHA_F = 1.6817928305074290f;
constexpr float LN_EPS_F = 1e-5f;
constexpr float LOG2E = 1.4426950408889634f;
constexpr int NSA_LD = 9472;
constexpr int KV_LD = 3840;

struct Params {
  const float* x; const int* pos;
  const float* ret_w_in[2]; const float* ret_w_out[2];
  const float* ln_g[4]; const float* ln_b[4];
  const float* w_kv; const float* pe_k; const float* pe_v; const float* w_ck1; const float* w_ck2; const float* w_cv1; const float* w_cv2;
  const float* nsa_w_in[2]; const float* nsa_w_out[2];
  float* out;
  h16* wA; h16* wB; float* xres; h16* xh; float* cs; h16* ck1T; h16* cv1T; float* biask; float* biasv; float* biasp;
  h16* qh; h16* kh; h16* kdT; h16* vT; h16* zh; h16* St; h16* Pbuf; h16* Obuf;
  h16* kvh; h16* vselT; h16* vwinT; h16* kc; h16* vcT; float* part; h16* proj; u64* masks; h16* mixed; unsigned* xbar;
};

typedef const __attribute__((address_space(4))) Params* PP;
#define WAIT_V0() asm volatile("s_waitcnt vmcnt(0)" ::: "memory")
__device__ __forceinline__ int opaque_tid() { int t = threadIdx.x; asm volatile("" : "+v"(t)); return t; }

__device__ __forceinline__ int lds_byte(int r, int c) {
  int st = (r >> 4) * 2 + (c >> 5), ob = (r & 15) * 64 + (c & 31) * 2;
  return st * 1024 + (ob ^ (((ob >> 9) & 1) << 5));
}
__device__ __forceinline__ void stage_rc(int b, int& R, int& C) {
  int st = b >> 10, sb = b & 1023, swz = sb ^ (((sb >> 9) & 1) << 5);
  R = (st >> 1) * 16 + swz / 64;
  C = (st & 1) * 32 + (swz % 64) / 2;
}
__device__ __forceinline__ float lg2gamma(int h) { return log1pf(-exp2f(-5.f - (float)h)) * LOG2E; }
__device__ __forceinline__ float sigmoidf_(float v) { return 1.f / (1.f + __expf(-v)); }
__device__ __forceinline__ float siluf_(float v) { return v / (1.f + __expf(-v)); }
__device__ __forceinline__ h16x4 cvt4(f32x4 v) { h16x4 r; r[0] = (h16)v[0]; r[1] = (h16)v[1]; r[2] = (h16)v[2]; r[3] = (h16)v[3]; return r; }

struct GOp { const h16* P; const h16* Q; long ldp, ldq; int nk, kt0, ksegP; long segP; };

__device__ __forceinline__ void gemm256(LAS char* shm, const GOp g, f32x4 (&acc)[8][4], const int tid) {
  const int wid = tid >> 6, lane = tid & 63, wr = wid >> 2, wc = wid & 3, fr = lane & 15, fq = lane >> 4;
  int offP[4], offQ[4];
#pragma unroll
  for (int i = 0; i < 4; ++i) { int R, C; stage_rc(wid * 1024 + i * 8192 + lane * 16, R, C); offP[i] = R * (int)g.ldp + C; offQ[i] = R * (int)g.ldq + C; }
#define G_STAGE(buf, t) do { const int kk_ = g.kt0 + (t); const long kp_ = (long)(kk_ / g.ksegP) * g.segP + (long)(kk_ % g.ksegP) * 64; const long kq_ = (long)kk_ * 64; \
    _Pragma("unroll") for (int i = 0; i < 4; ++i) { \
      __builtin_amdgcn_global_load_lds((const unsigned*)(g.P + offP[i] + kp_), (LAS unsigned*)(shm + (buf) * 65536 + wid * 1024 + i * 8192), 16, 0, 0); \
      __builtin_amdgcn_global_load_lds((const unsigned*)(g.Q + offQ[i] + kq_), (LAS unsigned*)(shm + (buf) * 65536 + 32768 + wid * 1024 + i * 8192), 16, 0, 0); } } while (0)
  G_STAGE(0, 0); WAIT_V0(); __syncthreads();
#pragma unroll 1
  for (int t = 0; t < g.nk; ++t) {
    const int cur = t & 1;
    if (t + 1 < g.nk) G_STAGE(cur ^ 1, t + 1);
#pragma unroll
    for (int ks = 0; ks < 2; ++ks) {
      h16x8 At[8], Bf[4];
#pragma unroll
      for (int m = 0; m < 8; ++m) At[m] = *(const LAS h16x8*)(shm + cur * 65536 + lds_byte(wr * 128 + m * 16 + fr, ks * 32 + fq * 8));
#pragma unroll
      for (int n = 0; n < 4; ++n) Bf[n] = *(const LAS h16x8*)(shm + cur * 65536 + 32768 + lds_byte(wc * 64 + n * 16 + fr, ks * 32 + fq * 8));
#pragma unroll
      for (int m = 0; m < 8; ++m)
#pragma unroll
        for (int n = 0; n < 4; ++n) acc[m][n] = __builtin_amdgcn_mfma_f32_16x16x32_f16(At[m], Bf[n], acc[m][n], 0, 0, 0);
    }
    WAIT_V0(); __syncthreads();
  }
#undef G_STAGE
}
__device__ __forceinline__ void zero_acc(f32x4 (&acc)[8][4]) {
#pragma unroll
  for (int m = 0; m < 8; ++m)
#pragma unroll
    for (int n = 0; n < 4; ++n) acc[m][n] = (f32x4){0.f, 0.f, 0.f, 0.f};
}


__device__ __forceinline__ void gemm8p(LAS char* shm, const h16* __restrict__ A, const int lda, const h16* __restrict__ Bt, const int ldb, const int nt,
                                        f32x4 (&acc)[2][2][4][2], const int tid) {
  constexpr int HTB = 128 * 64 * 2;
#define SA8(b, h) (shm + ((b) * 2 + (h)) * HTB)
#define SB8(b, h) (shm + (4 + (b) * 2 + (h)) * HTB)
  const int wid = tid >> 6, lane = tid & 63, wr = wid >> 2, wc = wid & 3, fr = lane & 15, fq = lane >> 4;
  int oa[2], ob[2];
#pragma unroll
  for (int i = 0; i < 2; ++i) { int R, C; stage_rc((tid & 511) * 16 + i * 8192, R, C); oa[i] = R * lda + C; ob[i] = R * ldb + C; }
#define STAGE8A(P_, half, kt) do { const h16* g_ = A + (long)(half) * 128 * lda + (long)(kt) * 64; \
    _Pragma("unroll") for (int i_ = 0; i_ < 2; ++i_) __builtin_amdgcn_global_load_lds((const unsigned*)(g_ + oa[i_]), (LAS unsigned*)((P_) + wid * 1024 + i_ * 8192), 16, 0, 0); } while (0)
#define STAGE8B(P_, half, kt) do { const h16* g_ = Bt + (long)(half) * 128 * ldb + (long)(kt) * 64; \
    _Pragma("unroll") for (int i_ = 0; i_ < 2; ++i_) __builtin_amdgcn_global_load_lds((const unsigned*)(g_ + ob[i_]), (LAS unsigned*)((P_) + wid * 1024 + i_ * 8192), 16, 0, 0); } while (0)
#define LDA8(dst, b, h) _Pragma("unroll") for (int m = 0; m < 4; ++m) _Pragma("unroll") for (int k = 0; k < 2; ++k) \
    dst[m][k] = *(const LAS h16x8*)(SA8(b, h) + lds_byte(wr * 64 + m * 16 + fr, k * 32 + fq * 8))
#define LDB8(dst, b, h) _Pragma("unroll") for (int n = 0; n < 2; ++n) _Pragma("unroll") for (int k = 0; k < 2; ++k) \
    dst[n][k] = *(const LAS h16x8*)(SB8(b, h) + lds_byte(wc * 32 + n * 16 + fr, k * 32 + fq * 8))
#define MMA8(ai, bj, At_, Bt_) do { __builtin_amdgcn_s_setprio(1); \
    _Pragma("unroll") for (int m = 0; m < 4; ++m) _Pragma("unroll") for (int n = 0; n < 2; ++n) _Pragma("unroll") for (int k = 0; k < 2; ++k) \
      acc[ai][bj][m][n] = __builtin_amdgcn_mfma_f32_16x16x32_f16(At_[m][k], Bt_[n][k], acc[ai][bj][m][n], 0, 0, 0); \
    __builtin_amdgcn_s_setprio(0); } while (0)
#define WAIT_V8(n) asm volatile("s_waitcnt vmcnt(" #n ")" ::: "memory")
#define WAIT_L8(n) asm volatile("s_waitcnt lgkmcnt(" #n ")" ::: "memory")
#define BAR8 __builtin_amdgcn_s_barrier()
#define SCHED8 __builtin_amdgcn_sched_barrier(0)
  h16x8 At[4][2], B0[2][2], B1[2][2];
  WAIT_V8(0);
  STAGE8B(SB8(0, 0), 0, 0); STAGE8A(SA8(0, 0), 0, 0);
  STAGE8B(SB8(0, 1), 1, 0); STAGE8A(SA8(0, 1), 1, 0);
  if (wr == 1) BAR8;
  WAIT_V8(4); BAR8;
  STAGE8B(SB8(1, 0), 0, 1); STAGE8A(SA8(1, 0), 0, 1); STAGE8B(SB8(1, 1), 1, 1);
  WAIT_V8(6); BAR8;
#pragma unroll 1
  for (int t = 0; t < nt - 2; t += 2) {
    LDB8(B0, 0, 0); SCHED8; LDA8(At, 0, 0); STAGE8A(SA8(1, 1), 1, t + 1);
    WAIT_L8(8); BAR8; WAIT_L8(0); MMA8(0, 0, At, B0); BAR8; SCHED8;
    LDB8(B1, 0, 1); STAGE8B(SB8(0, 0), 0, t + 2);
    BAR8; WAIT_L8(0); MMA8(0, 1, At, B1); BAR8;
    LDA8(At, 0, 1); STAGE8A(SA8(0, 0), 0, t + 2);
    BAR8; WAIT_L8(0); MMA8(1, 0, At, B0); BAR8; SCHED8;
    STAGE8B(SB8(0, 1), 1, t + 2);
    WAIT_V8(6); BAR8; MMA8(1, 1, At, B1); BAR8;
    LDB8(B0, 1, 0); SCHED8; LDA8(At, 1, 0); STAGE8A(SA8(0, 1), 1, t + 2);
    WAIT_L8(8); BAR8; WAIT_L8(0); MMA8(0, 0, At, B0); BAR8; SCHED8;
    LDB8(B1, 1, 1); STAGE8B(SB8(1, 0), 0, t + 3);
    BAR8; WAIT_L8(0); MMA8(0, 1, At, B1); BAR8;
    LDA8(At, 1, 1); STAGE8A(SA8(1, 0), 0, t + 3);
    BAR8; WAIT_L8(0); MMA8(1, 0, At, B0); BAR8; SCHED8;
    STAGE8B(SB8(1, 1), 1, t + 3);
    WAIT_V8(6); BAR8; MMA8(1, 1, At, B1); BAR8;
  }
  { LDB8(B0, 0, 0); LDA8(At, 0, 0); STAGE8A(SA8(1, 1), 1, nt - 1);
    BAR8; WAIT_L8(0); MMA8(0, 0, At, B0); BAR8;
    LDB8(B1, 0, 1); BAR8; WAIT_L8(0); MMA8(0, 1, At, B1); BAR8;
    LDA8(At, 0, 1); WAIT_V8(4); BAR8; WAIT_L8(0); MMA8(1, 0, At, B0); MMA8(1, 1, At, B1); BAR8; }
  { LDB8(B0, 1, 0); LDA8(At, 1, 0); WAIT_V8(2); BAR8; WAIT_L8(0); MMA8(0, 0, At, B0); BAR8;
    LDB8(B1, 1, 1); WAIT_V8(0); BAR8; WAIT_L8(0); MMA8(0, 1, At, B1); BAR8;
    LDA8(At, 1, 1); BAR8; WAIT_L8(0); MMA8(1, 0, At, B0); MMA8(1, 1, At, B1); BAR8; }
  if (wr == 0) BAR8;
#undef SA8
#undef SB8
#undef STAGE8A
#undef STAGE8B
#undef LDA8
#undef LDB8
#undef MMA8
}

__device__ __forceinline__ void conv_job(LAS char* shm, const float* __restrict__ src, int K, int N, int Npad, h16* __restrict__ dst, int& tilebase, int bid, int nb) {
  LAS h16* tile = (LAS h16*)shm;
  const int tid = threadIdx.x;
  const int nkt = K / 64, nnt = Npad / 64, ntiles = nkt * nnt;
  int start = (int)((((long)bid - tilebase) % nb + nb) % nb);
  for (int t = start; t < ntiles; t += nb) {
    const int k0 = (t % nkt) * 64, n0 = (t / nkt) * 64;
#pragma unroll
    for (int i = 0; i < 2; ++i) {
      const int e = tid * 4 + i * 2048, k = e >> 6, n = e & 63;
      float4 v = make_float4(0.f, 0.f, 0.f, 0.f);
      if (n0 + n < N) v = *(const float4*)(src + (long)(k0 + k) * N + n0 + n);
      tile[(n + 0) * 72 + k] = (h16)v.x; tile[(n + 1) * 72 + k] = (h16)v.y; tile[(n + 2) * 72 + k] = (h16)v.z; tile[(n + 3) * 72 + k] = (h16)v.w;
    }
    __syncthreads();
    { const int nn = tid >> 3, k8 = (tid & 7) * 8;
      *(u32x4*)(dst + (long)(n0 + nn) * K + k0 + k8) = *(const LAS u32x4*)(tile + nn * 72 + k8); }
    __syncthreads();
  }
  tilebase += ntiles;
}

__device__ __forceinline__ void phase_prep(PP p, LAS char* shm, int bid, int nb) {
  const int tid = threadIdx.x;
  int tb = 0;
  conv_job(shm, p->ret_w_in[0], 2048, 12288, 12288, p->wA, tb, bid, nb);
  conv_job(shm, p->ret_w_out[0], 4096, 2048, 2048, p->wB, tb, bid, nb);
  conv_job(shm, p->w_ck1, 6144, 256, 256, p->ck1T, tb, bid, nb);
  conv_job(shm, p->w_cv1, 4096, 256, 256, p->cv1T, tb, bid, nb);
  for (long i = ((long)bid * NTHR + tid) * 8; i < (long)NTOK * DM; i += (long)nb * NTHR * 8) {
    float4 a = *(const float4*)(p->x + i), b = *(const float4*)(p->x + i + 4);
    h16x8 o; o[0] = (h16)a.x; o[1] = (h16)a.y; o[2] = (h16)a.z; o[3] = (h16)a.w; o[4] = (h16)b.x; o[5] = (h16)b.y; o[6] = (h16)b.z; o[7] = (h16)b.w;
    *(h16x8*)(p->xh + i) = o;
  }
  for (int i = bid * NTHR + tid; i < NTOK * 128; i += nb * NTHR) {
    const int tok = i >> 7, f = i & 127;
    const double invf = exp2(-((double)f / 127.0) * 13.287712379549449);
    const float invf32 = (float)invf;
    const float ang = (float)p->pos[tok] * invf32;
    double a = (double)ang;
    const double k = rint(a * 0.63661977236758134308);
    const double r = (a - k * 1.5707963267948966192) - k * 6.123233995736766e-17;
    const double r2 = r * r;
    double sn = r * (1.0 + r2 * (-1.0 / 6 + r2 * (1.0 / 120 + r2 * (-1.0 / 5040 + r2 * (1.0 / 362880 + r2 * (-1.0 / 39916800 + r2 * (1.0 / 6227020800.0)))))));
    double cn = 1.0 + r2 * (-0.5 + r2 * (1.0 / 24 + r2 * (-1.0 / 720 + r2 * (1.0 / 40320 + r2 * (-1.0 / 3628800 + r2 * (1.0 / 479001600.0 + r2 * (-1.0 / 87178291200.0)))))));
    const int q = ((int)k) & 3;
    double c, s;
    if (q == 0) { c = cn; s = sn; } else if (q == 1) { c = -sn; s = cn; } else if (q == 2) { c = -cn; s = -sn; } else { c = sn; s = -cn; }
    p->cs[(long)i * 2] = (float)c; p->cs[(long)i * 2 + 1] = (float)s;
  }
  if (bid < 64) {
    const bool isk = (bid < 32); const int part = bid & 31;
    const float* pe = isk ? p->pe_k : p->pe_v; const float* w1 = isk ? p->w_ck1 : p->w_cv1; const int rng = isk ? 192 : 128;
    LAS float* red = (LAS float*)(shm + 16384);
    const int j = tid & 255, half = tid >> 8;
    float s = 0.f;
    const int i0 = part * rng + half * (rng / 2);
    for (int i = i0; i < i0 + rng / 2; ++i) s += pe[i] * w1[(long)i * 256 + j];
    red[tid] = s;
    __syncthreads();
    if (tid < 256) p->biasp[(bid) * 256 + tid] = red[tid] + red[tid + 256];
    __syncthreads();
  }
}

__device__ __forceinline__ void st_pair16(h16* p0, h16* p1, h16x4 v0, h16x4 v1, int fq) {
  typedef unsigned u32x2_t __attribute__((ext_vector_type(2)));
  const u32x2_t a = __builtin_bit_cast(u32x2_t, v0), b = __builtin_bit_cast(u32x2_t, v1);
  auto lo = __builtin_amdgcn_permlane16_swap(a[0], b[0], false, false);
  auto hi = __builtin_amdgcn_permlane16_swap(a[1], b[1], false, false);
  u32x4 o; o[0] = lo[0]; o[1] = hi[0]; o[2] = lo[1]; o[3] = hi[1];
  h16* dst = (fq & 1) ? (p1 - 4) : p0;
  *(u32x4*)dst = o;
}
template <int WHICH, bool tr>
__device__ __forceinline__ void proj_epi(PP p, int layer, const f32x4 (&acc)[2][2][4][2], const int tn, const int tm) {
  const int K = (WHICH == 1 && layer < 2) ? 4096 : 2048;
  const h16* Wt = (WHICH == 1) ? p->wB : (WHICH == 2) ? (p->wA + (long)3840 * 2048) : p->wA;
  const h16* A = (WHICH == 1) ? (layer < 2 ? p->Obuf : p->mixed) : p->xh;
  const long lda = K;
  {
    const int tid = opaque_tid(), wid = tid >> 6, lane = tid & 63, wr = wid >> 2, wc = wid & 3, fr = lane & 15, fq = lane >> 4;
    const int b = tm >> 4;
    if (tr) {
      h16* outT; long nf; int col0;
      if (WHICH == 0) { outT = p->vT; nf = 4096; col0 = (tn - 16) * 256; }
      else { outT = (tn < 10) ? p->vselT : p->vwinT; nf = 512; col0 = (tn < 10) ? (tn - 8) * 256 : (tn - 13) * 256; }
#pragma unroll
      for (int m = 0; m < 8; ++m)
#pragma unroll
        for (int n2 = 0; n2 < 2; ++n2) {
          const int feat0 = col0 + n2 * 128 + wc * 32 + fr;
          const int tl = (tm & 15) * 256 + (m >> 2) * 128 + wr * 64 + (m & 3) * 16 + fq * 4;
          h16* p0 = outT + ((long)b * nf + feat0) * SEQ + tl;
          st_pair16(p0, p0 + (long)16 * SEQ, cvt4(acc[m >> 2][n2][m & 3][0]), cvt4(acc[m >> 2][n2][m & 3][1]), fq); __builtin_amdgcn_sched_barrier(0);
        }
    } else {
      if (WHICH == 1) {
        const float* xin = (layer == 0) ? p->x : p->xres;
#pragma unroll
        for (int mp = 0; mp < 4; ++mp) {
          float4 xv[2][4];
#pragma unroll
          for (int mi = 0; mi < 2; ++mi)
#pragma unroll
            for (int n = 0; n < 4; ++n) {
              const int m = mp * 2 + mi;
              const long tok = tm * 256 + (n >> 1) * 128 + wc * 32 + (n & 1) * 16 + fr;
              xv[mi][n] = *(const float4*)(xin + tok * DM + tn * 256 + (m >> 2) * 128 + wr * 64 + (m & 3) * 16 + fq * 4);
            }
#pragma unroll
          for (int mi = 0; mi < 2; ++mi)
#pragma unroll
            for (int n = 0; n < 4; ++n) {
              const int m = mp * 2 + mi;
              const long tok = tm * 256 + (n >> 1) * 128 + wc * 32 + (n & 1) * 16 + fr;
              const long o = tok * DM + tn * 256 + (m >> 2) * 128 + wr * 64 + (m & 3) * 16 + fq * 4;
              const f32x4 a = acc[m >> 2][n >> 1][m & 3][n & 1];
              float4 r; r.x = ALPHA_F * xv[mi][n].x + a[0]; r.y = ALPHA_F * xv[mi][n].y + a[1]; r.z = ALPHA_F * xv[mi][n].z + a[2]; r.w = ALPHA_F * xv[mi][n].w + a[3];
              *(float4*)(p->xres + o) = r;
            }
          __builtin_amdgcn_sched_barrier(0);
        }
      } else if (WHICH == 0 && tn < 16) {
        const bool isk = tn >= 8; const int h = tn & 7;
        const float lg = lg2gamma(h);
        h16* outn = isk ? p->kh : p->qh;
        const float sc = isk ? 0.0625f : 1.0f;
#pragma unroll
        for (int m = 0; m < 8; ++m)
#pragma unroll
          for (int n2 = 0; n2 < 2; ++n2) {
            const int f0 = (m >> 2) * 128 + wr * 64 + (m & 3) * 16 + fq * 4;
            f32x4 rr[2];
#pragma unroll
            for (int q = 0; q < 2; ++q) {
              const int idx = n2 * 128 + wc * 32 + q * 16 + fr;
              const long tok = tm * 256 + idx;
              const float4 c = *(const float4*)(p->cs + tok * 256 + f0);
              const f32x4 a = acc[m >> 2][n2][m & 3][q];
              f32x4 r;
              r[0] = (a[0] * c.x - a[1] * c.y) * sc; r[1] = (a[0] * c.y + a[1] * c.x) * sc;
              r[2] = (a[2] * c.z - a[3] * c.w) * sc; r[3] = (a[2] * c.w + a[3] * c.z) * sc;
              rr[q] = r;
              if (isk) {
                const float dk = exp2f(lg * (float)(255 - idx));
                const long tl = (tm & 15) * 256 + idx;
                h16* kd = p->kdT + ((long)b * 2048 + h * 256 + f0) * SEQ + tl;
                kd[0] = (h16)(r[0] * dk); kd[SEQ] = (h16)(r[1] * dk); kd[2 * SEQ] = (h16)(r[2] * dk); kd[3 * SEQ] = (h16)(r[3] * dk);
              }
            }
            h16* p0 = outn + ((long)tm * 256 + n2 * 128 + wc * 32 + fr) * 2048 + h * 256 + f0;
            st_pair16(p0, p0 + 16 * 2048, cvt4(rr[0]), cvt4(rr[1]), fq);
          }
      } else {
        h16* outn; long ldo; int col0; float sc = 1.f;
        if (WHICH == 0) { outn = p->zh; ldo = 4096; col0 = (tn - 32) * 256; }
        else if (WHICH == 2) { outn = p->proj; ldo = NSA_LD; col0 = tn * 256; if (tn < 12) sc = 0.07216878364870322f * LOG2E; }
        else { outn = p->kvh; ldo = KV_LD; col0 = tn * 256; }
#pragma unroll
        for (int m = 0; m < 8; ++m)
#pragma unroll
          for (int n2 = 0; n2 < 2; ++n2) {
            const long tok0 = tm * 256 + n2 * 128 + wc * 32 + fr;
            const int f0 = col0 + (m >> 2) * 128 + wr * 64 + (m & 3) * 16 + fq * 4;
            h16* p0 = outn + tok0 * ldo + f0;
            st_pair16(p0, p0 + 16 * ldo, cvt4(acc[m >> 2][n2][m & 3][0] * sc), cvt4(acc[m >> 2][n2][m & 3][1] * sc), fq); __builtin_amdgcn_sched_barrier(0);
          }
      }
    }
  }
}

template <int WHICH>
__device__ __forceinline__ void proj_unit(PP p, int layer, int i, int& tn, int& tm, bool& tr, const h16*& Pp, const h16*& Qp) {
  const int K = (WHICH == 1 && layer < 2) ? 4096 : 2048;
  const h16* Wt = (WHICH == 1) ? p->wB : (WHICH == 2) ? (p->wA + (long)3840 * 2048) : p->wA;
  const h16* A = (WHICH == 1) ? (layer < 2 ? p->Obuf : p->mixed) : p->xh;
  tm = i % 32;
  if (WHICH == 0) { tn = i / 32; tr = (tn >= 16 && tn < 32); }
  else if (WHICH == 3) { if (i < 352) { const int j = i / 32; tn = j < 8 ? j : j + 2; tr = false; } else { const int j = (i - 352) / 32; tn = j < 2 ? 8 + j : 11 + j; tr = true; } }
  else { tn = i / 32; tr = false; }
  const h16* wt = Wt + (long)tn * 256 * K; const h16* at = A + (long)tm * 256 * K;
  Pp = tr ? at : wt; Qp = tr ? wt : at;
}
template <int WHICH>
__device__ __forceinline__ void phase_proj(PP p, int layer, LAS char* shm, int bid, int nb) {
  constexpr int NU = ((WHICH == 0) ? 48 : (WHICH == 1) ? 8 : (WHICH == 2) ? 37 : 15) * 32;
  const int K = (WHICH == 1 && layer < 2) ? 4096 : 2048;
  const int nt = K / 64;
  if (bid >= NU) return;
  constexpr int HTB = 128 * 64 * 2;
#define SA8(b, h) (shm + ((b) * 2 + (h)) * HTB)
#define SB8(b, h) (shm + (4 + (b) * 2 + (h)) * HTB)
  const int tid = opaque_tid();
  const int wid = tid >> 6, lane = tid & 63, wr = wid >> 2, wc = wid & 3, fr = lane & 15, fq = lane >> 4;
  int oo[2];
#pragma unroll
  for (int i = 0; i < 2; ++i) { int R, C; stage_rc(tid * 16 + i * 8192, R, C); oo[i] = R * K + C; }
  const h16 *cP, *cQ, *nP, *nQ; int tn, tm, ntn, ntm; bool tr, ntr;
  proj_unit<WHICH>(p, layer, bid, tn, tm, tr, cP, cQ);
#define STG(P_, base_c, base_n, half, kt) do { const h16* g_ = (((kt) < nt) ? (base_c) + (long)(kt) * 64 : (base_n) + (long)((kt) - nt) * 64) + (long)(half) * 128 * K; \
    _Pragma("unroll") for (int i_ = 0; i_ < 2; ++i_) __builtin_amdgcn_global_load_lds((const unsigned*)(g_ + oo[i_]), (LAS unsigned*)((P_) + wid * 1024 + i_ * 8192), 16, 0, 0); } while (0)
#define STAGE8A(P_, half, kt) STG(P_, cP, nP, half, kt)
#define STAGE8B(P_, half, kt) STG(P_, cQ, nQ, half, kt)
#define LDA8(dst, b, h) _Pragma("unroll") for (int m = 0; m < 4; ++m) _Pragma("unroll") for (int k = 0; k < 2; ++k) \
    dst[m][k] = *(const LAS h16x8*)(SA8(b, h) + lds_byte(wr * 64 + m * 16 + fr, k * 32 + fq * 8))
#define LDB8(dst, b, h) _Pragma("unroll") for (int n = 0; n < 2; ++n) _Pragma("unroll") for (int k = 0; k < 2; ++k) \
    dst[n][k] = *(const LAS h16x8*)(SB8(b, h) + lds_byte(wc * 32 + n * 16 + fr, k * 32 + fq * 8))
#define MMA8(ai, bj, At_, Bt_) do { __builtin_amdgcn_s_setprio(1); \
    _Pragma("unroll") for (int m = 0; m < 4; ++m) _Pragma("unroll") for (int n = 0; n < 2; ++n) _Pragma("unroll") for (int k = 0; k < 2; ++k) \
      acc[ai][bj][m][n] = __builtin_amdgcn_mfma_f32_16x16x32_f16(At_[m][k], Bt_[n][k], acc[ai][bj][m][n], 0, 0, 0); \
    __builtin_amdgcn_s_setprio(0); } while (0)
#define ZACC() do { _Pragma("unroll") for (int a_ = 0; a_ < 2; ++a_) _Pragma("unroll") for (int b_ = 0; b_ < 2; ++b_) _Pragma("unroll") for (int m_ = 0; m_ < 4; ++m_) { \
    acc[a_][b_][m_][0] = (f32x4){0.f, 0.f, 0.f, 0.f}; acc[a_][b_][m_][1] = (f32x4){0.f, 0.f, 0.f, 0.f}; } } while (0)
  f32x4 acc[2][2][4][2];
  h16x8 At[4][2], B0[2][2], B1[2][2];
  ZACC();
  nP = cP; nQ = cQ;
  WAIT_V8(0);
  STAGE8B(SB8(0, 0), 0, 0); STAGE8A(SA8(0, 0), 0, 0);
  STAGE8B(SB8(0, 1), 1, 0); STAGE8A(SA8(0, 1), 1, 0);
  if (wr == 1) BAR8;
  WAIT_V8(4); BAR8;
  STAGE8B(SB8(1, 0), 0, 1); STAGE8A(SA8(1, 0), 0, 1); STAGE8B(SB8(1, 1), 1, 1);
  WAIT_V8(6); BAR8;
#pragma unroll 1
  for (int u = bid; u < NU; u += nb) {
    if (u + nb < NU) proj_unit<WHICH>(p, layer, u + nb, ntn, ntm, ntr, nP, nQ);
    else { nP = cP; nQ = cQ; ntn = tn; ntm = tm; ntr = tr; }
#pragma unroll 1
    for (int t = 0; t < nt; t += 2) {
      LDB8(B0, 0, 0); SCHED8; LDA8(At, 0, 0); STAGE8A(SA8(1, 1), 1, t + 1);
      WAIT_L8(8); BAR8; WAIT_L8(0); MMA8(0, 0, At, B0); BAR8; SCHED8;
      LDB8(B1, 0, 1); STAGE8B(SB8(0, 0), 0, t + 2);
      BAR8; WAIT_L8(0); MMA8(0, 1, At, B1); BAR8;
      LDA8(At, 0, 1); STAGE8A(SA8(0, 0), 0, t + 2);
      BAR8; WAIT_L8(0); MMA8(1, 0, At, B0); BAR8; SCHED8;
      STAGE8B(SB8(0, 1), 1, t + 2);
      WAIT_V8(6); BAR8; MMA8(1, 1, At, B1); BAR8;
      LDB8(B0, 1, 0); SCHED8; LDA8(At, 1, 0); STAGE8A(SA8(0, 1), 1, t + 2);
      WAIT_L8(8); BAR8; WAIT_L8(0); MMA8(0, 0, At, B0); BAR8; SCHED8;
      LDB8(B1, 1, 1); STAGE8B(SB8(1, 0), 0, t + 3);
      BAR8; WAIT_L8(0); MMA8(0, 1, At, B1); BAR8;
      LDA8(At, 1, 1); STAGE8A(SA8(1, 0), 0, t + 3);
      BAR8; WAIT_L8(0); MMA8(1, 0, At, B0); BAR8; SCHED8;
      STAGE8B(SB8(1, 1), 1, t + 3);
      WAIT_V8(6); BAR8; MMA8(1, 1, At, B1); BAR8;
    }
    if (tr) proj_epi<WHICH, true>(p, layer, acc, tn, tm); else proj_epi<WHICH, false>(p, layer, acc, tn, tm);
    ZACC();
    cP = nP; cQ = nQ; tn = ntn; tm = ntm; tr = ntr;
  }
  WAIT_V8(0);
  if (wr == 0) BAR8;
  __syncthreads();
#undef SA8
#undef SB8
#undef STG
#undef STAGE8A
#undef STAGE8B
#undef LDA8
#undef LDB8
#undef MMA8
#undef ZACC
}

__device__ __forceinline__ void phase_retB(PP p, LAS char* shm, int bid, int nb) {
  for (int t = bid; t < 768; t += nb) {
    const int tid = opaque_tid(), wid = tid >> 6, lane = tid & 63, wr = wid >> 2, wc = wid & 3, fr = lane & 15, fq = lane >> 4;
    f32x4 acc[8][4];
    zero_acc(acc);
    GOp g; g.nk = 4; g.kt0 = 0; g.ksegP = 1 << 28; g.segP = 0;
    if (t < 512) {
      const int et = t & 1, c = (t >> 1) & 15, bh = t >> 5, b = bh >> 3, h = bh & 7;
      g.P = p->kdT + ((long)b * 2048 + h * 256) * SEQ + c * 256; g.ldp = SEQ;
      g.Q = p->vT + ((long)b * 4096 + h * 512 + et * 256) * SEQ + c * 256; g.ldq = SEQ;
      gemm256(shm, g, acc, tid);
      h16* st = p->St + ((long)(bh * 16 + c) * 512 + et * 256) * 256;
#pragma unroll
      for (int m = 0; m < 8; ++m)
#pragma unroll
        for (int n = 0; n < 4; ++n) {
          const int e = wc * 64 + n * 16 + fr, d0 = wr * 128 + m * 16 + fq * 4;
          *(h16x4*)(st + (long)e * 256 + d0) = cvt4(acc[m][n]); __builtin_amdgcn_sched_barrier(0);
        }
    } else {
      const int u = t - 512, c = u & 15, bh = u >> 4, b = bh >> 3, h = bh & 7;
      const float lg = lg2gamma(h);
      g.P = p->kh + ((long)b * SEQ + c * 256) * 2048 + h * 256; g.ldp = 2048;
      g.Q = p->qh + ((long)b * SEQ + c * 256) * 2048 + h * 256; g.ldq = 2048;
      gemm256(shm, g, acc, tid);
      h16* pb = p->Pbuf + ((long)bh * SEQ + c * 256) * 256;
#pragma unroll
      for (int m = 0; m < 8; ++m)
#pragma unroll
        for (int n = 0; n < 4; ++n) {
          const int qi = wc * 64 + n * 16 + fr, k0 = wr * 128 + m * 16 + fq * 4;
          f32x4 r;
#pragma unroll
          for (int j = 0; j < 4; ++j) { const int rel = qi - (k0 + j); r[j] = rel >= 0 ? acc[m][n][j] * exp2f(lg * (float)rel) : 0.f; }
          *(h16x4*)(pb + (long)qi * 256 + k0) = cvt4(r); __builtin_amdgcn_sched_barrier(0);
        }
    }
  }
}

__device__ __forceinline__ void phase_retC(PP p, int bid, int nb) {
  const int tid = threadIdx.x;
  for (int it = bid * NTHR + tid; it < 16 * 16384; it += nb * NTHR) {
    const int bh = it >> 14, idx = (it & 16383) * 8, h = bh & 7;
    const float dc = exp2f(lg2gamma(h) * 256.f);
    h16* base = p->St + (long)bh * 16 * 131072 + idx;
    h16x8 u[16];
#pragma unroll
    for (int c = 0; c < 16; ++c) u[c] = *(const h16x8*)(base + (long)c * 131072);
    float s[8];
#pragma unroll
    for (int j = 0; j < 8; ++j) s[j] = 0.f;
#pragma unroll
    for (int c = 0; c < 16; ++c) {
      h16x8 o;
#pragma unroll
      for (int j = 0; j < 8; ++j) { o[j] = (h16)s[j]; s[j] = s[j] * dc + (float)u[c][j]; }
      *(h16x8*)(base + (long)c * 131072) = o;
    }
  }
}

__device__ __forceinline__ float wave_sum(float v);
__device__ __forceinline__ void phase_retD(PP p, LAS char* shm, int bid, int nb) {
  for (int u = bid; u < 256; u += nb) {
    const int c = u & 15, bh = u >> 4, b = bh >> 3, h = bh & 7;
    const float lg = lg2gamma(h);
    for (int et = 0; et < 2; ++et) {
      const int tid = opaque_tid(), wid = tid >> 6, lane = tid & 63, wr = wid >> 2, wc = wid & 3, fr = lane & 15, fq = lane >> 4;
      f32x4 acc[8][4];
      zero_acc(acc);
      GOp g; g.nk = 4; g.kt0 = 0; g.ksegP = 1 << 28; g.segP = 0;
      g.P = p->St + ((long)(bh * 16 + c) * 512 + et * 256) * 256; g.ldp = 256;
      g.Q = p->qh + ((long)b * SEQ + c * 256) * 2048 + h * 256; g.ldq = 2048;
      gemm256(shm, g, acc, tid);
#pragma unroll
      for (int n = 0; n < 4; ++n) {
        const float dq = exp2f(lg * (float)(wc * 64 + n * 16 + fr + 1));
#pragma unroll
        for (int m = 0; m < 8; ++m) acc[m][n] = acc[m][n] * dq;
      }
      g.P = p->vT + ((long)b * 4096 + h * 512 + et * 256) * SEQ + c * 256; g.ldp = SEQ;
      g.Q = p->Pbuf + ((long)bh * SEQ + c * 256) * 256; g.ldq = 256;
      gemm256(shm, g, acc, tid);
#pragma unroll
      for (int m = 0; m < 8; ++m)
#pragma unroll
        for (int n = 0; n < 4; ++n) {
          const long tok = (long)b * SEQ + c * 256 + wc * 64 + n * 16 + fr;
          const int e0 = h * 512 + et * 256 + wr * 128 + m * 16 + fq * 4;
          *(h16x4*)(p->Obuf + tok * 4096 + e0) = cvt4(acc[m][n]); __builtin_amdgcn_sched_barrier(0);
        }
    }
    asm volatile("s_waitcnt vmcnt(0)" ::: "memory");
    __syncthreads();
    {
      const int tid = opaque_tid(), wid = tid >> 6, lane = tid & 63;
      for (int r0 = wid * 4; r0 < 256; r0 += 32) {
        h16x8 ov[4], zv[4];
#pragma unroll
        for (int q = 0; q < 4; ++q) {
          const long off = ((long)b * SEQ + c * 256 + r0 + q) * 4096 + h * 512 + lane * 8;
          ov[q] = *(const h16x8*)(p->Obuf + off); zv[q] = *(const h16x8*)(p->zh + off);
        }
#pragma unroll
        for (int q = 0; q < 4; ++q) {
          const long off = ((long)b * SEQ + c * 256 + r0 + q) * 4096 + h * 512 + lane * 8;
          float o[8]; float s = 0.f;
#pragma unroll
          for (int j = 0; j < 8; ++j) { o[j] = (float)ov[q][j]; s += o[j]; }
          const float mu = wave_sum(s) * (1.f / 512.f);
          float qq = 0.f;
#pragma unroll
          for (int j = 0; j < 8; ++j) { const float d = o[j] - mu; qq += d * d; }
          const float rstd = rsqrtf(wave_sum(qq) * (1.f / 512.f) + LN_EPS_F);
          h16x8 rr;
#pragma unroll
          for (int j = 0; j < 8; ++j) rr[j] = (h16)((o[j] - mu) * rstd * siluf_((float)zv[q][j]));
          *(h16x8*)(p->Obuf + off) = rr;
        }
      }
    }
    __syncthreads();
  }
}

__device__ __forceinline__ float wave_sum(float v) {
#pragma unroll
  for (int o = 32; o >= 1; o >>= 1) v += __shfl_xor(v, o);
  return v;
}

__device__ __forceinline__ void phase_retE(PP p, int bid, int nb) {
  const int tid = threadIdx.x, wid = tid >> 6, lane = tid & 63;
  for (int row = bid * 8 + wid; row < NTOK * 8; row += nb * 8) {
    const long off = (long)row * 512 + lane * 8;
    h16x8 ov = *(const h16x8*)(p->Obuf + off), zv = *(const h16x8*)(p->zh + off);
    float o[8]; float s = 0.f;
#pragma unroll
    for (int j = 0; j < 8; ++j) { o[j] = (float)ov[j]; s += o[j]; }
    const float mu = wave_sum(s) * (1.f / 512.f);
    float q = 0.f;
#pragma unroll
    for (int j = 0; j < 8; ++j) { const float d = o[j] - mu; q += d * d; }
    const float rstd = rsqrtf(wave_sum(q) * (1.f / 512.f) + LN_EPS_F);
    h16x8 r;
#pragma unroll
    for (int j = 0; j < 8; ++j) r[j] = (h16)((o[j] - mu) * rstd * siluf_((float)zv[j]));
    *(h16x8*)(p->Obuf + off) = r;
  }
}

__device__ __forceinline__ void phase_ln(PP p, int layer, LAS char* shm, int bid, int nb) {
  const int tid = threadIdx.x, wid = tid >> 6, lane = tid & 63;
  const float* gw = p->ln_g[layer]; const float* bw = p->ln_b[layer];
  float* dst = (layer == 3) ? p->out : p->xres;
  for (int row = bid * 8 + wid; row < NTOK; row += nb * 8) {
    const float* src = p->xres + (long)row * DM;
    float4 v[8]; float s = 0.f;
#pragma unroll
    for (int i = 0; i < 8; ++i) { v[i] = *(const float4*)(src + i * 256 + lane * 4); s += v[i].x + v[i].y + v[i].z + v[i].w; }
    const float mu = wave_sum(s) * (1.f / 2048.f);
    float q = 0.f;
#pragma unroll
    for (int i = 0; i < 8; ++i) { float a = v[i].x - mu, b = v[i].y - mu, c = v[i].z - mu, d = v[i].w - mu; q += a * a + b * b + c * c + d * d; }
    const float rstd = rsqrtf(wave_sum(q) * (1.f / 2048.f) + LN_EPS_F);
#pragma unroll
    for (int i = 0; i < 8; ++i) {
      const int col = i * 256 + lane * 4;
      const float4 gg = *(const float4*)(gw + col), bb = *(const float4*)(bw + col);
      float4 r; r.x = (v[i].x - mu) * rstd * gg.x + bb.x; r.y = (v[i].y - mu) * rstd * gg.y + bb.y; r.z = (v[i].z - mu) * rstd * gg.z + bb.z; r.w = (v[i].w - mu) * rstd * gg.w + bb.w;
      *(float4*)(dst + (long)row * DM + col) = r;
      h16x4 hv; hv[0] = (h16)r.x; hv[1] = (h16)r.y; hv[2] = (h16)r.z; hv[3] = (h16)r.w;
      *(h16x4*)(p->xh + (long)row * DM + col) = hv;
    }
  }
  __syncthreads();
  int tb = 0;
  if (layer == 0) {
    conv_job(shm, p->ret_w_in[1], 2048, 12288, 12288, p->wA, tb, bid, nb);
    conv_job(shm, p->ret_w_out[1], 4096, 2048, 2048, p->wB, tb, bid, nb);
  } else if (layer == 1) {
    conv_job(shm, p->w_kv, 2048, 3840, 3840, p->wA, tb, bid, nb);
    conv_job(shm, p->nsa_w_in[0], 2048, 9264, 9472, p->wA + (long)3840 * 2048, tb, bid, nb);
    conv_job(shm, p->nsa_w_out[0], 2048, 2048, 2048, p->wB, tb, bid, nb);
  } else if (layer == 2) {
    conv_job(shm, p->nsa_w_in[1], 2048, 9264, 9472, p->wA + (long)3840 * 2048, tb, bid, nb);
    conv_job(shm, p->nsa_w_out[1], 2048, 2048, 2048, p->wB, tb, bid, nb);
  }
}

__device__ __forceinline__ void phase_cmp1(PP p, LAS char* shm, int bid, int nb) {
  for (int t = bid; t < 256; t += nb) {
    const int tid = opaque_tid(), wid = tid >> 6, lane = tid & 63, wr = wid >> 2, wc = wid & 3, fr = lane & 15, fq = lane >> 4;
    const int kv = t >> 7, bg = (t >> 4) & 7, sp = t & 15, b = bg >> 2, gq = bg & 3;
    f32x4 acc[8][4];
    zero_acc(acc);
    GOp g;
    g.ldp = 16 * KV_LD; g.segP = KV_LD;
    if (kv == 0) { g.P = p->kvh + (long)b * SEQ * KV_LD + gq * 192; g.ksegP = 3; g.nk = 6; g.kt0 = 6 * sp; g.Q = p->ck1T; g.ldq = 6144; }
    else { g.P = p->kvh + (long)b * SEQ * KV_LD + 768 + gq * 128; g.ksegP = 2; g.nk = 4; g.kt0 = 4 * sp; g.Q = p->cv1T; g.ldq = 4096; }
    gemm256(shm, g, acc, tid);
    float* pt = p->part + (long)t * 65536;
#pragma unroll
    for (int m = 0; m < 8; ++m)
#pragma unroll
      for (int n = 0; n < 4; ++n) {
        *(f32x4*)(pt + (long)(wc * 64 + n * 16 + fr) * 256 + wr * 128 + m * 16 + fq * 4) = acc[m][n]; __builtin_amdgcn_sched_barrier(0);
      }
  }
}

__device__ __forceinline__ void phase_cmp2(PP p, LAS char* shm, int bid, int nb) {
  const int tid = threadIdx.x;
  LAS float* hid = (LAS float*)shm;
  for (int t = bid; t < 512; t += nb) {
    const int kv = t >> 8, bg = (t >> 5) & 7, ng = t & 31;
    const float* pt = p->part + (long)(kv * 128 + bg * 16) * 65536;
    const float* bias = p->biasp + (kv ? 32 * 256 : 0);
#pragma unroll
    for (int i = 0; i < 4; ++i) {
      const int e = tid + i * 512, nl = e & 7, hh = e >> 3;
      float s = 0.f;
      for (int pp = 0; pp < 32; ++pp) s += bias[pp * 256 + hh];
      for (int sp = 0; sp < 16; ++sp) s += pt[(long)sp * 65536 + (long)hh * 256 + ng * 8 + nl];
      hid[nl * 256 + hh] = siluf_(s);
    }
    __syncthreads();
    if (kv == 0) {
#pragma unroll
      for (int i = 0; i < 3; ++i) {
        const int o = tid + i * 512, nl = o / 192, j = o % 192, n = ng * 8 + nl;
        float s = 0.f;
        for (int hh = 0; hh < 256; ++hh) s += hid[nl * 256 + hh] * p->w_ck2[hh * 192 + j];
        p->kc[((long)bg * 256 + n) * 192 + j] = (n < 255) ? (h16)s : (h16)0.f;
      }
    } else {
#pragma unroll
      for (int i = 0; i < 2; ++i) {
        const int o = tid + i * 512, nl = o >> 7, j = o & 127, n = ng * 8 + nl;
        float s = 0.f;
        for (int hh = 0; hh < 256; ++hh) s += hid[nl * 256 + hh] * p->w_cv2[hh * 128 + j];
        p->vcT[((long)bg * 128 + j) * 256 + n] = (n < 255) ? (h16)s : (h16)0.f;
      }
    }
    __syncthreads();
  }
}

__device__ __forceinline__ void phase_select(PP p, LAS char* shm, int bid, int nb) {
  LAS float* psel = (LAS float*)(shm + 102400);
  for (int u = bid; u < 1024; u += nb) {
    const int tid = opaque_tid(), wid = tid >> 6, lane = tid & 63, fr = lane & 15, fq = lane >> 4;
    const int r = wid >> 1, th = wid & 1;
    const int bg = u >> 7, tile = u & 127, b = bg >> 2, gq = bg & 3, t0 = tile * 32;
    const h16* kcb = p->kc + (long)bg * 256 * 192;
    { const int row = tid >> 1, c0 = (tid & 1) * 12;
      const h16* src = kcb + row * 192 + c0 * 8; LAS char* dl = shm + row * 400 + c0 * 16;
#pragma unroll
      for (int i = 0; i < 12; ++i) *(LAS u32x4*)(dl + i * 16) = *(const u32x4*)(src + i * 8); }
    const int tq = t0 + th * 16 + fr;
    const h16* qrow = p->proj + ((long)b * SEQ + tq) * NSA_LD + (gq * 4 + r) * 192 + fq * 8;
    h16x8 qf[6];
#pragma unroll
    for (int ks = 0; ks < 6; ++ks) qf[ks] = *(const h16x8*)(qrow + ks * 32);
    __syncthreads();
    f32x4 s[16];
#pragma unroll
    for (int mt = 0; mt < 16; ++mt) s[mt] = (f32x4){0.f, 0.f, 0.f, 0.f};
#pragma unroll
    for (int ks = 0; ks < 6; ++ks)
#pragma unroll
      for (int mt = 0; mt < 16; ++mt) {
        const h16x8 kf = *(const LAS h16x8*)(shm + (mt * 16 + fr) * 400 + (ks * 32 + fq * 8) * 2);
        s[mt] = __builtin_amdgcn_mfma_f32_16x16x32_f16(kf, qf[ks], s[mt], 0, 0, 0);
      }
    float mx = -1e30f;
#pragma unroll
    for (int mt = 0; mt < 16; ++mt)
#pragma unroll
      for (int j = 0; j < 4; ++j) {
        const int n = mt * 16 + fq * 4 + j;
        const bool valid = (n < 255) && (16 * n + 31 <= tq);
        const float v = valid ? s[mt][j] : -1e30f;
        s[mt][j] = v; mx = fmaxf(mx, v);
      }
    mx = fmaxf(mx, __shfl_xor(mx, 16)); mx = fmaxf(mx, __shfl_xor(mx, 32));
    float l = 0.f;
#pragma unroll
    for (int mt = 0; mt < 16; ++mt)
#pragma unroll
      for (int j = 0; j < 4; ++j) { const float pv = (s[mt][j] > -1e29f) ? __builtin_amdgcn_exp2f(s[mt][j] - mx) : 0.f; s[mt][j] = pv; l += pv; }
    l += __shfl_xor(l, 16); l += __shfl_xor(l, 32);
    const float inv = l > 0.f ? 1.f / l : 0.f;
#pragma unroll
    for (int mt = 0; mt < 16; ++mt) {
      const float own = s[mt][0] + 2.f * (s[mt][1] + s[mt][2] + s[mt][3]);
      const float x1 = __shfl(s[mt][0], (lane + 16) & 63);
      const float nx = (mt < 15) ? s[(mt + 1) & 15][0] : 0.f;
      const float x2 = __shfl(nx, (lane + 16) & 63);
      const float val = (own + (fq < 3 ? x1 : x2)) * inv;
      psel[(r * 32 + th * 16 + fr) * 64 + mt * 4 + fq] = val;
    }
    __syncthreads();
#pragma unroll
    for (int i = 0; i < 4; ++i) {
      const int tl = wid * 4 + i, t = t0 + tl, cur = t >> 6, j = lane;
      const float ps = psel[(0 * 32 + tl) * 64 + j] + psel[(1 * 32 + tl) * 64 + j] + psel[(2 * 32 + tl) * 64 + j] + psel[(3 * 32 + tl) * 64 + j];
      const bool forced = (j == 0) || (j == cur) || (j == cur - 1);
      const float score = forced ? 1e9f : (j <= cur ? ps : -1.0f);
      int rank = 0;
      for (int k = 0; k < 64; ++k) { const float sk = __shfl(score, k); rank += (sk > score || (sk == score && k < j)) ? 1 : 0; }
      const u64 mk = __ballot(rank < 16);
      if (lane == 0) p->masks[(long)bg * SEQ + t] = mk;
    }
    __syncthreads();
  }
}


__device__ __forceinline__ float xr_max(float v) {
  const unsigned u = __float_as_uint(v);
  auto r = __builtin_amdgcn_permlane16_swap(u, u, false, false);
  const float a = fmaxf(__uint_as_float(r[0]), __uint_as_float(r[1]));
  const unsigned ua = __float_as_uint(a);
  auto r2 = __builtin_amdgcn_permlane32_swap(ua, ua, false, false);
  return fmaxf(__uint_as_float(r2[0]), __uint_as_float(r2[1]));
}
__device__ __forceinline__ float xr_sum(float v) {
  const unsigned u = __float_as_uint(v);
  auto r = __builtin_amdgcn_permlane16_swap(u, u, false, false);
  const float a = __uint_as_float(r[0]) + __uint_as_float(r[1]);
  const unsigned ua = __float_as_uint(a);
  auto r2 = __builtin_amdgcn_permlane32_swap(ua, ua, false, false);
  return __uint_as_float(r2[0]) + __uint_as_float(r2[1]);
}
constexpr int FK_OFF = 0, FV_OFF = 25600, FQ_OFF = 44032;
__device__ __forceinline__ void flash_branch(PP p, LAS char* shm, int branch, int b, int gq, int t0, const h16x8 (&qf)[2][6]) {
  const int tid = opaque_tid(), wid = tid >> 6, lane = tid & 63, fr = lane & 15, fq = lane >> 4;
  const int r = wid >> 1, th = wid & 1, bg = b * 4 + gq, hd = gq * 4 + r;
  const int cur = t0 >> 6;
  const h16* Kb; long ldk; const h16* VTb; long ldvt; int jlo, jhi;
  if (branch == 0) { Kb = p->kc + (long)bg * 256 * 192; ldk = 192; VTb = p->vcT + (long)bg * 128 * 256; ldvt = 256; jlo = 0; jhi = (t0 + 32) >> 10; if (jhi > 3) jhi = 3; }
  else if (branch == 1) { Kb = p->kvh + (long)b * SEQ * KV_LD + 1280 + gq * 192; ldk = KV_LD; VTb = p->vselT + ((long)b * 512 + gq * 128) * SEQ; ldvt = SEQ; jlo = 0; jhi = cur; }
  else { Kb = p->kvh + (long)b * SEQ * KV_LD + 2560 + gq * 192; ldk = KV_LD; VTb = p->vwinT + ((long)b * 512 + gq * 128) * SEQ; ldvt = SEQ; jlo = cur - 8 > 0 ? cur - 8 : 0; jhi = cur; }
  int tq[2]; u64 mk[2];
#pragma unroll
  for (int nt = 0; nt < 2; ++nt) { tq[nt] = t0 + th * 32 + nt * 16 + fr; mk[nt] = (branch == 1) ? p->masks[(long)bg * SEQ + tq[nt]] : 0ull; }
  f32x4 O[8][2];
#pragma unroll
  for (int et = 0; et < 8; ++et) { O[et][0] = (f32x4){0.f, 0.f, 0.f, 0.f}; O[et][1] = (f32x4){0.f, 0.f, 0.f, 0.f}; }
  float mrun[2] = {-1e30f, -1e30f}, lrun[2] = {0.f, 0.f};
  int koff[4], voff[3];
#pragma unroll
  for (int i = 0; i < 4; ++i) { const int c = (wid + 8 * i) * 64 + lane, row = c / 25, ch = c % 25; koff[i] = row * (int)ldk + (ch < 24 ? ch : 23) * 8; }
#pragma unroll
  for (int i = 0; i < 3; ++i) { const int c = (wid + 8 * i) * 64 + lane, e = c / 9, ch = c % 9; voff[i] = e * (int)ldvt + (ch < 8 ? ch : 7) * 8; }
#define F_STAGE(j, buf) do { \
    const h16* kb_ = Kb + (long)(j) * 64 * ldk; const h16* vb_ = VTb + (long)(j) * 64; LAS char* lb_ = shm + (buf) * 44032; \
    _Pragma("unroll") for (int i = 0; i < 4; ++i) if (wid + 8 * i < 25) __builtin_amdgcn_global_load_lds((const unsigned*)(kb_ + koff[i]), (LAS unsigned*)(lb_ + FK_OFF + (wid + 8 * i) * 1024), 16, 0, 0); \
    _Pragma("unroll") for (int i = 0; i < 3; ++i) if (wid + 8 * i < 18) __builtin_amdgcn_global_load_lds((const unsigned*)(vb_ + voff[i]), (LAS unsigned*)(lb_ + FV_OFF + (wid + 8 * i) * 1024), 16, 0, 0); } while (0)
  F_STAGE(jlo, 0);
  asm volatile("s_waitcnt vmcnt(0)" ::: "memory");
  __syncthreads();
  for (int j = jlo; j <= jhi; ++j) {
    const int cb = (j - jlo) & 1;
    LAS char* lb = shm + cb * 44032;
    if (j + 1 <= jhi) F_STAGE(j + 1, cb ^ 1);
    f32x4 s[4][2];
#pragma unroll
    for (int mt = 0; mt < 4; ++mt) { s[mt][0] = (f32x4){0.f, 0.f, 0.f, 0.f}; s[mt][1] = (f32x4){0.f, 0.f, 0.f, 0.f}; }
#pragma unroll
    for (int ks = 0; ks < 6; ++ks) {
      const h16x8 q0 = qf[0][ks], q1 = qf[1][ks];
#pragma unroll
      for (int mt = 0; mt < 4; ++mt) {
        const h16x8 kf = *(const LAS h16x8*)(lb + FK_OFF + (mt * 16 + fr) * 400 + (ks * 32 + fq * 8) * 2);
        s[mt][0] = __builtin_amdgcn_mfma_f32_16x16x32_f16(kf, q0, s[mt][0], 0, 0, 0);
        s[mt][1] = __builtin_amdgcn_mfma_f32_16x16x32_f16(kf, q1, s[mt][1], 0, 0, 0);
      }
    }
    __builtin_amdgcn_sched_group_barrier(0x100, 4, 0);
#pragma unroll
    for (int i = 0; i < 20; ++i) { __builtin_amdgcn_sched_group_barrier(0x100, 1, 0); __builtin_amdgcn_sched_group_barrier(0x008, 2, 0); }
    __builtin_amdgcn_sched_group_barrier(0x008, 8, 0);
    h16x8 pf[2][2];
    const bool full = (branch == 0) || (branch == 1 && j == cur) || (branch == 2 && (j == cur || j == cur - 8));
#pragma unroll
    for (int nt = 0; nt < 2; ++nt) {
      if (full) {
#pragma unroll
        for (int mt = 0; mt < 4; ++mt)
#pragma unroll
          for (int jj = 0; jj < 4; ++jj) {
            const int key = j * 64 + mt * 16 + fq * 4 + jj;
            bool valid;
            if (branch == 0) valid = (key < 255) && (16 * key + 31 <= tq[nt]);
            else if (branch == 1) valid = ((mk[nt] >> j) & 1ull) && (key <= tq[nt]);
            else valid = (key <= tq[nt]) && (tq[nt] - key < 512);
            s[mt][nt][jj] = valid ? s[mt][nt][jj] : -1e30f;
          }
      } else if (branch == 1) {
        const bool selb = (mk[nt] >> j) & 1ull;
#pragma unroll
        for (int mt = 0; mt < 4; ++mt)
#pragma unroll
          for (int jj = 0; jj < 4; ++jj) s[mt][nt][jj] = selb ? s[mt][nt][jj] : -1e30f;
      }
      float mx = fmaxf(fmaxf(s[0][nt][0], s[0][nt][1]), fmaxf(s[0][nt][2], s[0][nt][3]));
#pragma unroll
      for (int mt = 1; mt < 4; ++mt) mx = fmaxf(mx, fmaxf(fmaxf(s[mt][nt][0], s[mt][nt][1]), fmaxf(s[mt][nt][2], s[mt][nt][3])));
      mx = xr_max(mx);
      const float mold = mrun[nt];
      const float mnew = fmaxf(mold, mx);
      const float msafe = fmaxf(mnew, -1e29f);
      mrun[nt] = mnew;
      float rs = 0.f;
#pragma unroll
      for (int mt = 0; mt < 4; ++mt)
#pragma unroll
        for (int jj = 0; jj < 4; ++jj) { const float pv = __builtin_amdgcn_exp2f(s[mt][nt][jj] - msafe); s[mt][nt][jj] = pv; rs += pv; }
      rs = xr_sum(rs);
      if (__builtin_amdgcn_ballot_w64(mnew > mold) != 0ull) {
        const float alpha = __builtin_amdgcn_exp2f(mold - mnew);
        lrun[nt] = lrun[nt] * alpha + rs;
#pragma unroll
        for (int et = 0; et < 8; ++et) O[et][nt] = O[et][nt] * alpha;
      } else {
        lrun[nt] += rs;
      }
#pragma unroll
      for (int k2 = 0; k2 < 2; ++k2)
#pragma unroll
        for (int jj = 0; jj < 4; ++jj) { pf[nt][k2][jj] = (h16)s[2 * k2][nt][jj]; pf[nt][k2][4 + jj] = (h16)s[2 * k2 + 1][nt][jj]; }
    }
#pragma unroll
    for (int et = 0; et < 8; ++et)
#pragma unroll
      for (int k2 = 0; k2 < 2; ++k2) {
        const LAS char* va = lb + FV_OFF + (et * 16 + fr) * 144 + (k2 * 32 + fq * 4) * 2;
        const h16x4 lo = *(const LAS h16x4*)va, hi = *(const LAS h16x4*)(va + 32);
        h16x8 vf; vf[0] = lo[0]; vf[1] = lo[1]; vf[2] = lo[2]; vf[3] = lo[3]; vf[4] = hi[0]; vf[5] = hi[1]; vf[6] = hi[2]; vf[7] = hi[3];
        O[et][0] = __builtin_amdgcn_mfma_f32_16x16x32_f16(vf, pf[0][k2], O[et][0], 0, 0, 0);
        O[et][1] = __builtin_amdgcn_mfma_f32_16x16x32_f16(vf, pf[1][k2], O[et][1], 0, 0, 0);
      }
    __builtin_amdgcn_sched_group_barrier(0x100, 4, 0);
#pragma unroll
    for (int i = 0; i < 14; ++i) { __builtin_amdgcn_sched_group_barrier(0x100, 2, 0); __builtin_amdgcn_sched_group_barrier(0x008, 2, 0); }
    __builtin_amdgcn_sched_group_barrier(0x008, 4, 0);
    asm volatile("s_waitcnt vmcnt(0)" ::: "memory");
    __syncthreads();
  }
#undef F_STAGE
#pragma unroll
  for (int nt = 0; nt < 2; ++nt) {
    const long tok = (long)b * SEQ + tq[nt];
    const h16* pr = p->proj + tok * NSA_LD;
    const float gt = sigmoidf_((float)pr[9216 + branch * 16 + hd]);
    const float inv = lrun[nt] > 0.f ? gt / lrun[nt] : 0.f;
#pragma unroll
    for (int et = 0; et < 8; ++et) {
      const int e0 = hd * 128 + et * 16 + fq * 4;
      const h16x4 zv = *(const h16x4*)(pr + 3072 + branch * 2048 + e0);
      h16* mp = p->mixed + tok * DM + e0;
      f32x4 r;
#pragma unroll
      for (int jj = 0; jj < 4; ++jj) r[jj] = O[et][nt][jj] * inv * siluf_((float)zv[jj]);
      if (branch != 0) { const h16x4 old = *(const h16x4*)mp; r[0] += (float)old[0]; r[1] += (float)old[1]; r[2] += (float)old[2]; r[3] += (float)old[3]; }
      *(h16x4*)mp = cvt4(r);
    }
  }
}

__device__ __forceinline__ void phase_attn(PP p, LAS char* shm, int bid, int nb) {
  for (int u0 = bid; u0 < 256; u0 += nb) {
    const int u = (nb == 256) ? ((u0 & 7) << 5 | (u0 >> 3)) : u0;
    const int bg = u >> 5, pr = u & 31, b = bg >> 2, gq = bg & 3;
    for (int half = 0; half < 2; ++half) {
      const int tile = half ? 63 - pr : pr, t0 = tile * 64;
      h16x8 qf[2][6];
      { const int tid = opaque_tid(), wid = tid >> 6, lane = tid & 63, fr = lane & 15, fq = lane >> 4, r = wid >> 1, th = wid & 1;
#pragma unroll
        for (int nt = 0; nt < 2; ++nt) {
          const h16* qrow = p->proj + ((long)b * SEQ + t0 + th * 32 + nt * 16 + fr) * NSA_LD + (gq * 4 + r) * 192 + fq * 8;
#pragma unroll
          for (int ks = 0; ks < 6; ++ks) qf[nt][ks] = *(const h16x8*)(qrow + ks * 32);
        } }
      flash_branch(p, shm, 0, b, gq, t0, qf);
      flash_branch(p, shm, 1, b, gq, t0, qf);
      flash_branch(p, shm, 2, b, gq, t0, qf);
    }
  }
}


#define XB_TMO      128
#define XB_XCNT(j)  (256  + 64 * (j))
#define XB_XSUB(j)  (1280 + 64 * (j))
#define XB_XGEN(j)  (2304 + 64 * (j))
#define XB_TOP      3328
#define XB_TOPGEN   3392
#define XCD_BAR_WORDS 3456
#define XB_SPIN_CAP (1u << 18)
__device__ __forceinline__ unsigned xb_ld(unsigned* p)              { return __hip_atomic_load(p, __ATOMIC_RELAXED, __HIP_MEMORY_SCOPE_AGENT); }
__device__ __forceinline__ unsigned xb_add(unsigned* p, unsigned v) { return __hip_atomic_fetch_add(p, v, __ATOMIC_RELAXED, __HIP_MEMORY_SCOPE_AGENT); }
__device__ __forceinline__ unsigned xb_xcc_id() { return (unsigned)__builtin_amdgcn_s_getreg((3 << 11) | 20) & 0xFu; }
#define XB_SPIN(cond, bar) do { unsigned _sp = 0; while (cond) { __builtin_amdgcn_s_sleep(1); \
    if ((++_sp & 255u) == 0u) { if (xb_ld(&(bar)[XB_TMO])) break; if (_sp > XB_SPIN_CAP) { atomicAdd(&(bar)[XB_TMO], 1u); break; } } } } while (0)
struct XcdBarrier { unsigned* bar; unsigned x; volatile LAS unsigned* st; };
__device__ __forceinline__ XcdBarrier xcd_barrier_post(unsigned* bar, volatile LAS unsigned* st) {
  XcdBarrier b; b.bar = bar; b.x = xb_xcc_id(); b.st = st;
  if (threadIdx.x == 0) (void)xb_add(&bar[XB_XCNT(b.x)], 1u);
  return b;
}
__device__ __forceinline__ void xcd_barrier_complete(unsigned* bar, unsigned x, unsigned& nloc, unsigned& nx) {
  const unsigned G = gridDim.x * gridDim.y * gridDim.z;
  unsigned sum, cnt, mine, sp = 0u;
  for (;;) {
    sum = 0u; cnt = 0u; mine = 0u;
#pragma unroll
    for (unsigned j = 0; j < 16; ++j) { const unsigned c = xb_ld(&bar[XB_XCNT(j)]); sum += c; cnt += (c > 0u) ? 1u : 0u; mine = (j == x) ? c : mine; }
    if (sum == G) break;
    __builtin_amdgcn_s_sleep(1);
    if ((++sp & 255u) == 0u) { if (xb_ld(&bar[XB_TMO])) break; if (sp > XB_SPIN_CAP) { atomicAdd(&bar[XB_TMO], 1u); break; } }
  }
  nloc = mine > 0u ? mine : 1u; nx = cnt > 0u ? cnt : 1u;
}
__device__ __forceinline__ void xcd_barrier(const XcdBarrier& b) {
  asm volatile("s_waitcnt vmcnt(0)" ::: "memory");
  __syncthreads();
  if (threadIdx.x == 0) {
    unsigned* bar = b.bar;
    __builtin_amdgcn_s_waitcnt(0);
    unsigned nloc = b.st[0], nx = b.st[1];
    if (nloc == 0u) { xcd_barrier_complete(bar, b.x, nloc, nx); b.st[0] = nloc; b.st[1] = nx; }
    const unsigned old = xb_add(&bar[XB_XSUB(b.x)], 1u);
    const unsigned gen = old / nloc;
    if (old + 1u == (gen + 1u) * nloc) {
      __builtin_amdgcn_fence(__ATOMIC_RELEASE, "agent");
      asm volatile("s_waitcnt vmcnt(0)" ::: "memory");
      const unsigned og = xb_add(&bar[XB_TOP], 1u);
      const unsigned tg = og / nx;
      if (og + 1u == (tg + 1u) * nx) xb_add(&bar[XB_TOPGEN], 1u);
      else XB_SPIN(xb_ld(&bar[XB_TOPGEN]) == tg, bar);
      __builtin_amdgcn_fence(__ATOMIC_ACQUIRE, "agent");
      xb_add(&bar[XB_XGEN(b.x)], 1u);
      asm volatile("s_waitcnt vmcnt(0)" ::: "memory");
    } else {
      XB_SPIN(xb_ld(&bar[XB_XGEN(b.x)]) == gen, bar);
      __builtin_amdgcn_fence(__ATOMIC_ACQUIRE, "agent");
      asm volatile("s_waitcnt vmcnt(0)" ::: "memory");
    }
  }
  __syncthreads();
}

__global__ void __launch_bounds__(NTHR) mega_kernel(Params pk, int ph_lo, int ph_hi) {
  __shared__ __attribute__((aligned(1024))) char shm_raw[SHM_BYTES];
  LAS char* shm = (LAS char*)shm_raw;
  cg::grid_group grid = cg::this_grid();
  const int bid = blockIdx.x, nb = gridDim.x;
  if (threadIdx.x < 4) ((LAS unsigned*)(shm + SHM_BYTES - 16))[threadIdx.x] = 0u;
  __syncthreads();
  XcdBarrier xb;
  { PP p0 = (PP)__builtin_amdgcn_kernarg_segment_ptr(); xb = xcd_barrier_post(p0->xbar, (volatile LAS unsigned*)(shm + SHM_BYTES - 16)); }
#define PH(k, call) if (ph_lo <= (k) && (k) < ph_hi) { PP p = (PP)__builtin_amdgcn_kernarg_segment_ptr(); asm volatile("" : "+s"(p)); call; if ((k) + 1 < ph_hi) xcd_barrier(xb); }
  if (ph_lo < 0) { asm volatile("s_waitcnt vmcnt(0)" ::: "memory"); __syncthreads(); grid.sync(); }
  PH(0, phase_prep(p, shm, bid, nb))
  PH(1, phase_proj<0>(p, 0, shm, bid, nb))
  PH(2, phase_retB(p, shm, bid, nb))
  PH(3, phase_retC(p, bid, nb))
  PH(4, phase_retD(p, shm, bid, nb))
  PH(6, phase_proj<1>(p, 0, shm, bid, nb))
  PH(7, phase_ln(p, 0, shm, bid, nb))
  PH(8, phase_proj<0>(p, 1, shm, bid, nb))
  PH(9, phase_retB(p, shm, bid, nb))
  PH(10, phase_retC(p, bid, nb))
  PH(11, phase_retD(p, shm, bid, nb))
  PH(13, phase_proj<1>(p, 1, shm, bid, nb))
  PH(14, phase_ln(p, 1, shm, bid, nb))
  PH(15, (phase_proj<3>(p, 2, shm, bid, nb), phase_proj<2>(p, 2, shm, bid, nb)))
  PH(16, phase_cmp1(p, shm, bid, nb))
  PH(17, phase_cmp2(p, shm, bid, nb))
  PH(19, phase_select(p, shm, bid, nb))
  PH(20, phase_attn(p, shm, bid, nb))
  PH(21, phase_proj<1>(p, 2, shm, bid, nb))
  PH(22, phase_ln(p, 2, shm, bid, nb))
  PH(23, phase_proj<2>(p, 3, shm, bid, nb))
  PH(24, phase_select(p, shm, bid, nb))
  PH(25, phase_attn(p, shm, bid, nb))
  PH(26, phase_proj<1>(p, 3, shm, bid, nb))
  PH(27, phase_ln(p, 3, shm, bid, nb))
#undef PH
}

extern "C" void kernel_launch(void* const* d_in, const int* in_sizes, int n_in, void* d_out, int out_size, void* d_ws, size_t ws_size, hipStream_t stream) {
  Params p{};
  p.x = (const float*)d_in[0]; p.pos = (const int*)d_in[1];
  p.ret_w_in[0] = (const float*)d_in[2]; p.ret_w_out[0] = (const float*)d_in[3]; p.ln_g[0] = (const float*)d_in[4]; p.ln_b[0] = (const float*)d_in[5];
  p.ret_w_in[1] = (const float*)d_in[6]; p.ret_w_out[1] = (const float*)d_in[7]; p.ln_g[1] = (const float*)d_in[8]; p.ln_b[1] = (const float*)d_in[9];
  p.w_kv = (const float*)d_in[10]; p.pe_k = (const float*)d_in[11]; p.pe_v = (const float*)d_in[12];
  p.w_ck1 = (const float*)d_in[13]; p.w_ck2 = (const float*)d_in[14]; p.w_cv1 = (const float*)d_in[15]; p.w_cv2 = (const float*)d_in[16];
  p.nsa_w_in[0] = (const float*)d_in[17]; p.nsa_w_out[0] = (const float*)d_in[18]; p.ln_g[2] = (const float*)d_in[19]; p.ln_b[2] = (const float*)d_in[20];
  p.nsa_w_in[1] = (const float*)d_in[21]; p.nsa_w_out[1] = (const float*)d_in[22]; p.ln_g[3] = (const float*)d_in[23]; p.ln_b[3] = (const float*)d_in[24];
  p.out = (float*)d_out;
  char* ws = (char*)d_ws; size_t off = 0;
  auto take = [&](size_t bytes) { char* r = ws + off; off += (bytes + 4095) & ~(size_t)4095; return r; };
  p.wA = (h16*)take((size_t)13312 * 2048 * 2);
  p.wB = (h16*)take((size_t)4096 * 2048 * 2);
  p.xres = (float*)take((size_t)NTOK * DM * 4);
  p.xh = (h16*)take((size_t)NTOK * DM * 2);
  p.cs = (float*)take((size_t)NTOK * 256 * 4);
  p.ck1T = (h16*)take((size_t)256 * 6144 * 2);
  p.cv1T = (h16*)take((size_t)256 * 4096 * 2);
  p.biask = (float*)take(1024); p.biasv = (float*)take(1024); p.biasp = (float*)take(65536);
  p.kc = (h16*)take((size_t)8 * 256 * 192 * 2);
  p.vcT = (h16*)take((size_t)8 * 128 * 256 * 2);
  p.masks = (u64*)take((size_t)8 * SEQ * 8);
  const size_t region = off;
  p.kh = (h16*)take((size_t)NTOK * 2048 * 2);
  p.kdT = (h16*)take((size_t)NTOK * 2048 * 2);
  p.Obuf = p.kh;
  p.qh = (h16*)take((size_t)NTOK * 2048 * 2);
  p.vT = (h16*)take((size_t)NTOK * 4096 * 2);
  p.zh = (h16*)take((size_t)NTOK * 4096 * 2);
  p.St = (h16*)take((size_t)16 * 16 * 131072 * 2);
  p.Pbuf = (h16*)take((size_t)16 * SEQ * 256 * 2);
  off = region;
  p.kvh = (h16*)take((size_t)NTOK * KV_LD * 2 + 65536 * 4);
  p.vselT = (h16*)take((size_t)2 * 512 * SEQ * 2);
  p.vwinT = (h16*)take((size_t)2 * 512 * SEQ * 2);
  p.mixed = (h16*)take((size_t)NTOK * DM * 2);
  p.proj = (h16*)take((size_t)NTOK * NSA_LD * 2);
  p.part = (float*)take((size_t)256 * 65536 * 4);
  p.xbar = (unsigned*)take(XCD_BAR_WORDS * 4);

  if (off > ws_size) fprintf(stderr, "workspace too small: need %zu have %zu\n", off, ws_size);
  static int grid_blocks = 0;
  if (!grid_blocks) {
    int dev = 0, cus = 0, per_cu = 0;
    (void)hipGetDevice(&dev);
    (void)hipDeviceGetAttribute(&cus, hipDeviceAttributeMultiprocessorCount, dev);
    (void)hipOccupancyMaxActiveBlocksPerMultiprocessor(&per_cu, mega_kernel, NTHR, 0);
    if (per_cu < 1) per_cu = 1;
    grid_blocks = cus * per_cu;
    if (grid_blocks > 256) grid_blocks = 256;
  }
  (void)hipMemsetAsync(p.xbar, 0, XCD_BAR_WORDS * 4, stream);
#if FUSED
  int lo = 0, hi = 28;
  void* args[] = {&p, &lo, &hi};
  hipError_t e = hipLaunchCooperativeKernel((void*)mega_kernel, dim3(grid_blocks), dim3(NTHR), args, 0, stream);
  if (e != hipSuccess) fprintf(stderr, "cooperative launch failed: %s (grid %d)\n", hipGetErrorString(e), grid_blocks);
#else
  for (int ph = 0; ph < 28; ++ph) hipLaunchKernelGGL(mega_kernel, dim3(256), dim3(NTHR), 0, stream, p, ph, ph + 1);
#endif
}
```

```cpp
#include <hip/hip_runtime.h>
#include <hip/hip_cooperative_groups.h>
#include <cstdio>
namespace cg = cooperative_groups;

#ifndef FUSED
#define FUSED 1
#endif

#define LAS __attribute__((address_space(3)))
typedef _Float16 h16;
typedef _Float16 h16x8 __attribute__((ext_vector_type(8)));
typedef _Float16 h16x4 __attribute__((ext_vector_type(4)));
typedef float f32x4 __attribute__((ext_vector_type(4)));
typedef unsigned long long u64;
typedef unsigned u32x4 __attribute__((ext_vector_type(4)));

constexpr int NTHR = 512;
constexpr int SEQ = 4096, NTOK = 8192, DM = 2048;
constexpr int SHM_BYTES = 147456;
constexpr float ALPHA_F = 1.6817928305074290f;
constexpr float LN_EPS_F = 1e-5f;
constexpr float LOG2E = 1.4426950408889634f;
constexpr int NSA_LD = 9472;
constexpr int KV_LD = 3840;

struct Params {
  const float* x; const int* pos;
  const float* ret_w_in[2]; const float* ret_w_out[2];
  const float* ln_g[4]; const float* ln_b[4];
  const float* w_kv; const float* pe_k; const float* pe_v; const float* w_ck1; const float* w_ck2; const float* w_cv1; const float* w_cv2;
  const float* nsa_w_in[2]; const float* nsa_w_out[2];
  float* out;
  h16* wA; h16* wB; float* xres; h16* xh; float* cs; h16* ck1T; h16* cv1T; float* biask; float* biasv; float* biasp;
  h16* qh; h16* kh; h16* kdT; h16* vT; h16* zh; h16* St; h16* Pbuf; h16* Obuf;
  h16* kvh; h16* vselT; h16* vwinT; h16* kc; h16* vcT; float* part; h16* proj; u64* masks; h16* mixed; unsigned* xbar;
};

typedef const __attribute__((address_space(4))) Params* PP;
#define WAIT_V0() asm volatile("s_waitcnt vmcnt(0)" ::: "memory")
__device__ __forceinline__ int opaque_tid() { int t = threadIdx.x; asm volatile("" : "+v"(t)); return t; }

__device__ __forceinline__ int lds_byte(int r, int c) {
  int st = (r >> 4) * 2 + (c >> 5), ob = (r & 15) * 64 + (c & 31) * 2;
  return st * 1024 + (ob ^ (((ob >> 9) & 1) << 5));
}
__device__ __forceinline__ void stage_rc(int b, int& R, int& C) {
  int st = b >> 10, sb = b & 1023, swz = sb ^ (((sb >> 9) & 1) << 5);
  R = (st >> 1) * 16 + swz / 64;
  C = (st & 1) * 32 + (swz % 64) / 2;
}
__device__ __forceinline__ float lg2gamma(int h) { return log1pf(-exp2f(-5.f - (float)h)) * LOG2E; }
__device__ __forceinline__ float sigmoidf_(float v) { return 1.f / (1.f + __expf(-v)); }
__device__ __forceinline__ float siluf_(float v) { return v / (1.f + __expf(-v)); }
__device__ __forceinline__ h16x4 cvt4(f32x4 v) { h16x4 r; r[0] = (h16)v[0]; r[1] = (h16)v[1]; r[2] = (h16)v[2]; r[3] = (h16)v[3]; return r; }

struct GOp { const h16* P; const h16* Q; long ldp, ldq; int nk, kt0, ksegP; long segP; };

__device__ __forceinline__ void gemm256(LAS char* shm, const GOp g, f32x4 (&acc)[8][4], const int tid) {
  const int wid = tid >> 6, lane = tid & 63, wr = wid >> 2, wc = wid & 3, fr = lane & 15, fq = lane >> 4;
  int offP[4], offQ[4];
#pragma unroll
  for (int i = 0; i < 4; ++i) { int R, C; stage_rc(wid * 1024 + i * 8192 + lane * 16, R, C); offP[i] = R * (int)g.ldp + C; offQ[i] = R * (int)g.ldq + C; }
#define G_STAGE(buf, t) do { const int kk_ = g.kt0 + (t); const long kp_ = (long)(kk_ / g.ksegP) * g.segP + (long)(kk_ % g.ksegP) * 64; const long kq_ = (long)kk_ * 64; \
    _Pragma("unroll") for (int i = 0; i < 4; ++i) { \
      __builtin_amdgcn_global_load_lds((const unsigned*)(g.P + offP[i] + kp_), (LAS unsigned*)(shm + (buf) * 65536 + wid * 1024 + i * 8192), 16, 0, 0); \
      __builtin_amdgcn_global_load_lds((const unsigned*)(g.Q + offQ[i] + kq_), (LAS unsigned*)(shm + (buf) * 65536 + 32768 + wid * 1024 + i * 8192), 16, 0, 0); } } while (0)
  G_STAGE(0, 0); WAIT_V0(); __syncthreads();
#pragma unroll 1
  for (int t = 0; t < g.nk; ++t) {
    const int cur = t & 1;
    if (t + 1 < g.nk) G_STAGE(cur ^ 1, t + 1);
#pragma unroll
    for (int ks = 0; ks < 2; ++ks) {
      h16x8 At[8], Bf[4];
#pragma unroll
      for (int m = 0; m < 8; ++m) At[m] = *(const LAS h16x8*)(shm + cur * 65536 + lds_byte(wr * 128 + m * 16 + fr, ks * 32 + fq * 8));
#pragma unroll
      for (int n = 0; n < 4; ++n) Bf[n] = *(const LAS h16x8*)(shm + cur * 65536 + 32768 + lds_byte(wc * 64 + n * 16 + fr, ks * 32 + fq * 8));
#pragma unroll
      for (int m = 0; m < 8; ++m)
#pragma unroll
        for (int n = 0; n < 4; ++n) acc[m][n] = __builtin_amdgcn_mfma_f32_16x16x32_f16(At[m], Bf[n], acc[m][n], 0, 0, 0);
    }
    WAIT_V0(); __syncthreads();
  }
#undef G_STAGE
}
__device__ __forceinline__ void zero_acc(f32x4 (&acc)[8][4]) {
#pragma unroll
  for (int m = 0; m < 8; ++m)
#pragma unroll
    for (int n = 0; n < 4; ++n) acc[m][n] = (f32x4){0.f, 0.f, 0.f, 0.f};
}


__device__ __forceinline__ void gemm8p(LAS char* shm, const h16* __restrict__ A, const int lda, const h16* __restrict__ Bt, const int ldb, const int nt,
                                        f32x4 (&acc)[2][2][4][2], const int tid) {
  constexpr int HTB = 128 * 64 * 2;
#define SA8(b, h) (shm + ((b) * 2 + (h)) * HTB)
#define SB8(b, h) (shm + (4 + (b) * 2 + (h)) * HTB)
  const int wid = tid >> 6, lane = tid & 63, wr = wid >> 2, wc = wid & 3, fr = lane & 15, fq = lane >> 4;
  int oa[2], ob[2];
#pragma unroll
  for (int i = 0; i < 2; ++i) { int R, C; stage_rc((tid & 511) * 16 + i * 8192, R, C); oa[i] = R * lda + C; ob[i] = R * ldb + C; }
#define STAGE8A(P_, half, kt) do { const h16* g_ = A + (long)(half) * 128 * lda + (long)(kt) * 64; \
    _Pragma("unroll") for (int i_ = 0; i_ < 2; ++i_) __builtin_amdgcn_global_load_lds((const unsigned*)(g_ + oa[i_]), (LAS unsigned*)((P_) + wid * 1024 + i_ * 8192), 16, 0, 0); } while (0)
#define STAGE8B(P_, half, kt) do { const h16* g_ = Bt + (long)(half) * 128 * ldb + (long)(kt) * 64; \
    _Pragma("unroll") for (int i_ = 0; i_ < 2; ++i_) __builtin_amdgcn_global_load_lds((const unsigned*)(g_ + ob[i_]), (LAS unsigned*)((P_) + wid * 1024 + i_ * 8192), 16, 0, 0); } while (0)
#define LDA8(dst, b, h) _Pragma("unroll") for (int m = 0; m < 4; ++m) _Pragma("unroll") for (int k = 0; k < 2; ++k) \
    dst[m][k] = *(const LAS h16x8*)(SA8(b, h) + lds_byte(wr * 64 + m * 16 + fr, k * 32 + fq * 8))
#define LDB8(dst, b, h) _Pragma("unroll") for (int n = 0; n < 2; ++n) _Pragma("unroll") for (int k = 0; k < 2; ++k) \
    dst[n][k] = *(const LAS h16x8*)(SB8(b, h) + lds_byte(wc * 32 + n * 16 + fr, k * 32 + fq * 8))
#define MMA8(ai, bj, At_, Bt_) do { __builtin_amdgcn_s_setprio(1); \
    _Pragma("unroll") for (int m = 0; m < 4; ++m) _Pragma("unroll") for (int n = 0; n < 2; ++n) _Pragma("unroll") for (int k = 0; k < 2; ++k) \
      acc[ai][bj][m][n] = __builtin_amdgcn_mfma_f32_16x16x32_f16(At_[m][k], Bt_[n][k], acc[ai][bj][m][n], 0, 0, 0); \
    __builtin_amdgcn_s_setprio(0); } while (0)
#define WAIT_V8(n) asm volatile("s_waitcnt vmcnt(" #n ")" ::: "memory")
#define WAIT_L8(n) asm volatile("s_waitcnt lgkmcnt(" #n ")" ::: "memory")
#define BAR8 __builtin_amdgcn_s_barrier()
#define SCHED8 __builtin_amdgcn_sched_barrier(0)
  h16x8 At[4][2], B0[2][2], B1[2][2];
  WAIT_V8(0);
  STAGE8B(SB8(0, 0), 0, 0); STAGE8A(SA8(0, 0), 0, 0);
  STAGE8B(SB8(0, 1), 1, 0); STAGE8A(SA8(0, 1), 1, 0);
  if (wr == 1) BAR8;
  WAIT_V8(4); BAR8;
  STAGE8B(SB8(1, 0), 0, 1); STAGE8A(SA8(1, 0), 0, 1); STAGE8B(SB8(1, 1), 1, 1);
  WAIT_V8(6); BAR8;
#pragma unroll 1
  for (int t = 0; t < nt - 2; t += 2) {
    LDB8(B0, 0, 0); SCHED8; LDA8(At, 0, 0); STAGE8A(SA8(1, 1), 1, t + 1);
    WAIT_L8(8); BAR8; WAIT_L8(0); MMA8(0, 0, At, B0); BAR8; SCHED8;
    LDB8(B1, 0, 1); STAGE8B(SB8(0, 0), 0, t + 2);
    BAR8; WAIT_L8(0); MMA8(0, 1, At, B1); BAR8;
    LDA8(At, 0, 1); STAGE8A(SA8(0, 0), 0, t + 2);
    BAR8; WAIT_L8(0); MMA8(1, 0, At, B0); BAR8; SCHED8;
    STAGE8B(SB8(0, 1), 1, t + 2);
    WAIT_V8(6); BAR8; MMA8(1, 1, At, B1); BAR8;
    LDB8(B0, 1, 0); SCHED8; LDA8(At, 1, 0); STAGE8A(SA8(0, 1), 1, t + 2);
    WAIT_L8(8); BAR8; WAIT_L8(0); MMA8(0, 0, At, B0); BAR8; SCHED8;
    LDB8(B1, 1, 1); STAGE8B(SB8(1, 0), 0, t + 3);
    BAR8; WAIT_L8(0); MMA8(0, 1, At, B1); BAR8;
    LDA8(At, 1, 1); STAGE8A(SA8(1, 0), 0, t + 3);
    BAR8; WAIT_L8(0); MMA8(1, 0, At, B0); BAR8; SCHED8;
    STAGE8B(SB8(1, 1), 1, t + 3);
    WAIT_V8(6); BAR8; MMA8(1, 1, At, B1); BAR8;
  }
  { LDB8(B0, 0, 0); LDA8(At, 0, 0); STAGE8A(SA8(1, 1), 1, nt - 1);
    BAR8; WAIT_L8(0); MMA8(0, 0, At, B0); BAR8;
    LDB8(B1, 0, 1); BAR8; WAIT_L8(0); MMA8(0, 1, At, B1); BAR8;
    LDA8(At, 0, 1); WAIT_V8(4); BAR8; WAIT_L8(0); MMA8(1, 0, At, B0); MMA8(1, 1, At, B1); BAR8; }
  { LDB8(B0, 1, 0); LDA8(At, 1, 0); WAIT_V8(2); BAR8; WAIT_L8(0); MMA8(0, 0, At, B0); BAR8;
    LDB8(B1, 1, 1); WAIT_V8(0); BAR8; WAIT_L8(0); MMA8(0, 1, At, B1); BAR8;
    LDA8(At, 1, 1); BAR8; WAIT_L8(0); MMA8(1, 0, At, B0); MMA8(1, 1, At, B1); BAR8; }
  if (wr == 0) BAR8;
#undef SA8
#undef SB8
#undef STAGE8A
#undef STAGE8B
#undef LDA8
#undef LDB8
#undef MMA8
}

__device__ __forceinline__ void conv_job(LAS char* shm, const float* __restrict__ src, int K, int N, int Npad, h16* __restrict__ dst, int& tilebase, int bid, int nb) {
  LAS h16* tile = (LAS h16*)shm;
  const int tid = threadIdx.x;
  const int nkt = K / 64, nnt = Npad / 64, ntiles = nkt * nnt;
  int start = (int)((((long)bid - tilebase) % nb + nb) % nb);
  for (int t = start; t < ntiles; t += nb) {
    const int k0 = (t % nkt) * 64, n0 = (t / nkt) * 64;
#pragma unroll
    for (int i = 0; i < 2; ++i) {
      const int e = tid * 4 + i * 2048, k = e >> 6, n = e & 63;
      float4 v = make_float4(0.f, 0.f, 0.f, 0.f);
      if (n0 + n < N) v = *(const float4*)(src + (long)(k0 + k) * N + n0 + n);
      tile[(n + 0) * 72 + k] = (h16)v.x; tile[(n + 1) * 72 + k] = (h16)v.y; tile[(n + 2) * 72 + k] = (h16)v.z; tile[(n + 3) * 72 + k] = (h16)v.w;
    }
    __syncthreads();
    { const int nn = tid >> 3, k8 = (tid & 7) * 8;
      *(u32x4*)(dst + (long)(n0 + nn) * K + k0 + k8) = *(const LAS u32x4*)(tile + nn * 72 + k8); }
    __syncthreads();
  }
  tilebase += ntiles;
}

__device__ __forceinline__ void phase_prep(PP p, LAS char* shm, int bid, int nb) {
  const int tid = threadIdx.x;
  int tb = 0;
  conv_job(shm, p->ret_w_in[0], 2048, 12288, 12288, p->wA, tb, bid, nb);
  conv_job(shm, p->ret_w_out[0], 4096, 2048, 2048, p->wB, tb, bid, nb);
  conv_job(shm, p->w_ck1, 6144, 256, 256, p->ck1T, tb, bid, nb);
  conv_job(shm, p->w_cv1, 4096, 256, 256, p->cv1T, tb, bid, nb);
  for (long i = ((long)bid * NTHR + tid) * 8; i < (long)NTOK * DM; i += (long)nb * NTHR * 8) {
    float4 a = *(const float4*)(p->x + i), b = *(const float4*)(p->x + i + 4);
    h16x8 o; o[0] = (h16)a.x; o[1] = (h16)a.y; o[2] = (h16)a.z; o[3] = (h16)a.w; o[4] = (h16)b.x; o[5] = (h16)b.y; o[6] = (h16)b.z; o[7] = (h16)b.w;
    *(h16x8*)(p->xh + i) = o;
  }
  for (int i = bid * NTHR + tid; i < NTOK * 128; i += nb * NTHR) {
    const int tok = i >> 7, f = i & 127;
    const double invf = exp2(-((double)f / 127.0) * 13.287712379549449);
    const float invf32 = (float)invf;
    const float ang = (float)p->pos[tok] * invf32;
    double a = (double)ang;
    const double k = rint(a * 0.63661977236758134308);
    const double r = (a - k * 1.5707963267948966192) - k * 6.123233995736766e-17;
    const double r2 = r * r;
    double sn = r * (1.0 + r2 * (-1.0 / 6 + r2 * (1.0 / 120 + r2 * (-1.0 / 5040 + r2 * (1.0 / 362880 + r2 * (-1.0 / 39916800 + r2 * (1.0 / 6227020800.0)))))));
    double cn = 1.0 + r2 * (-0.5 + r2 * (1.0 / 24 + r2 * (-1.0 / 720 + r2 * (1.0 / 40320 + r2 * (-1.0 / 3628800 + r2 * (1.0 / 479001600.0 + r2 * (-1.0 / 87178291200.0)))))));
    const int q = ((int)k) & 3;
    double c, s;
    if (q == 0) { c = cn; s = sn; } else if (q == 1) { c = -sn; s = cn; } else if (q == 2) { c = -cn; s = -sn; } else { c = sn; s = -cn; }
    p->cs[(long)i * 2] = (float)c; p->cs[(long)i * 2 + 1] = (float)s;
  }
  if (bid < 64) {
    const bool isk = (bid < 32); const int part = bid & 31;
    const float* pe = isk ? p->pe_k : p->pe_v; const float* w1 = isk ? p->w_ck1 : p->w_cv1; const int rng = isk ? 192 : 128;
    LAS float* red = (LAS float*)(shm + 16384);
    const int j = tid & 255, half = tid >> 8;
    float s = 0.f;
    const int i0 = part * rng + half * (rng / 2);
    for (int i = i0; i < i0 + rng / 2; ++i) s += pe[i] * w1[(long)i * 256 + j];
    red[tid] = s;
    __syncthreads();
    if (tid < 256) p->biasp[(bid) * 256 + tid] = red[tid] + red[tid + 256];
    __syncthreads();
  }
}

__device__ __forceinline__ void st_pair16(h16* p0, h16* p1, h16x4 v0, h16x4 v1, int fq) {
  typedef unsigned u32x2_t __attribute__((ext_vector_type(2)));
  const u32x2_t a = __builtin_bit_cast(u32x2_t, v0), b = __builtin_bit_cast(u32x2_t, v1);
  auto lo = __builtin_amdgcn_permlane16_swap(a[0], b[0], false, false);
  auto hi = __builtin_amdgcn_permlane16_swap(a[1], b[1], false, false);
  u32x4 o; o[0] = lo[0]; o[1] = hi[0]; o[2] = lo[1]; o[3] = hi[1];
  h16* dst = (fq & 1) ? (p1 - 4) : p0;
  *(u32x4*)dst = o;
}
template <int WHICH, bool tr>
__device__ __forceinline__ void proj_epi(PP p, int layer, const f32x4 (&acc)[2][2][4][2], const int tn, const int tm) {
  const int K = (WHICH == 1 && layer < 2) ? 4096 : 2048;
  const h16* Wt = (WHICH == 1) ? p->wB : (WHICH == 2) ? (p->wA + (long)3840 * 2048) : p->wA;
  const h16* A = (WHICH == 1) ? (layer < 2 ? p->Obuf : p->mixed) : p->xh;
  const long lda = K;
  {
    const int tid = opaque_tid(), wid = tid >> 6, lane = tid & 63, wr = wid >> 2, wc = wid & 3, fr = lane & 15, fq = lane >> 4;
    const int b = tm >> 4;
    if (tr) {
      h16* outT; long nf; int col0;
      if (WHICH == 0) { outT = p->vT; nf = 4096; col0 = (tn - 16) * 256; }
      else { outT = (tn < 10) ? p->vselT : p->vwinT; nf = 512; col0 = (tn < 10) ? (tn - 8) * 256 : (tn - 13) * 256; }
#pragma unroll
      for (int m = 0; m < 8; ++m)
#pragma unroll
        for (int n2 = 0; n2 < 2; ++n2) {
          const int feat0 = col0 + n2 * 128 + wc * 32 + fr;
          const int tl = (tm & 15) * 256 + (m >> 2) * 128 + wr * 64 + (m & 3) * 16 + fq * 4;
          h16* p0 = outT + ((long)b * nf + feat0) * SEQ + tl;
          st_pair16(p0, p0 + (long)16 * SEQ, cvt4(acc[m >> 2][n2][m & 3][0]), cvt4(acc[m >> 2][n2][m & 3][1]), fq); __builtin_amdgcn_sched_barrier(0);
        }
    } else {
      if (WHICH == 1) {
        const float* xin = (layer == 0) ? p->x : p->xres;
#pragma unroll
        for (int mp = 0; mp < 4; ++mp) {
          float4 xv[2][4];
#pragma unroll
          for (int mi = 0; mi < 2; ++mi)
#pragma unroll
            for (int n = 0; n < 4; ++n) {
              const int m = mp * 2 + mi;
              const long tok = tm * 256 + (n >> 1) * 128 + wc * 32 + (n & 1) * 16 + fr;
              xv[mi][n] = *(const float4*)(xin + tok * DM + tn * 256 + (m >> 2) * 128 + wr * 64 + (m & 3) * 16 + fq * 4);
            }
#pragma unroll
          for (int mi = 0; mi < 2; ++mi)
#pragma unroll
            for (int n = 0; n < 4; ++n) {
              const int m = mp * 2 + mi;
              const long tok = tm * 256 + (n >> 1) * 128 + wc * 32 + (n & 1) * 16 + fr;
              const long o = tok * DM + tn * 256 + (m >> 2) * 128 + wr * 64 + (m & 3) * 16 + fq * 4;
              const f32x4 a = acc[m >> 2][n >> 1][m & 3][n & 1];
              float4 r; r.x = ALPHA_F * xv[mi][n].x + a[0]; r.y = ALPHA_F * xv[mi][n].y + a[1]; r.z = ALPHA_F * xv[mi][n].z + a[2]; r.w = ALPHA_F * xv[mi][n].w + a[3];
              *(float4*)(p->xres + o) = r;
            }
          __builtin_amdgcn_sched_barrier(0);
        }
      } else if (WHICH == 0 && tn < 16) {
        const bool isk = tn >= 8; const int h = tn & 7;
        const float lg = lg2gamma(h);
        h16* outn = isk ? p->kh : p->qh;
        const float sc = isk ? 0.0625f : 1.0f;
#pragma unroll
        for (int m = 0; m < 8; ++m)
#pragma unroll
          for (int n2 = 0; n2 < 2; ++n2) {
            const int f0 = (m >> 2) * 128 + wr * 64 + (m & 3) * 16 + fq * 4;
            f32x4 rr[2];
#pragma unroll
            for (int q = 0; q < 2; ++q) {
              const int idx = n2 * 128 + wc * 32 + q * 16 + fr;
              const long tok = tm * 256 + idx;
              const float4 c = *(const float4*)(p->cs + tok * 256 + f0);
              const f32x4 a = acc[m >> 2][n2][m & 3][q];
              f32x4 r;
              r[0] = (a[0] * c.x - a[1] * c.y) * sc; r[1] = (a[0] * c.y + a[1] * c.x) * sc;
              r[2] = (a[2] * c.z - a[3] * c.w) * sc; r[3] = (a[2] * c.w + a[3] * c.z) * sc;
              rr[q] = r;
              if (isk) {
                const float dk = exp2f(lg * (float)(255 - idx));
                const long tl = (tm & 15) * 256 + idx;
                h16* kd = p->kdT + ((long)b * 2048 + h * 256 + f0) * SEQ + tl;
                kd[0] = (h16)(r[0] * dk); kd[SEQ] = (h16)(r[1] * dk); kd[2 * SEQ] = (h16)(r[2] * dk); kd[3 * SEQ] = (h16)(r[3] * dk);
              }
            }
            h16* p0 = outn + ((long)tm * 256 + n2 * 128 + wc * 32 + fr) * 2048 + h * 256 + f0;
            st_pair16(p0, p0 + 16 * 2048, cvt4(rr[0]), cvt4(rr[1]), fq);
          }
      } else {
        h16* outn; long ldo; int col0; float sc = 1.f;
        if (WHICH == 0) { outn = p->zh; ldo = 4096; col0 = (tn - 32) * 256; }
        else if (WHICH == 2) { outn = p->proj; ldo = NSA_LD; col0 = tn * 256; if (tn < 12) sc = 0.07216878364870322f * LOG2E; }
        else { outn = p->kvh; ldo = KV_LD; col0 = tn * 256; }
#pragma unroll
        for (int m = 0; m < 8; ++m)
#pragma unroll
          for (int n2 = 0; n2 < 2; ++n2) {
            const long tok0 = tm * 256 + n2 * 128 + wc * 32 + fr;
            const int f0 = col0 + (m >> 2) * 128 + wr * 64 + (m & 3) * 16 + fq * 4;
            h16* p0 = outn + tok0 * ldo + f0;
            st_pair16(p0, p0 + 16 * ldo, cvt4(acc[m >> 2][n2][m & 3][0] * sc), cvt4(acc[m >> 2][n2][m & 3][1] * sc), fq); __builtin_amdgcn_sched_barrier(0);
          }
      }
    }
  }
}

template <int WHICH>
__device__ __forceinline__ void proj_unit(PP p, int layer, int i, int& tn, int& tm, bool& tr, const h16*& Pp, const h16*& Qp) {
  const int K = (WHICH == 1 && layer < 2) ? 4096 : 2048;
  const h16* Wt = (WHICH == 1) ? p->wB : (WHICH == 2) ? (p->wA + (long)3840 * 2048) : p->wA;
  const h16* A = (WHICH == 1) ? (layer < 2 ? p->Obuf : p->mixed) : p->xh;
  tm = i % 32;
  if (WHICH == 0) { tn = i / 32; tr = (tn >= 16 && tn < 32); }
  else if (WHICH == 3) { if (i < 352) { const int j = i / 32; tn = j < 8 ? j : j + 2; tr = false; } else { const int j = (i - 352) / 32; tn = j < 2 ? 8 + j : 11 + j; tr = true; } }
  else { tn = i / 32; tr = false; }
  const h16* wt = Wt + (long)tn * 256 * K; const h16* at = A + (long)tm * 256 * K;
  Pp = tr ? at : wt; Qp = tr ? wt : at;
}
template <int WHICH>
__device__ __forceinline__ void phase_proj(PP p, int layer, LAS char* shm, int bid, int nb) {
  constexpr int NU = ((WHICH == 0) ? 48 : (WHICH == 1) ? 8 : (WHICH == 2) ? 37 : 15) * 32;
  const int K = (WHICH == 1 && layer < 2) ? 4096 : 2048;
  const int nt = K / 64;
  if (bid >= NU) return;
  constexpr int HTB = 128 * 64 * 2;
#define SA8(b, h) (shm + ((b) * 2 + (h)) * HTB)
#define SB8(b, h) (shm + (4 + (b) * 2 + (h)) * HTB)
  const int tid = opaque_tid();
  const int wid = tid >> 6, lane = tid & 63, wr = wid >> 2, wc = wid & 3, fr = lane & 15, fq = lane >> 4;
  int oo[2];
#pragma unroll
  for (int i = 0; i < 2; ++i) { int R, C; stage_rc(tid * 16 + i * 8192, R, C); oo[i] = R * K + C; }
  const h16 *cP, *cQ, *nP, *nQ; int tn, tm, ntn, ntm; bool tr, ntr;
  proj_unit<WHICH>(p, layer, bid, tn, tm, tr, cP, cQ);
#define STG(P_, base_c, base_n, half, kt) do { const h16* g_ = (((kt) < nt) ? (base_c) + (long)(kt) * 64 : (base_n) + (long)((kt) - nt) * 64) + (long)(half) * 128 * K; \
    _Pragma("unroll") for (int i_ = 0; i_ < 2; ++i_) __builtin_amdgcn_global_load_lds((const unsigned*)(g_ + oo[i_]), (LAS unsigned*)((P_) + wid * 1024 + i_ * 8192), 16, 0, 0); } while (0)
#define STAGE8A(P_, half, kt) STG(P_, cP, nP, half, kt)
#define STAGE8B(P_, half, kt) STG(P_, cQ, nQ, half, kt)
#define LDA8(dst, b, h) _Pragma("unroll") for (int m = 0; m < 4; ++m) _Pragma("unroll") for (int k = 0; k < 2; ++k) \
    dst[m][k] = *(const LAS h16x8*)(SA8(b, h) + lds_byte(wr * 64 + m * 16 + fr, k * 32 + fq * 8))
#define LDB8(dst, b, h) _Pragma("unroll") for (int n = 0; n < 2; ++n) _Pragma("unroll") for (int k = 0; k < 2; ++k) \
    dst[n][k] = *(const LAS h16x8*)(SB8(b, h) + lds_byte(wc * 32 + n * 16 + fr, k * 32 + fq * 8))
#define MMA8(ai, bj, At_, Bt_) do { __builtin_amdgcn_s_setprio(1); \
    _Pragma("unroll") for (int m = 0; m < 4; ++m) _Pragma("unroll") for (int n = 0; n < 2; ++n) _Pragma("unroll") for (int k = 0; k < 2; ++k) \
      acc[ai][bj][m][n] = __builtin_amdgcn_mfma_f32_16x16x32_f16(At_[m][k], Bt_[n][k], acc[ai][bj][m][n], 0, 0, 0); \
    __builtin_amdgcn_s_setprio(0); } while (0)
#define ZACC() do { _Pragma("unroll") for (int a_ = 0; a_ < 2; ++a_) _Pragma("unroll") for (int b_ = 0; b_ < 2; ++b_) _Pragma("unroll") for (int m_ = 0; m_ < 4; ++m_) { \
    acc[a_][b_][m_][0] = (f32x4){0.f, 0.f, 0.f, 0.f}; acc[a_][b_][m_][1] = (f32x4){0.f, 0.f, 0.f, 0.f}; } } while (0)
  f32x4 acc[2][2][4][2];
  h16x8 At[4][2], B0[2][2], B1[2][2];
  ZACC();
  nP = cP; nQ = cQ;
  WAIT_V8(0);
  STAGE8B(SB8(0, 0), 0, 0); STAGE8A(SA8(0, 0), 0, 0);
  STAGE8B(SB8(0, 1), 1, 0); STAGE8A(SA8(0, 1), 1, 0);
  if (wr == 1) BAR8;
  WAIT_V8(4); BAR8;
  STAGE8B(SB8(1, 0), 0, 1); STAGE8A(SA8(1, 0), 0, 1); STAGE8B(SB8(1, 1), 1, 1);
  WAIT_V8(6); BAR8;
#pragma unroll 1
  for (int u = bid; u < NU; u += nb) {
    if (u + nb < NU) proj_unit<WHICH>(p, layer, u + nb, ntn, ntm, ntr, nP, nQ);
    else { nP = cP; nQ = cQ; ntn = tn; ntm = tm; ntr = tr; }
#pragma unroll 1
    for (int t = 0; t < nt; t += 2) {
      LDB8(B0, 0, 0); SCHED8; LDA8(At, 0, 0); STAGE8A(SA8(1, 1), 1, t + 1);
      WAIT_L8(8); BAR8; WAIT_L8(0); MMA8(0, 0, At, B0); BAR8; SCHED8;
      LDB8(B1, 0, 1); STAGE8B(SB8(0, 0), 0, t + 2);
      BAR8; WAIT_L8(0); MMA8(0, 1, At, B1); BAR8;
      LDA8(At, 0, 1); STAGE8A(SA8(0, 0), 0, t + 2);
      BAR8; WAIT_L8(0); MMA8(1, 0, At, B0); BAR8; SCHED8;
      STAGE8B(SB8(0, 1), 1, t + 2);
      WAIT_V8(6); BAR8; MMA8(1, 1, At, B1); BAR8;
      LDB8(B0, 1, 0); SCHED8; LDA8(At, 1, 0); STAGE8A(SA8(0, 1), 1, t + 2);
      WAIT_L8(8); BAR8; WAIT_L8(0); MMA8(0, 0, At, B0); BAR8; SCHED8;
      LDB8(B1, 1, 1); STAGE8B(SB8(1, 0), 0, t + 3);
      BAR8; WAIT_L8(0); MMA8(0, 1, At, B1); BAR8;
      LDA8(At, 1, 1); STAGE8A(SA8(1, 0), 0, t + 3);
      BAR8; WAIT_L8(0); MMA8(1, 0, At, B0); BAR8; SCHED8;
      STAGE8B(SB8(1, 1), 1, t + 3);
      WAIT_V8(6); BAR8; MMA8(1, 1, At, B1); BAR8;
    }
    if (tr) proj_epi<WHICH, true>(p, layer, acc, tn, tm); else proj_epi<WHICH, false>(p, layer, acc, tn, tm);
    ZACC();
    cP = nP; cQ = nQ; tn = ntn; tm = ntm; tr = ntr;
  }
  WAIT_V8(0);
  if (wr == 0) BAR8;
  __syncthreads();
#undef SA8
#undef SB8
#undef STG
#undef STAGE8A
#undef STAGE8B
#undef LDA8
#undef LDB8
#undef MMA8
#undef ZACC
}

__device__ __forceinline__ void phase_retB(PP p, LAS char* shm, int bid, int nb) {
  for (int t = bid; t < 768; t += nb) {
    const int tid = opaque_tid(), wid = tid >> 6, lane = tid & 63, wr = wid >> 2, wc = wid & 3, fr = lane & 15, fq = lane >> 4;
    f32x4 acc[8][4];
    zero_acc(acc);
    GOp g; g.nk = 4; g.kt0 = 0; g.ksegP = 1 << 28; g.segP = 0;
    if (t < 512) {
      const int et = t & 1, c = (t >> 1) & 15, bh = t >> 5, b = bh >> 3, h = bh & 7;
      g.P = p->kdT + ((long)b * 2048 + h * 256) * SEQ + c * 256; g.ldp = SEQ;
      g.Q = p->vT + ((long)b * 4096 + h * 512 + et * 256) * SEQ + c * 256; g.ldq = SEQ;
      gemm256(shm, g, acc, tid);
      h16* st = p->St + ((long)(bh * 16 + c) * 512 + et * 256) * 256;
#pragma unroll
      for (int m = 0; m < 8; ++m)
#pragma unroll
        for (int n = 0; n < 4; ++n) {
          const int e = wc * 64 + n * 16 + fr, d0 = wr * 128 + m * 16 + fq * 4;
          *(h16x4*)(st + (long)e * 256 + d0) = cvt4(acc[m][n]); __builtin_amdgcn_sched_barrier(0);
        }
    } else {
      const int u = t - 512, c = u & 15, bh = u >> 4, b = bh >> 3, h = bh & 7;
      const float lg = lg2gamma(h);
      g.P = p->kh + ((long)b * SEQ + c * 256) * 2048 + h * 256; g.ldp = 2048;
      g.Q = p->qh + ((long)b * SEQ + c * 256) * 2048 + h * 256; g.ldq = 2048;
      gemm256(shm, g, acc, tid);
      h16* pb = p->Pbuf + ((long)bh * SEQ + c * 256) * 256;
#pragma unroll
      for (int m = 0; m < 8; ++m)
#pragma unroll
        for (int n = 0; n < 4; ++n) {
          const int qi = wc * 64 + n * 16 + fr, k0 = wr * 128 + m * 16 + fq * 4;
          f32x4 r;
#pragma unroll
          for (int j = 0; j < 4; ++j) { const int rel = qi - (k0 + j); r[j] = rel >= 0 ? acc[m][n][j] * exp2f(lg * (float)rel) : 0.f; }
          *(h16x4*)(pb + (long)qi * 256 + k0) = cvt4(r); __builtin_amdgcn_sched_barrier(0);
        }
    }
  }
}

__device__ __forceinline__ void phase_retC(PP p, int bid, int nb) {
  const int tid = threadIdx.x;
  for (int it = bid * NTHR + tid; it < 16 * 16384; it += nb * NTHR) {
    const int bh = it >> 14, idx = (it & 16383) * 8, h = bh & 7;
    const float dc = exp2f(lg2gamma(h) * 256.f);
    h16* base = p->St + (long)bh * 16 * 131072 + idx;
    h16x8 u[16];
#pragma unroll
    for (int c = 0; c < 16; ++c) u[c] = *(const h16x8*)(base + (long)c * 131072);
    float s[8];
#pragma unroll
    for (int j = 0; j < 8; ++j) s[j] = 0.f;
#pragma unroll
    for (int c = 0; c < 16; ++c) {
      h16x8 o;
#pragma unroll
      for (int j = 0; j < 8; ++j) { o[j] = (h16)s[j]; s[j] = s[j] * dc + (float)u[c][j]; }
      *(h16x8*)(base + (long)c * 131072) = o;
    }
  }
}

__device__ __forceinline__ float wave_sum(float v);
__device__ __forceinline__ void phase_retD(PP p, LAS char* shm, int bid, int nb) {
  for (int u = bid; u < 256; u += nb) {
    const int c = u & 15, bh = u >> 4, b = bh >> 3, h = bh & 7;
    const float lg = lg2gamma(h);
    for (int et = 0; et < 2; ++et) {
      const int tid = opaque_tid(), wid = tid >> 6, lane = tid & 63, wr = wid >> 2, wc = wid & 3, fr = lane & 15, fq = lane >> 4;
      f32x4 acc[8][4];
      zero_acc(acc);
      GOp g; g.nk = 4; g.kt0 = 0; g.ksegP = 1 << 28; g.segP = 0;
      g.P = p->St + ((long)(bh * 16 + c) * 512 + et * 256) * 256; g.ldp = 256;
      g.Q = p->qh + ((long)b * SEQ + c * 256) * 2048 + h * 256; g.ldq = 2048;
      gemm256(shm, g, acc, tid);
#pragma unroll
      for (int n = 0; n < 4; ++n) {
        const float dq = exp2f(lg * (float)(wc * 64 + n * 16 + fr + 1));
#pragma unroll
        for (int m = 0; m < 8; ++m) acc[m][n] = acc[m][n] * dq;
      }
      g.P = p->vT + ((long)b * 4096 + h * 512 + et * 256) * SEQ + c * 256; g.ldp = SEQ;
      g.Q = p->Pbuf + ((long)bh * SEQ + c * 256) * 256; g.ldq = 256;
      gemm256(shm, g, acc, tid);
#pragma unroll
      for (int m = 0; m < 8; ++m)
#pragma unroll
        for (int n = 0; n < 4; ++n) {
          const long tok = (long)b * SEQ + c * 256 + wc * 64 + n * 16 + fr;
          const int e0 = h * 512 + et * 256 + wr * 128 + m * 16 + fq * 4;
          *(h16x4*)(p->Obuf + tok * 4096 + e0) = cvt4(acc[m][n]); __builtin_amdgcn_sched_barrier(0);
        }
    }
    asm volatile("s_waitcnt vmcnt(0)" ::: "memory");
    __syncthreads();
    {
      const int tid = opaque_tid(), wid = tid >> 6, lane = tid & 63;
      for (int r0 = wid * 4; r0 < 256; r0 += 32) {
        h16x8 ov[4], zv[4];
#pragma unroll
        for (int q = 0; q < 4; ++q) {
          const long off = ((long)b * SEQ + c * 256 + r0 + q) * 4096 + h * 512 + lane * 8;
          ov[q] = *(const h16x8*)(p->Obuf + off); zv[q] = *(const h16x8*)(p->zh + off);
        }
#pragma unroll
        for (int q = 0; q < 4; ++q) {
          const long off = ((long)b * SEQ + c * 256 + r0 + q) * 4096 + h * 512 + lane * 8;
          float o[8]; float s = 0.f;
#pragma unroll
          for (int j = 0; j < 8; ++j) { o[j] = (float)ov[q][j]; s += o[j]; }
          const float mu = wave_sum(s) * (1.f / 512.f);
          float qq = 0.f;
#pragma unroll
          for (int j = 0; j < 8; ++j) { const float d = o[j] - mu; qq += d * d; }
          const float rstd = rsqrtf(wave_sum(qq) * (1.f / 512.f) + LN_EPS_F);
          h16x8 rr;
#pragma unroll
          for (int j = 0; j < 8; ++j) rr[j] = (h16)((o[j] - mu) * rstd * siluf_((float)zv[q][j]));
          *(h16x8*)(p->Obuf + off) = rr;
        }
      }
    }
    __syncthreads();
  }
}

__device__ __forceinline__ float wave_sum(float v) {
#pragma unroll
  for (int o = 32; o >= 1; o >>= 1) v += __shfl_xor(v, o);
  return v;
}

__device__ __forceinline__ void phase_retE(PP p, int bid, int nb) {
  const int tid = threadIdx.x, wid = tid >> 6, lane = tid & 63;
  for (int row = bid * 8 + wid; row < NTOK * 8; row += nb * 8) {
    const long off = (long)row * 512 + lane * 8;
    h16x8 ov = *(const h16x8*)(p->Obuf + off), zv = *(const h16x8*)(p->zh + off);
    float o[8]; float s = 0.f;
#pragma unroll
    for (int j = 0; j < 8; ++j) { o[j] = (float)ov[j]; s += o[j]; }
    const float mu = wave_sum(s) * (1.f / 512.f);
    float q = 0.f;
#pragma unroll
    for (int j = 0; j < 8; ++j) { const float d = o[j] - mu; q += d * d; }
    const float rstd = rsqrtf(wave_sum(q) * (1.f / 512.f) + LN_EPS_F);
    h16x8 r;
#pragma unroll
    for (int j = 0; j < 8; ++j) r[j] = (h16)((o[j] - mu) * rstd * siluf_((float)zv[j]));
    *(h16x8*)(p->Obuf + off) = r;
  }
}

__device__ __forceinline__ void phase_ln(PP p, int layer, LAS char* shm, int bid, int nb) {
  const int tid = threadIdx.x, wid = tid >> 6, lane = tid & 63;
  const float* gw = p->ln_g[layer]; const float* bw = p->ln_b[layer];
  float* dst = (layer == 3) ? p->out : p->xres;
  float4 gg8[8], bb8[8];
#pragma unroll
  for (int i = 0; i < 8; ++i) { gg8[i] = *(const float4*)(gw + i * 256 + lane * 4); bb8[i] = *(const float4*)(bw + i * 256 + lane * 4); }
  for (int row0 = bid * 8 + wid; row0 < NTOK; row0 += nb * 16) {
    const int row1 = row0 + nb * 8;
    const bool has1 = row1 < NTOK;
    float4 v[2][8];
#pragma unroll
    for (int i = 0; i < 8; ++i) {
      v[0][i] = *(const float4*)(p->xres + (long)row0 * DM + i * 256 + lane * 4);
      v[1][i] = has1 ? *(const float4*)(p->xres + (long)row1 * DM + i * 256 + lane * 4) : make_float4(0.f, 0.f, 0.f, 0.f);
    }
#pragma unroll
    for (int q = 0; q < 2; ++q) {
      const int row = q ? row1 : row0;
      float s = 0.f;
#pragma unroll
      for (int i = 0; i < 8; ++i) s += v[q][i].x + v[q][i].y + v[q][i].z + v[q][i].w;
      const float mu = wave_sum(s) * (1.f / 2048.f);
      float qq = 0.f;
#pragma unroll
      for (int i = 0; i < 8; ++i) { float a = v[q][i].x - mu, b = v[q][i].y - mu, c = v[q][i].z - mu, d = v[q][i].w - mu; qq += a * a + b * b + c * c + d * d; }
      const float rstd = rsqrtf(wave_sum(qq) * (1.f / 2048.f) + LN_EPS_F);
      if (q == 0 || has1) {
#pragma unroll
        for (int i = 0; i < 8; ++i) {
          const int col = i * 256 + lane * 4;
          const float4 gg = gg8[i], bb = bb8[i];
          float4 r; r.x = (v[q][i].x - mu) * rstd * gg.x + bb.x; r.y = (v[q][i].y - mu) * rstd * gg.y + bb.y; r.z = (v[q][i].z - mu) * rstd * gg.z + bb.z; r.w = (v[q][i].w - mu) * rstd * gg.w + bb.w;
          *(float4*)(dst + (long)row * DM + col) = r;
          h16x4 hv; hv[0] = (h16)r.x; hv[1] = (h16)r.y; hv[2] = (h16)r.z; hv[3] = (h16)r.w;
          *(h16x4*)(p->xh + (long)row * DM + col) = hv;
        }
      }
    }
  }
  __syncthreads();
  int tb = 0;
  if (layer == 0) {
    conv_job(shm, p->ret_w_in[1], 2048, 12288, 12288, p->wA, tb, bid, nb);
    conv_job(shm, p->ret_w_out[1], 4096, 2048, 2048, p->wB, tb, bid, nb);
  } else if (layer == 1) {
    conv_job(shm, p->w_kv, 2048, 3840, 3840, p->wA, tb, bid, nb);
    conv_job(shm, p->nsa_w_in[0], 2048, 9264, 9472, p->wA + (long)3840 * 2048, tb, bid, nb);
    conv_job(shm, p->nsa_w_out[0], 2048, 2048, 2048, p->wB, tb, bid, nb);
  } else if (layer == 2) {
    conv_job(shm, p->nsa_w_in[1], 2048, 9264, 9472, p->wA + (long)3840 * 2048, tb, bid, nb);
    conv_job(shm, p->nsa_w_out[1], 2048, 2048, 2048, p->wB, tb, bid, nb);
  }
}

__device__ __forceinline__ void phase_cmp1(PP p, LAS char* shm, int bid, int nb) {
  for (int t = bid; t < 256; t += nb) {
    const int tid = opaque_tid(), wid = tid >> 6, lane = tid & 63, wr = wid >> 2, wc = wid & 3, fr = lane & 15, fq = lane >> 4;
    const int kv = t >> 7, bg = (t >> 4) & 7, sp = t & 15, b = bg >> 2, gq = bg & 3;
    f32x4 acc[8][4];
    zero_acc(acc);
    GOp g;
    g.ldp = 16 * KV_LD; g.segP = KV_LD;
    if (kv == 0) { g.P = p->kvh + (long)b * SEQ * KV_LD + gq * 192; g.ksegP = 3; g.nk = 6; g.kt0 = 6 * sp; g.Q = p->ck1T; g.ldq = 6144; }
    else { g.P = p->kvh + (long)b * SEQ * KV_LD + 768 + gq * 128; g.ksegP = 2; g.nk = 4; g.kt0 = 4 * sp; g.Q = p->cv1T; g.ldq = 4096; }
    gemm256(shm, g, acc, tid);
    float* pt = p->part + (long)t * 65536;
#pragma unroll
    for (int m = 0; m < 8; ++m)
#pragma unroll
      for (int n = 0; n < 4; ++n) {
        *(f32x4*)(pt + (long)(wc * 64 + n * 16 + fr) * 256 + wr * 128 + m * 16 + fq * 4) = acc[m][n]; __builtin_amdgcn_sched_barrier(0);
      }
  }
}

__device__ __forceinline__ void phase_cmp2(PP p, LAS char* shm, int bid, int nb) {
  const int tid = threadIdx.x;
  LAS float* hid = (LAS float*)shm;
  for (int t = bid; t < 512; t += nb) {
    const int kv = t >> 8, bg = (t >> 5) & 7, ng = t & 31;
    const float* pt = p->part + (long)(kv * 128 + bg * 16) * 65536;
    const float* bias = p->biasp + (kv ? 32 * 256 : 0);
#pragma unroll
    for (int i = 0; i < 4; ++i) {
      const int e = tid + i * 512, nl = e & 7, hh = e >> 3;
      float s = 0.f;
      for (int pp = 0; pp < 32; ++pp) s += bias[pp * 256 + hh];
      for (int sp = 0; sp < 16; ++sp) s += pt[(long)sp * 65536 + (long)hh * 256 + ng * 8 + nl];
      hid[nl * 256 + hh] = siluf_(s);
    }
    __syncthreads();
    if (kv == 0) {
#pragma unroll
      for (int i = 0; i < 3; ++i) {
        const int o = tid + i * 512, nl = o / 192, j = o % 192, n = ng * 8 + nl;
        float s = 0.f;
        for (int hh = 0; hh < 256; ++hh) s += hid[nl * 256 + hh] * p->w_ck2[hh * 192 + j];
        p->kc[((long)bg * 256 + n) * 192 + j] = (n < 255) ? (h16)s : (h16)0.f;
      }
    } else {
#pragma unroll
      for (int i = 0; i < 2; ++i) {
        const int o = tid + i * 512, nl = o >> 7, j = o & 127, n = ng * 8 + nl;
        float s = 0.f;
        for (int hh = 0; hh < 256; ++hh) s += hid[nl * 256 + hh] * p->w_cv2[hh * 128 + j];
        p->vcT[((long)bg * 128 + j) * 256 + n] = (n < 255) ? (h16)s : (h16)0.f;
      }
    }
    __syncthreads();
  }
}

__device__ __forceinline__ void phase_select(PP p, LAS char* shm, int bid, int nb) {
  LAS float* psel = (LAS float*)(shm + 102400);
  for (int u = bid; u < 1024; u += nb) {
    const int tid = opaque_tid(), wid = tid >> 6, lane = tid & 63, fr = lane & 15, fq = lane >> 4;
    const int r = wid >> 1, th = wid & 1;
    const int bg = u >> 7, tile = u & 127, b = bg >> 2, gq = bg & 3, t0 = tile * 32;
    const h16* kcb = p->kc + (long)bg * 256 * 192;
    { const int row = tid >> 1, c0 = (tid & 1) * 12;
      const h16* src = kcb + row * 192 + c0 * 8; LAS char* dl = shm + row * 400 + c0 * 16;
#pragma unroll
      for (int i = 0; i < 12; ++i) *(LAS u32x4*)(dl + i * 16) = *(const u32x4*)(src + i * 8); }
    const int tq = t0 + th * 16 + fr;
    const h16* qrow = p->proj + ((long)b * SEQ + tq) * NSA_LD + (gq * 4 + r) * 192 + fq * 8;
    h16x8 qf[6];
#pragma unroll
    for (int ks = 0; ks < 6; ++ks) qf[ks] = *(const h16x8*)(qrow + ks * 32);
    __syncthreads();
    f32x4 s[16];
#pragma unroll
    for (int mt = 0; mt < 16; ++mt) s[mt] = (f32x4){0.f, 0.f, 0.f, 0.f};
#pragma unroll
    for (int ks = 0; ks < 6; ++ks)
#pragma unroll
      for (int mt = 0; mt < 16; ++mt) {
        const h16x8 kf = *(const LAS h16x8*)(shm + (mt * 16 + fr) * 400 + (ks * 32 + fq * 8) * 2);
        s[mt] = __builtin_amdgcn_mfma_f32_16x16x32_f16(kf, qf[ks], s[mt], 0, 0, 0);
      }
    float mx = -1e30f;
#pragma unroll
    for (int mt = 0; mt < 16; ++mt)
#pragma unroll
      for (int j = 0; j < 4; ++j) {
        const int n = mt * 16 + fq * 4 + j;
        const bool valid = (n < 255) && (16 * n + 31 <= tq);
        const float v = valid ? s[mt][j] : -1e30f;
        s[mt][j] = v; mx = fmaxf(mx, v);
      }
    mx = fmaxf(mx, __shfl_xor(mx, 16)); mx = fmaxf(mx, __shfl_xor(mx, 32));
    float l = 0.f;
#pragma unroll
    for (int mt = 0; mt < 16; ++mt)
#pragma unroll
      for (int j = 0; j < 4; ++j) { const float pv = (s[mt][j] > -1e29f) ? __builtin_amdgcn_exp2f(s[mt][j] - mx) : 0.f; s[mt][j] = pv; l += pv; }
    l += __shfl_xor(l, 16); l += __shfl_xor(l, 32);
    const float inv = l > 0.f ? 1.f / l : 0.f;
#pragma unroll
    for (int mt = 0; mt < 16; ++mt) {
      const float own = s[mt][0] + 2.f * (s[mt][1] + s[mt][2] + s[mt][3]);
      const float x1 = __shfl(s[mt][0], (lane + 16) & 63);
      const float nx = (mt < 15) ? s[(mt + 1) & 15][0] : 0.f;
      const float x2 = __shfl(nx, (lane + 16) & 63);
      const float val = (own + (fq < 3 ? x1 : x2)) * inv;
      psel[(r * 32 + th * 16 + fr) * 64 + mt * 4 + fq] = val;
    }
    __syncthreads();
#pragma unroll
    for (int i = 0; i < 4; ++i) {
      const int tl = wid * 4 + i, t = t0 + tl, cur = t >> 6, j = lane;
      const float ps = psel[(0 * 32 + tl) * 64 + j] + psel[(1 * 32 + tl) * 64 + j] + psel[(2 * 32 + tl) * 64 + j] + psel[(3 * 32 + tl) * 64 + j];
      const bool forced = (j == 0) || (j == cur) || (j == cur - 1);
      const float score = forced ? 1e9f : (j <= cur ? ps : -1.0f);
      int rank = 0;
      for (int k = 0; k < 64; ++k) { const float sk = __shfl(score, k); rank += (sk > score || (sk == score && k < j)) ? 1 : 0; }
      const u64 mk = __ballot(rank < 16);
      if (lane == 0) p->masks[(long)bg * SEQ + t] = mk;
    }
    __syncthreads();
  }
}


__device__ __forceinline__ float xr_max(float v) {
  const unsigned u = __float_as_uint(v);
  auto r = __builtin_amdgcn_permlane16_swap(u, u, false, false);
  const float a = fmaxf(__uint_as_float(r[0]), __uint_as_float(r[1]));
  const unsigned ua = __float_as_uint(a);
  auto r2 = __builtin_amdgcn_permlane32_swap(ua, ua, false, false);
  return fmaxf(__uint_as_float(r2[0]), __uint_as_float(r2[1]));
}
__device__ __forceinline__ float xr_sum(float v) {
  const unsigned u = __float_as_uint(v);
  auto r = __builtin_amdgcn_permlane16_swap(u, u, false, false);
  const float a = __uint_as_float(r[0]) + __uint_as_float(r[1]);
  const unsigned ua = __float_as_uint(a);
  auto r2 = __builtin_amdgcn_permlane32_swap(ua, ua, false, false);
  return __uint_as_float(r2[0]) + __uint_as_float(r2[1]);
}
constexpr int FK_OFF = 0, FV_OFF = 25600, FQ_OFF = 44032;
__device__ __forceinline__ void flash_branch(PP p, LAS char* shm, int branch, int b, int gq, int t0, const h16x8 (&qf)[2][6]) {
  const int tid = opaque_tid(), wid = tid >> 6, lane = tid & 63, fr = lane & 15, fq = lane >> 4;
  const int r = wid >> 1, th = wid & 1, bg = b * 4 + gq, hd = gq * 4 + r;
  const int cur = t0 >> 6;
  const h16* Kb; long ldk; const h16* VTb; long ldvt; int jlo, jhi;
  if (branch == 0) { Kb = p->kc + (long)bg * 256 * 192; ldk = 192; VTb = p->vcT + (long)bg * 128 * 256; ldvt = 256; jlo = 0; jhi = (t0 + 32) >> 10; if (jhi > 3) jhi = 3; }
  else if (branch == 1) { Kb = p->kvh + (long)b * SEQ * KV_LD + 1280 + gq * 192; ldk = KV_LD; VTb = p->vselT + ((long)b * 512 + gq * 128) * SEQ; ldvt = SEQ; jlo = 0; jhi = cur; }
  else { Kb = p->kvh + (long)b * SEQ * KV_LD + 2560 + gq * 192; ldk = KV_LD; VTb = p->vwinT + ((long)b * 512 + gq * 128) * SEQ; ldvt = SEQ; jlo = cur - 8 > 0 ? cur - 8 : 0; jhi = cur; }
  int tq[2]; u64 mk[2];
#pragma unroll
  for (int nt = 0; nt < 2; ++nt) { tq[nt] = t0 + th * 32 + nt * 16 + fr; mk[nt] = (branch == 1) ? p->masks[(long)bg * SEQ + tq[nt]] : 0ull; }
  f32x4 O[8][2];
#pragma unroll
  for (int et = 0; et < 8; ++et) { O[et][0] = (f32x4){0.f, 0.f, 0.f, 0.f}; O[et][1] = (f32x4){0.f, 0.f, 0.f, 0.f}; }
  float mrun[2] = {-1e30f, -1e30f}, lrun[2] = {0.f, 0.f};
  int koff[4], voff[3];
#pragma unroll
  for (int i = 0; i < 4; ++i) { const int c = (wid + 8 * i) * 64 + lane, row = c / 25, ch = c % 25; koff[i] = row * (int)ldk + (ch < 24 ? ch : 23) * 8; }
#pragma unroll
  for (int i = 0; i < 3; ++i) { const int c = (wid + 8 * i) * 64 + lane, e = c / 9, ch = c % 9; voff[i] = e * (int)ldvt + (ch < 8 ? ch : 7) * 8; }
#define F_STAGE(j, buf) do { \
    const h16* kb_ = Kb + (long)(j) * 64 * ldk; const h16* vb_ = VTb + (long)(j) * 64; LAS char* lb_ = shm + (buf) * 44032; \
    _Pragma("unroll") for (int i = 0; i < 4; ++i) if (wid + 8 * i < 25) __builtin_amdgcn_global_load_lds((const unsigned*)(kb_ + koff[i]), (LAS unsigned*)(lb_ + FK_OFF + (wid + 8 * i) * 1024), 16, 0, 0); \
    _Pragma("unroll") for (int i = 0; i < 3; ++i) if (wid + 8 * i < 18) __builtin_amdgcn_global_load_lds((const unsigned*)(vb_ + voff[i]), (LAS unsigned*)(lb_ + FV_OFF + (wid + 8 * i) * 1024), 16, 0, 0); } while (0)
  F_STAGE(jlo, 0);
  asm volatile("s_waitcnt vmcnt(0)" ::: "memory");
  __syncthreads();
  for (int j = jlo; j <= jhi; ++j) {
    const int cb = (j - jlo) & 1;
    LAS char* lb = shm + cb * 44032;
    if (j + 1 <= jhi) F_STAGE(j + 1, cb ^ 1);
    f32x4 s[4][2];
#pragma unroll
    for (int mt = 0; mt < 4; ++mt) { s[mt][0] = (f32x4){0.f, 0.f, 0.f, 0.f}; s[mt][1] = (f32x4){0.f, 0.f, 0.f, 0.f}; }
#pragma unroll
    for (int ks = 0; ks < 6; ++ks) {
      const h16x8 q0 = qf[0][ks], q1 = qf[1][ks];
#pragma unroll
      for (int mt = 0; mt < 4; ++mt) {
        const h16x8 kf = *(const LAS h16x8*)(lb + FK_OFF + (mt * 16 + fr) * 400 + (ks * 32 + fq * 8) * 2);
        s[mt][0] = __builtin_amdgcn_mfma_f32_16x16x32_f16(kf, q0, s[mt][0], 0, 0, 0);
        s[mt][1] = __builtin_amdgcn_mfma_f32_16x16x32_f16(kf, q1, s[mt][1], 0, 0, 0);
      }
    }
    __builtin_amdgcn_sched_group_barrier(0x100, 4, 0);
#pragma unroll
    for (int i = 0; i < 20; ++i) { __builtin_amdgcn_sched_group_barrier(0x100, 1, 0); __builtin_amdgcn_sched_group_barrier(0x008, 2, 0); }
    __builtin_amdgcn_sched_group_barrier(0x008, 8, 0);
    h16x8 pf[2][2];
    const bool full = (branch == 0) || (branch == 1 && j == cur) || (branch == 2 && (j == cur || j == cur - 8));
#pragma unroll
    for (int nt = 0; nt < 2; ++nt) {
      if (full) {
#pragma unroll
        for (int mt = 0; mt < 4; ++mt)
#pragma unroll
          for (int jj = 0; jj < 4; ++jj) {
            const int key = j * 64 + mt * 16 + fq * 4 + jj;
            bool valid;
            if (branch == 0) valid = (key < 255) && (16 * key + 31 <= tq[nt]);
            else if (branch == 1) valid = ((mk[nt] >> j) & 1ull) && (key <= tq[nt]);
            else valid = (key <= tq[nt]) && (tq[nt] - key < 512);
            s[mt][nt][jj] = valid ? s[mt][nt][jj] : -1e30f;
          }
      } else if (branch == 1) {
        const bool selb = (mk[nt] >> j) & 1ull;
#pragma unroll
        for (int mt = 0; mt < 4; ++mt)
#pragma unroll
          for (int jj = 0; jj < 4; ++jj) s[mt][nt][jj] = selb ? s[mt][nt][jj] : -1e30f;
      }
      float mx = fmaxf(fmaxf(s[0][nt][0], s[0][nt][1]), fmaxf(s[0][nt][2], s[0][nt][3]));
#pragma unroll
      for (int mt = 1; mt < 4; ++mt) mx = fmaxf(mx, fmaxf(fmaxf(s[mt][nt][0], s[mt][nt][1]), fmaxf(s[mt][nt][2], s[mt][nt][3])));
      mx = xr_max(mx);
      const float mold = mrun[nt];
      const float mnew = fmaxf(mold, mx);
      const float msafe = fmaxf(mnew, -1e29f);
      mrun[nt] = mnew;
      float rs = 0.f;
#pragma unroll
      for (int mt = 0; mt < 4; ++mt)
#pragma unroll
        for (int jj = 0; jj < 4; ++jj) { const float pv = __builtin_amdgcn_exp2f(s[mt][nt][jj] - msafe); s[mt][nt][jj] = pv; rs += pv; }
      rs = xr_sum(rs);
      if (__builtin_amdgcn_ballot_w64(mnew > mold) != 0ull) {
        const float alpha = __builtin_amdgcn_exp2f(mold - mnew);
        lrun[nt] = lrun[nt] * alpha + rs;
#pragma unroll
        for (int et = 0; et < 8; ++et) O[et][nt] = O[et][nt] * alpha;
      } else {
        lrun[nt] += rs;
      }
#pragma unroll
      for (int k2 = 0; k2 < 2; ++k2)
#pragma unroll
        for (int jj = 0; jj < 4; ++jj) { pf[nt][k2][jj] = (h16)s[2 * k2][nt][jj]; pf[nt][k2][4 + jj] = (h16)s[2 * k2 + 1][nt][jj]; }
    }
#pragma unroll
    for (int et = 0; et < 8; ++et)
#pragma unroll
      for (int k2 = 0; k2 < 2; ++k2) {
        const LAS char* va = lb + FV_OFF + (et * 16 + fr) * 144 + (k2 * 32 + fq * 4) * 2;
        const h16x4 lo = *(const LAS h16x4*)va, hi = *(const LAS h16x4*)(va + 32);
        h16x8 vf; vf[0] = lo[0]; vf[1] = lo[1]; vf[2] = lo[2]; vf[3] = lo[3]; vf[4] = hi[0]; vf[5] = hi[1]; vf[6] = hi[2]; vf[7] = hi[3];
        O[et][0] = __builtin_amdgcn_mfma_f32_16x16x32_f16(vf, pf[0][k2], O[et][0], 0, 0, 0);
        O[et][1] = __builtin_amdgcn_mfma_f32_16x16x32_f16(vf, pf[1][k2], O[et][1], 0, 0, 0);
      }
    __builtin_amdgcn_sched_group_barrier(0x100, 4, 0);
#pragma unroll
    for (int i = 0; i < 14; ++i) { __builtin_amdgcn_sched_group_barrier(0x100, 2, 0); __builtin_amdgcn_sched_group_barrier(0x008, 2, 0); }
    __builtin_amdgcn_sched_group_barrier(0x008, 4, 0);
    asm volatile("s_waitcnt vmcnt(0)" ::: "memory");
    __syncthreads();
  }
#undef F_STAGE
#pragma unroll
  for (int nt = 0; nt < 2; ++nt) {
    const long tok = (long)b * SEQ + tq[nt];
    const h16* pr = p->proj + tok * NSA_LD;
    const float gt = sigmoidf_((float)pr[9216 + branch * 16 + hd]);
    const float inv = lrun[nt] > 0.f ? gt / lrun[nt] : 0.f;
#pragma unroll
    for (int et = 0; et < 8; ++et) {
      const int e0 = hd * 128 + et * 16 + fq * 4;
      const h16x4 zv = *(const h16x4*)(pr + 3072 + branch * 2048 + e0);
      h16* mp = p->mixed + tok * DM + e0;
      f32x4 r;
#pragma unroll
      for (int jj = 0; jj < 4; ++jj) r[jj] = O[et][nt][jj] * inv * siluf_((float)zv[jj]);
      if (branch != 0) { const h16x4 old = *(const h16x4*)mp; r[0] += (float)old[0]; r[1] += (float)old[1]; r[2] += (float)old[2]; r[3] += (float)old[3]; }
      *(h16x4*)mp = cvt4(r);
    }
  }
}

__device__ __forceinline__ void phase_attn(PP p, LAS char* shm, int bid, int nb) {
  for (int u0 = bid; u0 < 256; u0 += nb) {
    const int u = (nb == 256) ? ((u0 & 7) << 5 | (u0 >> 3)) : u0;
    const int bg = u >> 5, pr = u & 31, b = bg >> 2, gq = bg & 3;
    for (int half = 0; half < 2; ++half) {
      const int tile = half ? 63 - pr : pr, t0 = tile * 64;
      h16x8 qf[2][6];
      { const int tid = opaque_tid(), wid = tid >> 6, lane = tid & 63, fr = lane & 15, fq = lane >> 4, r = wid >> 1, th = wid & 1;
#pragma unroll
        for (int nt = 0; nt < 2; ++nt) {
          const h16* qrow = p->proj + ((long)b * SEQ + t0 + th * 32 + nt * 16 + fr) * NSA_LD + (gq * 4 + r) * 192 + fq * 8;
#pragma unroll
          for (int ks = 0; ks < 6; ++ks) qf[nt][ks] = *(const h16x8*)(qrow + ks * 32);
        } }
      flash_branch(p, shm, 0, b, gq, t0, qf);
      flash_branch(p, shm, 1, b, gq, t0, qf);
      flash_branch(p, shm, 2, b, gq, t0, qf);
    }
  }
}


#define XB_TMO      128
#define XB_XCNT(j)  (256  + 64 * (j))
#define XB_XSUB(j)  (1280 + 64 * (j))
#define XB_XGEN(j)  (2304 + 64 * (j))
#define XB_TOP      3328
#define XB_TOPGEN   3392
#define XCD_BAR_WORDS 3456
#define XB_SPIN_CAP (1u << 18)
__device__ __forceinline__ unsigned xb_ld(unsigned* p)              { return __hip_atomic_load(p, __ATOMIC_RELAXED, __HIP_MEMORY_SCOPE_AGENT); }
__device__ __forceinline__ unsigned xb_add(unsigned* p, unsigned v) { return __hip_atomic_fetch_add(p, v, __ATOMIC_RELAXED, __HIP_MEMORY_SCOPE_AGENT); }
__device__ __forceinline__ unsigned xb_xcc_id() { return (unsigned)__builtin_amdgcn_s_getreg((3 << 11) | 20) & 0xFu; }
#define XB_SPIN(cond, bar) do { unsigned _sp = 0; while (cond) { __builtin_amdgcn_s_sleep(1); \
    if ((++_sp & 255u) == 0u) { if (xb_ld(&(bar)[XB_TMO])) break; if (_sp > XB_SPIN_CAP) { atomicAdd(&(bar)[XB_TMO], 1u); break; } } } } while (0)
struct XcdBarrier { unsigned* bar; unsigned x; volatile LAS unsigned* st; };
__device__ __forceinline__ XcdBarrier xcd_barrier_post(unsigned* bar, volatile LAS unsigned* st) {
  XcdBarrier b; b.bar = bar; b.x = xb_xcc_id(); b.st = st;
  if (threadIdx.x == 0) (void)xb_add(&bar[XB_XCNT(b.x)], 1u);
  return b;
}
__device__ __forceinline__ void xcd_barrier_complete(unsigned* bar, unsigned x, unsigned& nloc, unsigned& nx) {
  const unsigned G = gridDim.x * gridDim.y * gridDim.z;
  unsigned sum, cnt, mine, sp = 0u;
  for (;;) {
    sum = 0u; cnt = 0u; mine = 0u;
#pragma unroll
    for (unsigned j = 0; j < 16; ++j) { const unsigned c = xb_ld(&bar[XB_XCNT(j)]); sum += c; cnt += (c > 0u) ? 1u : 0u; mine = (j == x) ? c : mine; }
    if (sum == G) break;
    __builtin_amdgcn_s_sleep(1);
    if ((++sp & 255u) == 0u) { if (xb_ld(&bar[XB_TMO])) break; if (sp > XB_SPIN_CAP) { atomicAdd(&bar[XB_TMO], 1u); break; } }
  }
  nloc = mine > 0u ? mine : 1u; nx = cnt > 0u ? cnt : 1u;
}
__device__ __forceinline__ void xcd_barrier(const XcdBarrier& b) {
  asm volatile("s_waitcnt vmcnt(0)" ::: "memory");
  __syncthreads();
  if (threadIdx.x == 0) {
    unsigned* bar = b.bar;
    __builtin_amdgcn_s_waitcnt(0);
    unsigned nloc = b.st[0], nx = b.st[1];
    if (nloc == 0u) { xcd_barrier_complete(bar, b.x, nloc, nx); b.st[0] = nloc; b.st[1] = nx; }
    const unsigned old = xb_add(&bar[XB_XSUB(b.x)], 1u);
    const unsigned gen = old / nloc;
    if (old + 1u == (gen + 1u) * nloc) {
      __builtin_amdgcn_fence(__ATOMIC_RELEASE, "agent");
      asm volatile("s_waitcnt vmcnt(0)" ::: "memory");
      const unsigned og = xb_add(&bar[XB_TOP], 1u);
      const unsigned tg = og / nx;
      if (og + 1u == (tg + 1u) * nx) xb_add(&bar[XB_TOPGEN], 1u);
      else XB_SPIN(xb_ld(&bar[XB_TOPGEN]) == tg, bar);
      __builtin_amdgcn_fence(__ATOMIC_ACQUIRE, "agent");
      xb_add(&bar[XB_XGEN(b.x)], 1u);
      asm volatile("s_waitcnt vmcnt(0)" ::: "memory");
    } else {
      XB_SPIN(xb_ld(&bar[XB_XGEN(b.x)]) == gen, bar);
      __builtin_amdgcn_fence(__ATOMIC_ACQUIRE, "agent");
      asm volatile("s_waitcnt vmcnt(0)" ::: "memory");
    }
  }
  __syncthreads();
}

__global__ void __launch_bounds__(NTHR) mega_kernel(Params pk, int ph_lo, int ph_hi) {
  __shared__ __attribute__((aligned(1024))) char shm_raw[SHM_BYTES];
  LAS char* shm = (LAS char*)shm_raw;
  cg::grid_group grid = cg::this_grid();
  const int bid = blockIdx.x, nb = gridDim.x;
  if (threadIdx.x < 4) ((LAS unsigned*)(shm + SHM_BYTES - 16))[threadIdx.x] = 0u;
  __syncthreads();
  XcdBarrier xb;
  { PP p0 = (PP)__builtin_amdgcn_kernarg_segment_ptr(); xb = xcd_barrier_post(p0->xbar, (volatile LAS unsigned*)(shm + SHM_BYTES - 16)); }
#define PH(k, call) if (ph_lo <= (k) && (k) < ph_hi) { PP p = (PP)__builtin_amdgcn_kernarg_segment_ptr(); asm volatile("" : "+s"(p)); call; if ((k) + 1 < ph_hi) xcd_barrier(xb); }
  if (ph_lo < 0) { asm volatile("s_waitcnt vmcnt(0)" ::: "memory"); __syncthreads(); grid.sync(); }
  PH(0, phase_prep(p, shm, bid, nb))
  PH(1, phase_proj<0>(p, 0, shm, bid, nb))
  PH(2, phase_retB(p, shm, bid, nb))
  PH(3, phase_retC(p, bid, nb))
  PH(4, phase_retD(p, shm, bid, nb))
  PH(6, phase_proj<1>(p, 0, shm, bid, nb))
  PH(7, phase_ln(p, 0, shm, bid, nb))
  PH(8, phase_proj<0>(p, 1, shm, bid, nb))
  PH(9, phase_retB(p, shm, bid, nb))
  PH(10, phase_retC(p, bid, nb))
  PH(11, phase_retD(p, shm, bid, nb))
  PH(13, phase_proj<1>(p, 1, shm, bid, nb))
  PH(14, phase_ln(p, 1, shm, bid, nb))
  PH(15, (phase_proj<3>(p, 2, shm, bid, nb), phase_proj<2>(p, 2, shm, bid, nb)))
  PH(16, phase_cmp1(p, shm, bid, nb))
  PH(17, phase_cmp2(p, shm, bid, nb))
  PH(19, phase_select(p, shm, bid, nb))
  PH(20, phase_attn(p, shm, bid, nb))
  PH(21, phase_proj<1>(p, 2, shm, bid, nb))
  PH(22, phase_ln(p, 2, shm, bid, nb))
  PH(23, phase_proj<2>(p, 3, shm, bid, nb))
  PH(24, phase_select(p, shm, bid, nb))
  PH(25, phase_attn(p, shm, bid, nb))
  PH(26, phase_proj<1>(p, 3, shm, bid, nb))
  PH(27, phase_ln(p, 3, shm, bid, nb))
#undef PH
}

extern "C" void kernel_launch(void* const* d_in, const int* in_sizes, int n_in, void* d_out, int out_size, void* d_ws, size_t ws_size, hipStream_t stream) {
  Params p{};
  p.x = (const float*)d_in[0]; p.pos = (const int*)d_in[1];
  p.ret_w_in[0] = (const float*)d_in[2]; p.ret_w_out[0] = (const float*)d_in[3]; p.ln_g[0] = (const float*)d_in[4]; p.ln_b[0] = (const float*)d_in[5];
  p.ret_w_in[1] = (const float*)d_in[6]; p.ret_w_out[1] = (const float*)d_in[7]; p.ln_g[1] = (const float*)d_in[8]; p.ln_b[1] = (const float*)d_in[9];
  p.w_kv = (const float*)d_in[10]; p.pe_k = (const float*)d_in[11]; p.pe_v = (const float*)d_in[12];
  p.w_ck1 = (const float*)d_in[13]; p.w_ck2 = (const float*)d_in[14]; p.w_cv1 = (const float*)d_in[15]; p.w_cv2 = (const float*)d_in[16];
  p.nsa_w_in[0] = (const float*)d_in[17]; p.nsa_w_out[0] = (const float*)d_in[18]; p.ln_g[2] = (const float*)d_in[19]; p.ln_b[2] = (const float*)d_in[20];
  p.nsa_w_in[1] = (const float*)d_in[21]; p.nsa_w_out[1] = (const float*)d_in[22]; p.ln_g[3] = (const float*)d_in[23]; p.ln_b[3] = (const float*)d_in[24];
  p.out = (float*)d_out;
  char* ws = (char*)d_ws; size_t off = 0;
  auto take = [&](size_t bytes) { char* r = ws + off; off += (bytes + 4095) & ~(size_t)4095; return r; };
  p.wA = (h16*)take((size_t)13312 * 2048 * 2);
  p.wB = (h16*)take((size_t)4096 * 2048 * 2);
  p.xres = (float*)take((size_t)NTOK * DM * 4);
  p.xh = (h16*)take((size_t)NTOK * DM * 2);
  p.cs = (float*)take((size_t)NTOK * 256 * 4);
  p.ck1T = (h16*)take((size_t)256 * 6144 * 2);
  p.cv1T = (h16*)take((size_t)256 * 4096 * 2);
  p.biask = (float*)take(1024); p.biasv = (float*)take(1024); p.biasp = (float*)take(65536);
  p.kc = (h16*)take((size_t)8 * 256 * 192 * 2);
  p.vcT = (h16*)take((size_t)8 * 128 * 256 * 2);
  p.masks = (u64*)take((size_t)8 * SEQ * 8);
  const size_t region = off;
  p.kh = (h16*)take((size_t)NTOK * 2048 * 2);
  p.kdT = (h16*)take((size_t)NTOK * 2048 * 2);
  p.Obuf = p.kh;
  p.qh = (h16*)take((size_t)NTOK * 2048 * 2);
  p.vT = (h16*)take((size_t)NTOK * 4096 * 2);
  p.zh = (h16*)take((size_t)NTOK * 4096 * 2);
  p.St = (h16*)take((size_t)16 * 16 * 131072 * 2);
  p.Pbuf = (h16*)take((size_t)16 * SEQ * 256 * 2);
  off = region;
  p.kvh = (h16*)take((size_t)NTOK * KV_LD * 2 + 65536 * 4);
  p.vselT = (h16*)take((size_t)2 * 512 * SEQ * 2);
  p.vwinT = (h16*)take((size_t)2 * 512 * SEQ * 2);
  p.mixed = (h16*)take((size_t)NTOK * DM * 2);
  p.proj = (h16*)take((size_t)NTOK * NSA_LD * 2);
  p.part = (float*)take((size_t)256 * 65536 * 4);
  p.xbar = (unsigned*)take(XCD_BAR_WORDS * 4);

  if (off > ws_size) fprintf(stderr, "workspace too small: need %zu have %zu\n", off, ws_size);
  static int grid_blocks = 0;
  if (!grid_blocks) {
    int dev = 0, cus = 0, per_cu = 0;
    (void)hipGetDevice(&dev);
    (void)hipDeviceGetAttribute(&cus, hipDeviceAttributeMultiprocessorCount, dev);
    (void)hipOccupancyMaxActiveBlocksPerMultiprocessor(&per_cu, mega_kernel, NTHR, 0);
    if (per_cu < 1) per_cu = 1;
    grid_blocks = cus * per_cu;
    if (grid_blocks > 256) grid_blocks = 256;
  }
  (void)hipMemsetAsync(p.xbar, 0, XCD_BAR_WORDS * 4, stream);
#if FUSED
  int lo = 0, hi = 28;
  void* args[] = {&p, &lo, &hi};
  hipError_t e = hipLaunchCooperativeKernel((void*)mega_kernel, dim3(grid_blocks), dim3(NTHR), args, 0, stream);
  if (e != hipSuccess) fprintf(stderr, "cooperative launch failed: %s (grid %d)\n", hipGetErrorString(e), grid_blocks);
#else
  for (int ph = 0; ph < 28; ++ph) hipLaunchKernelGGL(mega_kernel, dim3(256), dim3(NTHR), 0, stream, p, ph, ph + 1);
#endif
}
```

```cpp
#include <hip/hip_runtime.h>
#include <hip/hip_cooperative_groups.h>
#include <cstdio>
namespace cg = cooperative_groups;

#ifndef FUSED
#define FUSED 1
#endif

#define LAS __attribute__((address_space(3)))
typedef _Float16 h16;
typedef _Float16 h16x8 __attribute__((ext_vector_type(8)));
typedef _Float16 h16x4 __attribute__((ext_vector_type(4)));
typedef float f32x4 __attribute__((ext_vector_type(4)));
typedef unsigned long long u64;
typedef unsigned u32x4 __attribute__((ext_vector_type(4)));

constexpr int NTHR = 512;
constexpr int SEQ = 4096, NTOK = 8192, DM = 2048;
constexpr int SHM_BYTES = 147456;
constexpr float ALPHA_F = 1.6817928305074290f;
constexpr float LN_EPS_F = 1e-5f;
constexpr float LOG2E = 1.4426950408889634f;
constexpr int NSA_LD = 9472;
constexpr int KV_LD = 3840;

struct Params {
  const float* x; const int* pos;
  const float* ret_w_in[2]; const float* ret_w_out[2];
  const float* ln_g[4]; const float* ln_b[4];
  const float* w_kv; const float* pe_k; const float* pe_v; const float* w_ck1; const float* w_ck2; const float* w_cv1; const float* w_cv2;
  const float* nsa_w_in[2]; const float* nsa_w_out[2];
  float* out;
  h16* wA; h16* wB; float* xres; h16* xh; float* cs; h16* ck1T; h16* cv1T; float* biask; float* biasv; float* biasp;
  h16* qh; h16* kh; h16* kdT; h16* vT; h16* zh; h16* St; h16* Pbuf; h16* Obuf;
  h16* kvh; h16* vselT; h16* vwinT; h16* kc; h16* vcT; float* part; h16* proj; u64* masks; h16* mixed; unsigned* xbar;
};

typedef const __attribute__((address_space(4))) Params* PP;
#define WAIT_V0() asm volatile("s_waitcnt vmcnt(0)" ::: "memory")
__device__ __forceinline__ int opaque_tid() { int t = threadIdx.x; asm volatile("" : "+v"(t)); return t; }

__device__ __forceinline__ int lds_byte(int r, int c) {
  int st = (r >> 4) * 2 + (c >> 5), ob = (r & 15) * 64 + (c & 31) * 2;
  return st * 1024 + (ob ^ (((ob >> 9) & 1) << 5));
}
__device__ __forceinline__ void stage_rc(int b, int& R, int& C) {
  int st = b >> 10, sb = b & 1023, swz = sb ^ (((sb >> 9) & 1) << 5);
  R = (st >> 1) * 16 + swz / 64;
  C = (st & 1) * 32 + (swz % 64) / 2;
}
__device__ __forceinline__ float lg2gamma(int h) { return log1pf(-exp2f(-5.f - (float)h)) * LOG2E; }
__device__ __forceinline__ float sigmoidf_(float v) { return 1.f / (1.f + __expf(-v)); }
__device__ __forceinline__ float siluf_(float v) { return v / (1.f + __expf(-v)); }
__device__ __forceinline__ h16x4 cvt4(f32x4 v) { h16x4 r; r[0] = (h16)v[0]; r[1] = (h16)v[1]; r[2] = (h16)v[2]; r[3] = (h16)v[3]; return r; }

struct GOp { const h16* P; const h16* Q; long ldp, ldq; int nk, kt0, ksegP; long segP; };

__device__ __forceinline__ void gemm256(LAS char* shm, const GOp g, f32x4 (&acc)[8][4], const int tid) {
  const int wid = tid >> 6, lane = tid & 63, wr = wid >> 2, wc = wid & 3, fr = lane & 15, fq = lane >> 4;
  int offP[4], offQ[4];
#pragma unroll
  for (int i = 0; i < 4; ++i) { int R, C; stage_rc(wid * 1024 + i * 8192 + lane * 16, R, C); offP[i] = R * (int)g.ldp + C; offQ[i] = R * (int)g.ldq + C; }
#define G_STAGE(buf, t) do { const int kk_ = g.kt0 + (t); const long kp_ = (long)(kk_ / g.ksegP) * g.segP + (long)(kk_ % g.ksegP) * 64; const long kq_ = (long)kk_ * 64; \
    _Pragma("unroll") for (int i = 0; i < 4; ++i) { \
      __builtin_amdgcn_global_load_lds((const unsigned*)(g.P + offP[i] + kp_), (LAS unsigned*)(shm + (buf) * 65536 + wid * 1024 + i * 8192), 16, 0, 0); \
      __builtin_amdgcn_global_load_lds((const unsigned*)(g.Q + offQ[i] + kq_), (LAS unsigned*)(shm + (buf) * 65536 + 32768 + wid * 1024 + i * 8192), 16, 0, 0); } } while (0)
  G_STAGE(0, 0); WAIT_V0(); __syncthreads();
#pragma unroll 1
  for (int t = 0; t < g.nk; ++t) {
    const int cur = t & 1;
    if (t + 1 < g.nk) G_STAGE(cur ^ 1, t + 1);
#pragma unroll
    for (int ks = 0; ks < 2; ++ks) {
      h16x8 At[8], Bf[4];
#pragma unroll
      for (int m = 0; m < 8; ++m) At[m] = *(const LAS h16x8*)(shm + cur * 65536 + lds_byte(wr * 128 + m * 16 + fr, ks * 32 + fq * 8));
#pragma unroll
      for (int n = 0; n < 4; ++n) Bf[n] = *(const LAS h16x8*)(shm + cur * 65536 + 32768 + lds_byte(wc * 64 + n * 16 + fr, ks * 32 + fq * 8));
#pragma unroll
      for (int m = 0; m < 8; ++m)
#pragma unroll
        for (int n = 0; n < 4; ++n) acc[m][n] = __builtin_amdgcn_mfma_f32_16x16x32_f16(At[m], Bf[n], acc[m][n], 0, 0, 0);
    }
    WAIT_V0(); __syncthreads();
  }
#undef G_STAGE
}
__device__ __forceinline__ void zero_acc(f32x4 (&acc)[8][4]) {
#pragma unroll
  for (int m = 0; m < 8; ++m)
#pragma unroll
    for (int n = 0; n < 4; ++n) acc[m][n] = (f32x4){0.f, 0.f, 0.f, 0.f};
}


__device__ __forceinline__ void gemm8p(LAS char* shm, const h16* __restrict__ A, const int lda, const h16* __restrict__ Bt, const int ldb, const int nt,
                                        f32x4 (&acc)[2][2][4][2], const int tid) {
  constexpr int HTB = 128 * 64 * 2;
#define SA8(b, h) (shm + ((b) * 2 + (h)) * HTB)
#define SB8(b, h) (shm + (4 + (b) * 2 + (h)) * HTB)
  const int wid = tid >> 6, lane = tid & 63, wr = wid >> 2, wc = wid & 3, fr = lane & 15, fq = lane >> 4;
  int oa[2], ob[2];
#pragma unroll
  for (int i = 0; i < 2; ++i) { int R, C; stage_rc((tid & 511) * 16 + i * 8192, R, C); oa[i] = R * lda + C; ob[i] = R * ldb + C; }
#define STAGE8A(P_, half, kt) do { const h16* g_ = A + (long)(half) * 128 * lda + (long)(kt) * 64; \
    _Pragma("unroll") for (int i_ = 0; i_ < 2; ++i_) __builtin_amdgcn_global_load_lds((const unsigned*)(g_ + oa[i_]), (LAS unsigned*)((P_) + wid * 1024 + i_ * 8192), 16, 0, 0); } while (0)
#define STAGE8B(P_, half, kt) do { const h16* g_ = Bt + (long)(half) * 128 * ldb + (long)(kt) * 64; \
    _Pragma("unroll") for (int i_ = 0; i_ < 2; ++i_) __builtin_amdgcn_global_load_lds((const unsigned*)(g_ + ob[i_]), (LAS unsigned*)((P_) + wid * 1024 + i_ * 8192), 16, 0, 0); } while (0)
#define LDA8(dst, b, h) _Pragma("unroll") for (int m = 0; m < 4; ++m) _Pragma("unroll") for (int k = 0; k < 2; ++k) \
    dst[m][k] = *(const LAS h16x8*)(SA8(b, h) + lds_byte(wr * 64 + m * 16 + fr, k * 32 + fq * 8))
#define LDB8(dst, b, h) _Pragma("unroll") for (int n = 0; n < 2; ++n) _Pragma("unroll") for (int k = 0; k < 2; ++k) \
    dst[n][k] = *(const LAS h16x8*)(SB8(b, h) + lds_byte(wc * 32 + n * 16 + fr, k * 32 + fq * 8))
#define MMA8(ai, bj, At_, Bt_) do { __builtin_amdgcn_s_setprio(1); \
    _Pragma("unroll") for (int m = 0; m < 4; ++m) _Pragma("unroll") for (int n = 0; n < 2; ++n) _Pragma("unroll") for (int k = 0; k < 2; ++k) \
      acc[ai][bj][m][n] = __builtin_amdgcn_mfma_f32_16x16x32_f16(At_[m][k], Bt_[n][k], acc[ai][bj][m][n], 0, 0, 0); \
    __builtin_amdgcn_s_setprio(0); } while (0)
#define WAIT_V8(n) asm volatile("s_waitcnt vmcnt(" #n ")" ::: "memory")
#define WAIT_L8(n) asm volatile("s_waitcnt lgkmcnt(" #n ")" ::: "memory")
#define BAR8 __builtin_amdgcn_s_barrier()
#define SCHED8 __builtin_amdgcn_sched_barrier(0)
  h16x8 At[4][2], B0[2][2], B1[2][2];
  WAIT_V8(0);
  STAGE8B(SB8(0, 0), 0, 0); STAGE8A(SA8(0, 0), 0, 0);
  STAGE8B(SB8(0, 1), 1, 0); STAGE8A(SA8(0, 1), 1, 0);
  if (wr == 1) BAR8;
  WAIT_V8(4); BAR8;
  STAGE8B(SB8(1, 0), 0, 1); STAGE8A(SA8(1, 0), 0, 1); STAGE8B(SB8(1, 1), 1, 1);
  WAIT_V8(6); BAR8;
#pragma unroll 1
  for (int t = 0; t < nt - 2; t += 2) {
    LDB8(B0, 0, 0); SCHED8; LDA8(At, 0, 0); STAGE8A(SA8(1, 1), 1, t + 1);
    WAIT_L8(8); BAR8; WAIT_L8(0); MMA8(0, 0, At, B0); BAR8; SCHED8;
    LDB8(B1, 0, 1); STAGE8B(SB8(0, 0), 0, t + 2);
    BAR8; WAIT_L8(0); MMA8(0, 1, At, B1); BAR8;
    LDA8(At, 0, 1); STAGE8A(SA8(0, 0), 0, t + 2);
    BAR8; WAIT_L8(0); MMA8(1, 0, At, B0); BAR8; SCHED8;
    STAGE8B(SB8(0, 1), 1, t + 2);
    WAIT_V8(6); BAR8; MMA8(1, 1, At, B1); BAR8;
    LDB8(B0, 1, 0); SCHED8; LDA8(At, 1, 0); STAGE8A(SA8(0, 1), 1, t + 2);
    WAIT_L8(8); BAR8; WAIT_L8(0); MMA8(0, 0, At, B0); BAR8; SCHED8;
    LDB8(B1, 1, 1); STAGE8B(SB8(1, 0), 0, t + 3);
    BAR8; WAIT_L8(0); MMA8(0, 1, At, B1); BAR8;
    LDA8(At, 1, 1); STAGE8A(SA8(1, 0), 0, t + 3);
    BAR8; WAIT_L8(0); MMA8(1, 0, At, B0); BAR8; SCHED8;
    STAGE8B(SB8(1, 1), 1, t + 3);
    WAIT_V8(6); BAR8; MMA8(1, 1, At, B1); BAR8;
  }
  { LDB8(B0, 0, 0); LDA8(At, 0, 0); STAGE8A(SA8(1, 1), 1, nt - 1);
    BAR8; WAIT_L8(0); MMA8(0, 0, At, B0); BAR8;
    LDB8(B1, 0, 1); BAR8; WAIT_L8(0); MMA8(0, 1, At, B1); BAR8;
    LDA8(At, 0, 1); WAIT_V8(4); BAR8; WAIT_L8(0); MMA8(1, 0, At, B0); MMA8(1, 1, At, B1); BAR8; }
  { LDB8(B0, 1, 0); LDA8(At, 1, 0); WAIT_V8(2); BAR8; WAIT_L8(0); MMA8(0, 0, At, B0); BAR8;
    LDB8(B1, 1, 1); WAIT_V8(0); BAR8; WAIT_L8(0); MMA8(0, 1, At, B1); BAR8;
    LDA8(At, 1, 1); BAR8; WAIT_L8(0); MMA8(1, 0, At, B0); MMA8(1, 1, At, B1); BAR8; }
  if (wr == 0) BAR8;
#undef SA8
#undef SB8
#undef STAGE8A
#undef STAGE8B
#undef LDA8
#undef LDB8
#undef MMA8
}

__device__ __forceinline__ void conv_job(LAS char* shm, const float* __restrict__ src, int K, int N, int Npad, h16* __restrict__ dst, int& tilebase, int bid, int nb) {
  LAS unsigned* tile = (LAS unsigned*)shm;
  const int tid = threadIdx.x;
  const int nkg = K / 256, nnt = Npad / 64, nunits = nkg * nnt;
  const int n4 = tid & 15, kp = tid >> 4, nn = tid >> 3, kq = tid & 7;
  typedef _Float16 h2 __attribute__((ext_vector_type(2)));
  const int start = (int)((((long)bid - tilebase) % nb + nb) % nb);
  float4 a[4], b[4];
#define CV_LOAD(t_) do { const int k0_ = ((t_) % nkg) * 256, n0_ = ((t_) / nkg) * 64; \
    _Pragma("unroll") for (int q = 0; q < 4; ++q) { a[q] = make_float4(0.f, 0.f, 0.f, 0.f); b[q] = a[q]; \
      if (n0_ + 4 * n4 < N) { a[q] = *(const float4*)(src + (long)(k0_ + q * 64 + 2 * kp) * N + n0_ + 4 * n4); \
                               b[q] = *(const float4*)(src + (long)(k0_ + q * 64 + 2 * kp + 1) * N + n0_ + 4 * n4); } } } while (0)
  if (start < nunits) CV_LOAD(start);
  for (int t = start; t < nunits; t += nb) {
    const int k0 = (t % nkg) * 256, n0 = (t / nkg) * 64;
#pragma unroll
    for (int q = 0; q < 4; ++q) {
      LAS unsigned* tq = tile + q * 2112;
      h2 p0 = {(h16)a[q].x, (h16)b[q].x}, p1 = {(h16)a[q].y, (h16)b[q].y}, p2 = {(h16)a[q].z, (h16)b[q].z}, p3 = {(h16)a[q].w, (h16)b[q].w};
      tq[(4 * n4 + 0) * 33 + kp] = __builtin_bit_cast(unsigned, p0);
      tq[(4 * n4 + 1) * 33 + kp] = __builtin_bit_cast(unsigned, p1);
      tq[(4 * n4 + 2) * 33 + kp] = __builtin_bit_cast(unsigned, p2);
      tq[(4 * n4 + 3) * 33 + kp] = __builtin_bit_cast(unsigned, p3);
    }
    __syncthreads();
    if (t + nb < nunits) CV_LOAD(t + nb);
#pragma unroll
    for (int q = 0; q < 4; ++q) {
      const LAS unsigned* tq = tile + q * 2112 + nn * 33 + kq * 4;
      u32x4 o; o[0] = tq[0]; o[1] = tq[1]; o[2] = tq[2]; o[3] = tq[3];
      *(u32x4*)(dst + (long)(n0 + nn) * K + k0 + q * 64 + kq * 8) = o;
    }
    __syncthreads();
  }
#undef CV_LOAD
  tilebase += nunits;
}

__device__ __forceinline__ void phase_prep(PP p, LAS char* shm, int bid, int nb) {
  const int tid = threadIdx.x;
  int tb = 0;
  conv_job(shm, p->ret_w_in[0], 2048, 12288, 12288, p->wA, tb, bid, nb);
  conv_job(shm, p->ret_w_out[0], 4096, 2048, 2048, p->wB, tb, bid, nb);
  conv_job(shm, p->w_ck1, 6144, 256, 256, p->ck1T, tb, bid, nb);
  conv_job(shm, p->w_cv1, 4096, 256, 256, p->cv1T, tb, bid, nb);
  for (long i = ((long)bid * NTHR + tid) * 8; i < (long)NTOK * DM; i += (long)nb * NTHR * 8) {
    float4 a = *(const float4*)(p->x + i), b = *(const float4*)(p->x + i + 4);
    h16x8 o; o[0] = (h16)a.x; o[1] = (h16)a.y; o[2] = (h16)a.z; o[3] = (h16)a.w; o[4] = (h16)b.x; o[5] = (h16)b.y; o[6] = (h16)b.z; o[7] = (h16)b.w;
    *(h16x8*)(p->xh + i) = o;
  }
  for (int i = bid * NTHR + tid; i < NTOK * 128; i += nb * NTHR) {
    const int tok = i >> 7, f = i & 127;
    const double invf = exp2(-((double)f / 127.0) * 13.287712379549449);
    const float invf32 = (float)invf;
    const float ang = (float)p->pos[tok] * invf32;
    double a = (double)ang;
    const double k = rint(a * 0.63661977236758134308);
    const double r = (a - k * 1.5707963267948966192) - k * 6.123233995736766e-17;
    const double r2 = r * r;
    double sn = r * (1.0 + r2 * (-1.0 / 6 + r2 * (1.0 / 120 + r2 * (-1.0 / 5040 + r2 * (1.0 / 362880 + r2 * (-1.0 / 39916800 + r2 * (1.0 / 6227020800.0)))))));
    double cn = 1.0 + r2 * (-0.5 + r2 * (1.0 / 24 + r2 * (-1.0 / 720 + r2 * (1.0 / 40320 + r2 * (-1.0 / 3628800 + r2 * (1.0 / 479001600.0 + r2 * (-1.0 / 87178291200.0)))))));
    const int q = ((int)k) & 3;
    double c, s;
    if (q == 0) { c = cn; s = sn; } else if (q == 1) { c = -sn; s = cn; } else if (q == 2) { c = -cn; s = -sn; } else { c = sn; s = -cn; }
    p->cs[(long)i * 2] = (float)c; p->cs[(long)i * 2 + 1] = (float)s;
  }
  if (bid < 64) {
    const bool isk = (bid < 32); const int part = bid & 31;
    const float* pe = isk ? p->pe_k : p->pe_v; const float* w1 = isk ? p->w_ck1 : p->w_cv1; const int rng = isk ? 192 : 128;
    LAS float* red = (LAS float*)(shm + 40960);
    const int j = tid & 255, half = tid >> 8;
    float s = 0.f;
    const int i0 = part * rng + half * (rng / 2);
    for (int i = i0; i < i0 + rng / 2; ++i) s += pe[i] * w1[(long)i * 256 + j];
    red[tid] = s;
    __syncthreads();
    if (tid < 256) p->biasp[(bid) * 256 + tid] = red[tid] + red[tid + 256];
    __syncthreads();
  }
}

__device__ __forceinline__ void st_pair16(h16* p0, h16* p1, h16x4 v0, h16x4 v1, int fq) {
  typedef unsigned u32x2_t __attribute__((ext_vector_type(2)));
  const u32x2_t a = __builtin_bit_cast(u32x2_t, v0), b = __builtin_bit_cast(u32x2_t, v1);
  auto lo = __builtin_amdgcn_permlane16_swap(a[0], b[0], false, false);
  auto hi = __builtin_amdgcn_permlane16_swap(a[1], b[1], false, false);
  u32x4 o; o[0] = lo[0]; o[1] = hi[0]; o[2] = lo[1]; o[3] = hi[1];
  h16* dst = (fq & 1) ? (p1 - 4) : p0;
  *(u32x4*)dst = o;
}
template <int WHICH, bool tr>
__device__ __forceinline__ void proj_epi(PP p, int layer, const f32x4 (&acc)[2][2][4][2], const int tn, const int tm) {
  const int K = (WHICH == 1 && layer < 2) ? 4096 : 2048;
  const h16* Wt = (WHICH == 1) ? p->wB : (WHICH == 2) ? (p->wA + (long)3840 * 2048) : p->wA;
  const h16* A = (WHICH == 1) ? (layer < 2 ? p->Obuf : p->mixed) : p->xh;
  const long lda = K;
  {
    const int tid = opaque_tid(), wid = tid >> 6, lane = tid & 63, wr = wid >> 2, wc = wid & 3, fr = lane & 15, fq = lane >> 4;
    const int b = tm >> 4;
    if (tr) {
      h16* outT; long nf; int col0;
      if (WHICH == 0) { outT = p->vT; nf = 4096; col0 = (tn - 16) * 256; }
      else { outT = (tn < 10) ? p->vselT : p->vwinT; nf = 512; col0 = (tn < 10) ? (tn - 8) * 256 : (tn - 13) * 256; }
#pragma unroll
      for (int m = 0; m < 8; ++m)
#pragma unroll
        for (int n2 = 0; n2 < 2; ++n2) {
          const int feat0 = col0 + n2 * 128 + wc * 32 + fr;
          const int tl = (tm & 15) * 256 + (m >> 2) * 128 + wr * 64 + (m & 3) * 16 + fq * 4;
          h16* p0 = outT + ((long)b * nf + feat0) * SEQ + tl;
          st_pair16(p0, p0 + (long)16 * SEQ, cvt4(acc[m >> 2][n2][m & 3][0]), cvt4(acc[m >> 2][n2][m & 3][1]), fq); __builtin_amdgcn_sched_barrier(0);
        }
    } else {
      if (WHICH == 1) {
        const float* xin = (layer == 0) ? p->x : p->xres;
#pragma unroll
        for (int mp = 0; mp < 4; ++mp) {
          float4 xv[2][4];
#pragma unroll
          for (int mi = 0; mi < 2; ++mi)
#pragma unroll
            for (int n = 0; n < 4; ++n) {
              const int m = mp * 2 + mi;
              const long tok = tm * 256 + (n >> 1) * 128 + wc * 32 + (n & 1) * 16 + fr;
              xv[mi][n] = *(const float4*)(xin + tok * DM + tn * 256 + (m >> 2) * 128 + wr * 64 + (m & 3) * 16 + fq * 4);
            }
#pragma unroll
          for (int mi = 0; mi < 2; ++mi)
#pragma unroll
            for (int n = 0; n < 4; ++n) {
              const int m = mp * 2 + mi;
              const long tok = tm * 256 + (n >> 1) * 128 + wc * 32 + (n & 1) * 16 + fr;
              const long o = tok * DM + tn * 256 + (m >> 2) * 128 + wr * 64 + (m & 3) * 16 + fq * 4;
              const f32x4 a = acc[m >> 2][n >> 1][m & 3][n & 1];
              float4 r; r.x = ALPHA_F * xv[mi][n].x + a[0]; r.y = ALPHA_F * xv[mi][n].y + a[1]; r.z = ALPHA_F * xv[mi][n].z + a[2]; r.w = ALPHA_F * xv[mi][n].w + a[3];
              *(float4*)(p->xres + o) = r;
            }
          __builtin_amdgcn_sched_barrier(0);
        }
      } else if (WHICH == 0 && tn < 16) {
        const bool isk = tn >= 8; const int h = tn & 7;
        const float lg = lg2gamma(h);
        h16* outn = isk ? p->kh : p->qh;
        const float sc = isk ? 0.0625f : 1.0f;
#pragma unroll
        for (int m = 0; m < 8; ++m)
#pragma unroll
          for (int n2 = 0; n2 < 2; ++n2) {
            const int f0 = (m >> 2) * 128 + wr * 64 + (m & 3) * 16 + fq * 4;
            f32x4 rr[2];
#pragma unroll
            for (int q = 0; q < 2; ++q) {
              const int idx = n2 * 128 + wc * 32 + q * 16 + fr;
              const long tok = tm * 256 + idx;
              const float4 c = *(const float4*)(p->cs + tok * 256 + f0);
              const f32x4 a = acc[m >> 2][n2][m & 3][q];
              f32x4 r;
              r[0] = (a[0] * c.x - a[1] * c.y) * sc; r[1] = (a[0] * c.y + a[1] * c.x) * sc;
              r[2] = (a[2] * c.z - a[3] * c.w) * sc; r[3] = (a[2] * c.w + a[3] * c.z) * sc;
              rr[q] = r;
              if (isk) {
                const float dk = exp2f(lg * (float)(255 - idx));
                const long tl = (tm & 15) * 256 + idx;
                h16* kd = p->kdT + ((long)b * 2048 + h * 256 + f0) * SEQ + tl;
                kd[0] = (h16)(r[0] * dk); kd[SEQ] = (h16)(r[1] * dk); kd[2 * SEQ] = (h16)(r[2] * dk); kd[3 * SEQ] = (h16)(r[3] * dk);
              }
            }
            h16* p0 = outn + ((long)tm * 256 + n2 * 128 + wc * 32 + fr) * 2048 + h * 256 + f0;
            st_pair16(p0, p0 + 16 * 2048, cvt4(rr[0]), cvt4(rr[1]), fq);
          }
      } else {
        h16* outn; long ldo; int col0; float sc = 1.f;
        if (WHICH == 0) { outn = p->zh; ldo = 4096; col0 = (tn - 32) * 256; }
        else if (WHICH == 2) { outn = p->proj; ldo = NSA_LD; col0 = tn * 256; if (tn < 12) sc = 0.07216878364870322f * LOG2E; }
        else { outn = p->kvh; ldo = KV_LD; col0 = tn * 256; }
#pragma unroll
        for (int m = 0; m < 8; ++m)
#pragma unroll
          for (int n2 = 0; n2 < 2; ++n2) {
            const long tok0 = tm * 256 + n2 * 128 + wc * 32 + fr;
            const int f0 = col0 + (m >> 2) * 128 + wr * 64 + (m & 3) * 16 + fq * 4;
            h16* p0 = outn + tok0 * ldo + f0;
            st_pair16(p0, p0 + 16 * ldo, cvt4(acc[m >> 2][n2][m & 3][0] * sc), cvt4(acc[m >> 2][n2][m & 3][1] * sc), fq); __builtin_amdgcn_sched_barrier(0);
          }
      }
    }
  }
}

template <int WHICH>
__device__ __forceinline__ void proj_unit(PP p, int layer, int i, int& tn, int& tm, bool& tr, const h16*& Pp, const h16*& Qp) {
  const int K = (WHICH == 1 && layer < 2) ? 4096 : 2048;
  const h16* Wt = (WHICH == 1) ? p->wB : (WHICH == 2) ? (p->wA + (long)3840 * 2048) : p->wA;
  const h16* A = (WHICH == 1) ? (layer < 2 ? p->Obuf : p->mixed) : p->xh;
  tm = i % 32;
  if (WHICH == 0) { tn = i / 32; tr = (tn >= 16 && tn < 32); }
  else if (WHICH == 3) { if (i < 352) { const int j = i / 32; tn = j < 8 ? j : j + 2; tr = false; } else { const int j = (i - 352) / 32; tn = j < 2 ? 8 + j : 11 + j; tr = true; } }
  else { tn = i / 32; tr = false; }
  const h16* wt = Wt + (long)tn * 256 * K; const h16* at = A + (long)tm * 256 * K;
  Pp = tr ? at : wt; Qp = tr ? wt : at;
}
template <int WHICH>
__device__ __forceinline__ void phase_proj(PP p, int layer, LAS char* shm, int bid, int nb) {
  constexpr int NU = ((WHICH == 0) ? 48 : (WHICH == 1) ? 8 : (WHICH == 2) ? 37 : 15) * 32;
  const int K = (WHICH == 1 && layer < 2) ? 4096 : 2048;
  const int nt = K / 64;
  if (bid >= NU) return;
  constexpr int HTB = 128 * 64 * 2;
#define SA8(b, h) (shm + ((b) * 2 + (h)) * HTB)
#define SB8(b, h) (shm + (4 + (b) * 2 + (h)) * HTB)
  const int tid = opaque_tid();
  const int wid = tid >> 6, lane = tid & 63, wr = wid >> 2, wc = wid & 3, fr = lane & 15, fq = lane >> 4;
  int oo[2];
#pragma unroll
  for (int i = 0; i < 2; ++i) { int R, C; stage_rc(tid * 16 + i * 8192, R, C); oo[i] = R * K + C; }
  const h16 *cP, *cQ, *nP, *nQ; int tn, tm, ntn, ntm; bool tr, ntr;
  proj_unit<WHICH>(p, layer, bid, tn, tm, tr, cP, cQ);
#define STG(P_, base_c, base_n, half, kt) do { const h16* g_ = (((kt) < nt) ? (base_c) + (long)(kt) * 64 : (base_n) + (long)((kt) - nt) * 64) + (long)(half) * 128 * K; \
    _Pragma("unroll") for (int i_ = 0; i_ < 2; ++i_) __builtin_amdgcn_global_load_lds((const unsigned*)(g_ + oo[i_]), (LAS unsigned*)((P_) + wid * 1024 + i_ * 8192), 16, 0, 0); } while (0)
#define STAGE8A(P_, half, kt) STG(P_, cP, nP, half, kt)
#define STAGE8B(P_, half, kt) STG(P_, cQ, nQ, half, kt)
#define LDA8(dst, b, h) _Pragma("unroll") for (int m = 0; m < 4; ++m) _Pragma("unroll") for (int k = 0; k < 2; ++k) \
    dst[m][k] = *(const LAS h16x8*)(SA8(b, h) + lds_byte(wr * 64 + m * 16 + fr, k * 32 + fq * 8))
#define LDB8(dst, b, h) _Pragma("unroll") for (int n = 0; n < 2; ++n) _Pragma("unroll") for (int k = 0; k < 2; ++k) \
    dst[n][k] = *(const LAS h16x8*)(SB8(b, h) + lds_byte(wc * 32 + n * 16 + fr, k * 32 + fq * 8))
#define MMA8(ai, bj, At_, Bt_) do { __builtin_amdgcn_s_setprio(1); \
    _Pragma("unroll") for (int m = 0; m < 4; ++m) _Pragma("unroll") for (int n = 0; n < 2; ++n) _Pragma("unroll") for (int k = 0; k < 2; ++k) \
      acc[ai][bj][m][n] = __builtin_amdgcn_mfma_f32_16x16x32_f16(At_[m][k], Bt_[n][k], acc[ai][bj][m][n], 0, 0, 0); \
    __builtin_amdgcn_s_setprio(0); } while (0)
#define ZACC() do { _Pragma("unroll") for (int a_ = 0; a_ < 2; ++a_) _Pragma("unroll") for (int b_ = 0; b_ < 2; ++b_) _Pragma("unroll") for (int m_ = 0; m_ < 4; ++m_) { \
    acc[a_][b_][m_][0] = (f32x4){0.f, 0.f, 0.f, 0.f}; acc[a_][b_][m_][1] = (f32x4){0.f, 0.f, 0.f, 0.f}; } } while (0)
  f32x4 acc[2][2][4][2];
  h16x8 At[4][2], B0[2][2], B1[2][2];
  ZACC();
  nP = cP; nQ = cQ;
  WAIT_V8(0);
  STAGE8B(SB8(0, 0), 0, 0); STAGE8A(SA8(0, 0), 0, 0);
  STAGE8B(SB8(0, 1), 1, 0); STAGE8A(SA8(0, 1), 1, 0);
  if (wr == 1) BAR8;
  WAIT_V8(4); BAR8;
  STAGE8B(SB8(1, 0), 0, 1); STAGE8A(SA8(1, 0), 0, 1); STAGE8B(SB8(1, 1), 1, 1);
  WAIT_V8(6); BAR8;
#pragma unroll 1
  for (int u = bid; u < NU; u += nb) {
    if (u + nb < NU) proj_unit<WHICH>(p, layer, u + nb, ntn, ntm, ntr, nP, nQ);
    else { nP = cP; nQ = cQ; ntn = tn; ntm = tm; ntr = tr; }
#pragma unroll 1
    for (int t = 0; t < nt; t += 2) {
      LDB8(B0, 0, 0); SCHED8; LDA8(At, 0, 0); STAGE8A(SA8(1, 1), 1, t + 1);
      WAIT_L8(8); BAR8; WAIT_L8(0); MMA8(0, 0, At, B0); BAR8; SCHED8;
      LDB8(B1, 0, 1); STAGE8B(SB8(0, 0), 0, t + 2);
      BAR8; WAIT_L8(0); MMA8(0, 1, At, B1); BAR8;
      LDA8(At, 0, 1); STAGE8A(SA8(0, 0), 0, t + 2);
      BAR8; WAIT_L8(0); MMA8(1, 0, At, B0); BAR8; SCHED8;
      STAGE8B(SB8(0, 1), 1, t + 2);
      WAIT_V8(6); BAR8; MMA8(1, 1, At, B1); BAR8;
      LDB8(B0, 1, 0); SCHED8; LDA8(At, 1, 0); STAGE8A(SA8(0, 1), 1, t + 2);
      WAIT_L8(8); BAR8; WAIT_L8(0); MMA8(0, 0, At, B0); BAR8; SCHED8;
      LDB8(B1, 1, 1); STAGE8B(SB8(1, 0), 0, t + 3);
      BAR8; WAIT_L8(0); MMA8(0, 1, At, B1); BAR8;
      LDA8(At, 1, 1); STAGE8A(SA8(1, 0), 0, t + 3);
      BAR8; WAIT_L8(0); MMA8(1, 0, At, B0); BAR8; SCHED8;
      STAGE8B(SB8(1, 1), 1, t + 3);
      WAIT_V8(6); BAR8; MMA8(1, 1, At, B1); BAR8;
    }
    if (tr) proj_epi<WHICH, true>(p, layer, acc, tn, tm); else proj_epi<WHICH, false>(p, layer, acc, tn, tm);
    ZACC();
    cP = nP; cQ = nQ; tn = ntn; tm = ntm; tr = ntr;
  }
  WAIT_V8(0);
  if (wr == 0) BAR8;
  __syncthreads();
#undef SA8
#undef SB8
#undef STG
#undef STAGE8A
#undef STAGE8B
#undef LDA8
#undef LDB8
#undef MMA8
#undef ZACC
}

__device__ __forceinline__ void phase_retB(PP p, LAS char* shm, int bid, int nb) {
  for (int t = bid; t < 768; t += nb) {
    const int tid = opaque_tid(), wid = tid >> 6, lane = tid & 63, wr = wid >> 2, wc = wid & 3, fr = lane & 15, fq = lane >> 4;
    f32x4 acc[8][4];
    zero_acc(acc);
    GOp g; g.nk = 4; g.kt0 = 0; g.ksegP = 1 << 28; g.segP = 0;
    if (t < 512) {
      const int et = t & 1, c = (t >> 1) & 15, bh = t >> 5, b = bh >> 3, h = bh & 7;
      g.P = p->kdT + ((long)b * 2048 + h * 256) * SEQ + c * 256; g.ldp = SEQ;
      g.Q = p->vT + ((long)b * 4096 + h * 512 + et * 256) * SEQ + c * 256; g.ldq = SEQ;
      gemm256(shm, g, acc, tid);
      h16* st = p->St + ((long)(bh * 16 + c) * 512 + et * 256) * 256;
#pragma unroll
      for (int m = 0; m < 8; ++m)
#pragma unroll
        for (int n = 0; n < 4; ++n) {
          const int e = wc * 64 + n * 16 + fr, d0 = wr * 128 + m * 16 + fq * 4;
          *(h16x4*)(st + (long)e * 256 + d0) = cvt4(acc[m][n]); __builtin_amdgcn_sched_barrier(0);
        }
    } else {
      const int u = t - 512, c = u & 15, bh = u >> 4, b = bh >> 3, h = bh & 7;
      const float lg = lg2gamma(h);
      g.P = p->kh + ((long)b * SEQ + c * 256) * 2048 + h * 256; g.ldp = 2048;
      g.Q = p->qh + ((long)b * SEQ + c * 256) * 2048 + h * 256; g.ldq = 2048;
      gemm256(shm, g, acc, tid);
      h16* pb = p->Pbuf + ((long)bh * SEQ + c * 256) * 256;
#pragma unroll
      for (int m = 0; m < 8; ++m)
#pragma unroll
        for (int n = 0; n < 4; ++n) {
          const int qi = wc * 64 + n * 16 + fr, k0 = wr * 128 + m * 16 + fq * 4;
          f32x4 r;
#pragma unroll
          for (int j = 0; j < 4; ++j) { const int rel = qi - (k0 + j); r[j] = rel >= 0 ? acc[m][n][j] * exp2f(lg * (float)rel) : 0.f; }
          *(h16x4*)(pb + (long)qi * 256 + k0) = cvt4(r); __builtin_amdgcn_sched_barrier(0);
        }
    }
  }
}

__device__ __forceinline__ void phase_retC(PP p, int bid, int nb) {
  const int tid = threadIdx.x;
  for (int it = bid * NTHR + tid; it < 16 * 16384; it += nb * NTHR) {
    const int bh = it >> 14, idx = (it & 16383) * 8, h = bh & 7;
    const float dc = exp2f(lg2gamma(h) * 256.f);
    h16* base = p->St + (long)bh * 16 * 131072 + idx;
    h16x8 u[16];
#pragma unroll
    for (int c = 0; c < 16; ++c) u[c] = *(const h16x8*)(base + (long)c * 131072);
    float s[8];
#pragma unroll
    for (int j = 0; j < 8; ++j) s[j] = 0.f;
#pragma unroll
    for (int c = 0; c < 16; ++c) {
      h16x8 o;
#pragma unroll
      for (int j = 0; j < 8; ++j) { o[j] = (h16)s[j]; s[j] = s[j] * dc + (float)u[c][j]; }
      *(h16x8*)(base + (long)c * 131072) = o;
    }
  }
}

__device__ __forceinline__ float wave_sum(float v);
__device__ __forceinline__ void phase_retD(PP p, LAS char* shm, int bid, int nb) {
  for (int u = bid; u < 256; u += nb) {
    const int c = u & 15, bh = u >> 4, b = bh >> 3, h = bh & 7;
    const float lg = lg2gamma(h);
    for (int et = 0; et < 2; ++et) {
      const int tid = opaque_tid(), wid = tid >> 6, lane = tid & 63, wr = wid >> 2, wc = wid & 3, fr = lane & 15, fq = lane >> 4;
      f32x4 acc[8][4];
      zero_acc(acc);
      GOp g; g.nk = 4; g.kt0 = 0; g.ksegP = 1 << 28; g.segP = 0;
      g.P = p->St + ((long)(bh * 16 + c) * 512 + et * 256) * 256; g.ldp = 256;
      g.Q = p->qh + ((long)b * SEQ + c * 256) * 2048 + h * 256; g.ldq = 2048;
      gemm256(shm, g, acc, tid);
#pragma unroll
      for (int n = 0; n < 4; ++n) {
        const float dq = exp2f(lg * (float)(wc * 64 + n * 16 + fr + 1));
#pragma unroll
        for (int m = 0; m < 8; ++m) acc[m][n] = acc[m][n] * dq;
      }
      g.P = p->vT + ((long)b * 4096 + h * 512 + et * 256) * SEQ + c * 256; g.ldp = SEQ;
      g.Q = p->Pbuf + ((long)bh * SEQ + c * 256) * 256; g.ldq = 256;
      gemm256(shm, g, acc, tid);
#pragma unroll
      for (int m = 0; m < 8; ++m)
#pragma unroll
        for (int n = 0; n < 4; ++n) {
          const long tok = (long)b * SEQ + c * 256 + wc * 64 + n * 16 + fr;
          const int e0 = h * 512 + et * 256 + wr * 128 + m * 16 + fq * 4;
          *(h16x4*)(p->Obuf + tok * 4096 + e0) = cvt4(acc[m][n]); __builtin_amdgcn_sched_barrier(0);
        }
    }
    asm volatile("s_waitcnt vmcnt(0)" ::: "memory");
    __syncthreads();
    {
      const int tid = opaque_tid(), wid = tid >> 6, lane = tid & 63;
      for (int r0 = wid * 4; r0 < 256; r0 += 32) {
        h16x8 ov[4], zv[4];
#pragma unroll
        for (int q = 0; q < 4; ++q) {
          const long off = ((long)b * SEQ + c * 256 + r0 + q) * 4096 + h * 512 + lane * 8;
          ov[q] = *(const h16x8*)(p->Obuf + off); zv[q] = *(const h16x8*)(p->zh + off);
        }
#pragma unroll
        for (int q = 0; q < 4; ++q) {
          const long off = ((long)b * SEQ + c * 256 + r0 + q) * 4096 + h * 512 + lane * 8;
          float o[8]; float s = 0.f;
#pragma unroll
          for (int j = 0; j < 8; ++j) { o[j] = (float)ov[q][j]; s += o[j]; }
          const float mu = wave_sum(s) * (1.f / 512.f);
          float qq = 0.f;
#pragma unroll
          for (int j = 0; j < 8; ++j) { const float d = o[j] - mu; qq += d * d; }
          const float rstd = rsqrtf(wave_sum(qq) * (1.f / 512.f) + LN_EPS_F);
          h16x8 rr;
#pragma unroll
          for (int j = 0; j < 8; ++j) rr[j] = (h16)((o[j] - mu) * rstd * siluf_((float)zv[q][j]));
          *(h16x8*)(p->Obuf + off) = rr;
        }
      }
    }
    __syncthreads();
  }
}

__device__ __forceinline__ float wave_sum(float v) {
#pragma unroll
  for (int o = 32; o >= 1; o >>= 1) v += __shfl_xor(v, o);
  return v;
}

__device__ __forceinline__ void phase_retE(PP p, int bid, int nb) {
  const int tid = threadIdx.x, wid = tid >> 6, lane = tid & 63;
  for (int row = bid * 8 + wid; row < NTOK * 8; row += nb * 8) {
    const long off = (long)row * 512 + lane * 8;
    h16x8 ov = *(const h16x8*)(p->Obuf + off), zv = *(const h16x8*)(p->zh + off);
    float o[8]; float s = 0.f;
#pragma unroll
    for (int j = 0; j < 8; ++j) { o[j] = (float)ov[j]; s += o[j]; }
    const float mu = wave_sum(s) * (1.f / 512.f);
    float q = 0.f;
#pragma unroll
    for (int j = 0; j < 8; ++j) { const float d = o[j] - mu; q += d * d; }
    const float rstd = rsqrtf(wave_sum(q) * (1.f / 512.f) + LN_EPS_F);
    h16x8 r;
#pragma unroll
    for (int j = 0; j < 8; ++j) r[j] = (h16)((o[j] - mu) * rstd * siluf_((float)zv[j]));
    *(h16x8*)(p->Obuf + off) = r;
  }
}

__device__ __forceinline__ void phase_ln(PP p, int layer, LAS char* shm, int bid, int nb) {
  const int tid = threadIdx.x, wid = tid >> 6, lane = tid & 63;
  const float* gw = p->ln_g[layer]; const float* bw = p->ln_b[layer];
  float* dst = (layer == 3) ? p->out : p->xres;
  float4 gg8[8], bb8[8];
#pragma unroll
  for (int i = 0; i < 8; ++i) { gg8[i] = *(const float4*)(gw + i * 256 + lane * 4); bb8[i] = *(const float4*)(bw + i * 256 + lane * 4); }
  for (int row0 = bid * 8 + wid; row0 < NTOK; row0 += nb * 16) {
    const int row1 = row0 + nb * 8;
    const bool has1 = row1 < NTOK;
    float4 v[2][8];
#pragma unroll
    for (int i = 0; i < 8; ++i) {
      v[0][i] = *(const float4*)(p->xres + (long)row0 * DM + i * 256 + lane * 4);
      v[1][i] = has1 ? *(const float4*)(p->xres + (long)row1 * DM + i * 256 + lane * 4) : make_float4(0.f, 0.f, 0.f, 0.f);
    }
#pragma unroll
    for (int q = 0; q < 2; ++q) {
      const int row = q ? row1 : row0;
      float s = 0.f;
#pragma unroll
      for (int i = 0; i < 8; ++i) s += v[q][i].x + v[q][i].y + v[q][i].z + v[q][i].w;
      const float mu = wave_sum(s) * (1.f / 2048.f);
      float qq = 0.f;
#pragma unroll
      for (int i = 0; i < 8; ++i) { float a = v[q][i].x - mu, b = v[q][i].y - mu, c = v[q][i].z - mu, d = v[q][i].w - mu; qq += a * a + b * b + c * c + d * d; }
      const float rstd = rsqrtf(wave_sum(qq) * (1.f / 2048.f) + LN_EPS_F);
      if (q == 0 || has1) {
#pragma unroll
        for (int i = 0; i < 8; ++i) {
          const int col = i * 256 + lane * 4;
          const float4 gg = gg8[i], bb = bb8[i];
          float4 r; r.x = (v[q][i].x - mu) * rstd * gg.x + bb.x; r.y = (v[q][i].y - mu) * rstd * gg.y + bb.y; r.z = (v[q][i].z - mu) * rstd * gg.z + bb.z; r.w = (v[q][i].w - mu) * rstd * gg.w + bb.w;
          *(float4*)(dst + (long)row * DM + col) = r;
          h16x4 hv; hv[0] = (h16)r.x; hv[1] = (h16)r.y; hv[2] = (h16)r.z; hv[3] = (h16)r.w;
          *(h16x4*)(p->xh + (long)row * DM + col) = hv;
        }
      }
    }
  }
  __syncthreads();
  int tb = 0;
  if (layer == 0) {
    conv_job(shm, p->ret_w_in[1], 2048, 12288, 12288, p->wA, tb, bid, nb);
    conv_job(shm, p->ret_w_out[1], 4096, 2048, 2048, p->wB, tb, bid, nb);
  } else if (layer == 1) {
    conv_job(shm, p->w_kv, 2048, 3840, 3840, p->wA, tb, bid, nb);
    conv_job(shm, p->nsa_w_in[0], 2048, 9264, 9472, p->wA + (long)3840 * 2048, tb, bid, nb);
    conv_job(shm, p->nsa_w_out[0], 2048, 2048, 2048, p->wB, tb, bid, nb);
  } else if (layer == 2) {
    conv_job(shm, p->nsa_w_in[1], 2048, 9264, 9472, p->wA + (long)3840 * 2048, tb, bid, nb);
    conv_job(shm, p->nsa_w_out[1], 2048, 2048, 2048, p->wB, tb, bid, nb);
  }
}

__device__ __forceinline__ void phase_cmp1(PP p, LAS char* shm, int bid, int nb) {
  for (int t = bid; t < 256; t += nb) {
    const int tid = opaque_tid(), wid = tid >> 6, lane = tid & 63, wr = wid >> 2, wc = wid & 3, fr = lane & 15, fq = lane >> 4;
    const int kv = t >> 7, bg = (t >> 4) & 7, sp = t & 15, b = bg >> 2, gq = bg & 3;
    f32x4 acc[8][4];
    zero_acc(acc);
    GOp g;
    g.ldp = 16 * KV_LD; g.segP = KV_LD;
    if (kv == 0) { g.P = p->kvh + (long)b * SEQ * KV_LD + gq * 192; g.ksegP = 3; g.nk = 6; g.kt0 = 6 * sp; g.Q = p->ck1T; g.ldq = 6144; }
    else { g.P = p->kvh + (long)b * SEQ * KV_LD + 768 + gq * 128; g.ksegP = 2; g.nk = 4; g.kt0 = 4 * sp; g.Q = p->cv1T; g.ldq = 4096; }
    gemm256(shm, g, acc, tid);
    float* pt = p->part + (long)t * 65536;
#pragma unroll
    for (int m = 0; m < 8; ++m)
#pragma unroll
      for (int n = 0; n < 4; ++n) {
        *(f32x4*)(pt + (long)(wc * 64 + n * 16 + fr) * 256 + wr * 128 + m * 16 + fq * 4) = acc[m][n]; __builtin_amdgcn_sched_barrier(0);
      }
  }
}

__device__ __forceinline__ void phase_cmp2(PP p, LAS char* shm, int bid, int nb) {
  const int tid = threadIdx.x;
  LAS float* hid = (LAS float*)shm;
  for (int t = bid; t < 512; t += nb) {
    const int kv = t >> 8, bg = (t >> 5) & 7, ng = t & 31;
    const float* pt = p->part + (long)(kv * 128 + bg * 16) * 65536;
    const float* bias = p->biasp + (kv ? 32 * 256 : 0);
#pragma unroll
    for (int i = 0; i < 4; ++i) {
      const int e = tid + i * 512, nl = e & 7, hh = e >> 3;
      float s = 0.f;
      for (int pp = 0; pp < 32; ++pp) s += bias[pp * 256 + hh];
      for (int sp = 0; sp < 16; ++sp) s += pt[(long)sp * 65536 + (long)hh * 256 + ng * 8 + nl];
      hid[nl * 256 + hh] = siluf_(s);
    }
    __syncthreads();
    if (kv == 0) {
#pragma unroll
      for (int i = 0; i < 3; ++i) {
        const int o = tid + i * 512, nl = o / 192, j = o % 192, n = ng * 8 + nl;
        float s = 0.f;
        for (int hh = 0; hh < 256; ++hh) s += hid[nl * 256 + hh] * p->w_ck2[hh * 192 + j];
        p->kc[((long)bg * 256 + n) * 192 + j] = (n < 255) ? (h16)s : (h16)0.f;
      }
    } else {
#pragma unroll
      for (int i = 0; i < 2; ++i) {
        const int o = tid + i * 512, nl = o >> 7, j = o & 127, n = ng * 8 + nl;
        float s = 0.f;
        for (int hh = 0; hh < 256; ++hh) s += hid[nl * 256 + hh] * p->w_cv2[hh * 128 + j];
        p->vcT[((long)bg * 128 + j) * 256 + n] = (n < 255) ? (h16)s : (h16)0.f;
      }
    }
    __syncthreads();
  }
}

__device__ __forceinline__ void phase_select(PP p, LAS char* shm, int bid, int nb) {
  LAS float* psel = (LAS float*)(shm + 102400);
  for (int u = bid; u < 1024; u += nb) {
    const int tid = opaque_tid(), wid = tid >> 6, lane = tid & 63, fr = lane & 15, fq = lane >> 4;
    const int r = wid >> 1, th = wid & 1;
    const int bg = u >> 7, tile = u & 127, b = bg >> 2, gq = bg & 3, t0 = tile * 32;
    const h16* kcb = p->kc + (long)bg * 256 * 192;
    { const int row = tid >> 1, c0 = (tid & 1) * 12;
      const h16* src = kcb + row * 192 + c0 * 8; LAS char* dl = shm + row * 400 + c0 * 16;
#pragma unroll
      for (int i = 0; i < 12; ++i) *(LAS u32x4*)(dl + i * 16) = *(const u32x4*)(src + i * 8); }
    const int tq = t0 + th * 16 + fr;
    const h16* qrow = p->proj + ((long)b * SEQ + tq) * NSA_LD + (gq * 4 + r) * 192 + fq * 8;
    h16x8 qf[6];
#pragma unroll
    for (int ks = 0; ks < 6; ++ks) qf[ks] = *(const h16x8*)(qrow + ks * 32);
    __syncthreads();
    f32x4 s[16];
#pragma unroll
    for (int mt = 0; mt < 16; ++mt) s[mt] = (f32x4){0.f, 0.f, 0.f, 0.f};
#pragma unroll
    for (int ks = 0; ks < 6; ++ks)
#pragma unroll
      for (int mt = 0; mt < 16; ++mt) {
        const h16x8 kf = *(const LAS h16x8*)(shm + (mt * 16 + fr) * 400 + (ks * 32 + fq * 8) * 2);
        s[mt] = __builtin_amdgcn_mfma_f32_16x16x32_f16(kf, qf[ks], s[mt], 0, 0, 0);
      }
    float mx = -1e30f;
#pragma unroll
    for (int mt = 0; mt < 16; ++mt)
#pragma unroll
      for (int j = 0; j < 4; ++j) {
        const int n = mt * 16 + fq * 4 + j;
        const bool valid = (n < 255) && (16 * n + 31 <= tq);
        const float v = valid ? s[mt][j] : -1e30f;
        s[mt][j] = v; mx = fmaxf(mx, v);
      }
    mx = fmaxf(mx, __shfl_xor(mx, 16)); mx = fmaxf(mx, __shfl_xor(mx, 32));
    float l = 0.f;
#pragma unroll
    for (int mt = 0; mt < 16; ++mt)
#pragma unroll
      for (int j = 0; j < 4; ++j) { const float pv = (s[mt][j] > -1e29f) ? __builtin_amdgcn_exp2f(s[mt][j] - mx) : 0.f; s[mt][j] = pv; l += pv; }
    l += __shfl_xor(l, 16); l += __shfl_xor(l, 32);
    const float inv = l > 0.f ? 1.f / l : 0.f;
#pragma unroll
    for (int mt = 0; mt < 16; ++mt) {
      const float own = s[mt][0] + 2.f * (s[mt][1] + s[mt][2] + s[mt][3]);
      const float x1 = __shfl(s[mt][0], (lane + 16) & 63);
      const float nx = (mt < 15) ? s[(mt + 1) & 15][0] : 0.f;
      const float x2 = __shfl(nx, (lane + 16) & 63);
      const float val = (own + (fq < 3 ? x1 : x2)) * inv;
      psel[(r * 32 + th * 16 + fr) * 64 + mt * 4 + fq] = val;
    }
    __syncthreads();
#pragma unroll
    for (int i = 0; i < 4; ++i) {
      const int tl = wid * 4 + i, t = t0 + tl, cur = t >> 6, j = lane;
      const float ps = psel[(0 * 32 + tl) * 64 + j] + psel[(1 * 32 + tl) * 64 + j] + psel[(2 * 32 + tl) * 64 + j] + psel[(3 * 32 + tl) * 64 + j];
      const bool forced = (j == 0) || (j == cur) || (j == cur - 1);
      const float score = forced ? 1e9f : (j <= cur ? ps : -1.0f);
      int rank = 0;
      for (int k = 0; k < 64; ++k) { const float sk = __shfl(score, k); rank += (sk > score || (sk == score && k < j)) ? 1 : 0; }
      const u64 mk = __ballot(rank < 16);
      if (lane == 0) p->masks[(long)bg * SEQ + t] = mk;
    }
    __syncthreads();
  }
}


__device__ __forceinline__ float xr_max(float v) {
  const unsigned u = __float_as_uint(v);
  auto r = __builtin_amdgcn_permlane16_swap(u, u, false, false);
  const float a = fmaxf(__uint_as_float(r[0]), __uint_as_float(r[1]));
  const unsigned ua = __float_as_uint(a);
  auto r2 = __builtin_amdgcn_permlane32_swap(ua, ua, false, false);
  return fmaxf(__uint_as_float(r2[0]), __uint_as_float(r2[1]));
}
__device__ __forceinline__ float xr_sum(float v) {
  const unsigned u = __float_as_uint(v);
  auto r = __builtin_amdgcn_permlane16_swap(u, u, false, false);
  const float a = __uint_as_float(r[0]) + __uint_as_float(r[1]);
  const unsigned ua = __float_as_uint(a);
  auto r2 = __builtin_amdgcn_permlane32_swap(ua, ua, false, false);
  return __uint_as_float(r2[0]) + __uint_as_float(r2[1]);
}
constexpr int FK_OFF = 0, FV_OFF = 25600, FQ_OFF = 44032;
__device__ __forceinline__ void flash_branch(PP p, LAS char* shm, int branch, int b, int gq, int t0, const h16x8 (&qf)[2][6]) {
  const int tid = opaque_tid(), wid = tid >> 6, lane = tid & 63, fr = lane & 15, fq = lane >> 4;
  const int r = wid >> 1, th = wid & 1, bg = b * 4 + gq, hd = gq * 4 + r;
  const int cur = t0 >> 6;
  const h16* Kb; long ldk; const h16* VTb; long ldvt; int jlo, jhi;
  if (branch == 0) { Kb = p->kc + (long)bg * 256 * 192; ldk = 192; VTb = p->vcT + (long)bg * 128 * 256; ldvt = 256; jlo = 0; jhi = (t0 + 32) >> 10; if (jhi > 3) jhi = 3; }
  else if (branch == 1) { Kb = p->kvh + (long)b * SEQ * KV_LD + 1280 + gq * 192; ldk = KV_LD; VTb = p->vselT + ((long)b * 512 + gq * 128) * SEQ; ldvt = SEQ; jlo = 0; jhi = cur; }
  else { Kb = p->kvh + (long)b * SEQ * KV_LD + 2560 + gq * 192; ldk = KV_LD; VTb = p->vwinT + ((long)b * 512 + gq * 128) * SEQ; ldvt = SEQ; jlo = cur - 8 > 0 ? cur - 8 : 0; jhi = cur; }
  int tq[2]; u64 mk[2];
#pragma unroll
  for (int nt = 0; nt < 2; ++nt) { tq[nt] = t0 + th * 32 + nt * 16 + fr; mk[nt] = (branch == 1) ? p->masks[(long)bg * SEQ + tq[nt]] : 0ull; }
  f32x4 O[8][2];
#pragma unroll
  for (int et = 0; et < 8; ++et) { O[et][0] = (f32x4){0.f, 0.f, 0.f, 0.f}; O[et][1] = (f32x4){0.f, 0.f, 0.f, 0.f}; }
  float mrun[2] = {-1e30f, -1e30f}, lrun[2] = {0.f, 0.f};
  int koff[4], voff[3];
#pragma unroll
  for (int i = 0; i < 4; ++i) { const int c = (wid + 8 * i) * 64 + lane, row = c / 25, ch = c % 25; koff[i] = row * (int)ldk + (ch < 24 ? ch : 23) * 8; }
#pragma unroll
  for (int i = 0; i < 3; ++i) { const int c = (wid + 8 * i) * 64 + lane, e = c / 9, ch = c % 9; voff[i] = e * (int)ldvt + (ch < 8 ? ch : 7) * 8; }
#define F_STAGE(j, buf) do { \
    const h16* kb_ = Kb + (long)(j) * 64 * ldk; const h16* vb_ = VTb + (long)(j) * 64; LAS char* lb_ = shm + (buf) * 44032; \
    _Pragma("unroll") for (int i = 0; i < 4; ++i) if (wid + 8 * i < 25) __builtin_amdgcn_global_load_lds((const unsigned*)(kb_ + koff[i]), (LAS unsigned*)(lb_ + FK_OFF + (wid + 8 * i) * 1024), 16, 0, 0); \
    _Pragma("unroll") for (int i = 0; i < 3; ++i) if (wid + 8 * i < 18) __builtin_amdgcn_global_load_lds((const unsigned*)(vb_ + voff[i]), (LAS unsigned*)(lb_ + FV_OFF + (wid + 8 * i) * 1024), 16, 0, 0); } while (0)
  F_STAGE(jlo, 0);
  asm volatile("s_waitcnt vmcnt(0)" ::: "memory");
  __syncthreads();
  for (int j = jlo; j <= jhi; ++j) {
    const int cb = (j - jlo) & 1;
    LAS char* lb = shm + cb * 44032;
    if (j + 1 <= jhi) F_STAGE(j + 1, cb ^ 1);
    f32x4 s[4][2];
#pragma unroll
    for (int mt = 0; mt < 4; ++mt) { s[mt][0] = (f32x4){0.f, 0.f, 0.f, 0.f}; s[mt][1] = (f32x4){0.f, 0.f, 0.f, 0.f}; }
#pragma unroll
    for (int ks = 0; ks < 6; ++ks) {
      const h16x8 q0 = qf[0][ks], q1 = qf[1][ks];
#pragma unroll
      for (int mt = 0; mt < 4; ++mt) {
        const h16x8 kf = *(const LAS h16x8*)(lb + FK_OFF + (mt * 16 + fr) * 400 + (ks * 32 + fq * 8) * 2);
        s[mt][0] = __builtin_amdgcn_mfma_f32_16x16x32_f16(kf, q0, s[mt][0], 0, 0, 0);
        s[mt][1] = __builtin_amdgcn_mfma_f32_16x16x32_f16(kf, q1, s[mt][1], 0, 0, 0);
      }
    }
    __builtin_amdgcn_sched_group_barrier(0x100, 4, 0);
#pragma unroll
    for (int i = 0; i < 20; ++i) { __builtin_amdgcn_sched_group_barrier(0x100, 1, 0); __builtin_amdgcn_sched_group_barrier(0x008, 2, 0); }
    __builtin_amdgcn_sched_group_barrier(0x008, 8, 0);
    h16x8 pf[2][2];
    const bool full = (branch == 0) || (branch == 1 && j == cur) || (branch == 2 && (j == cur || j == cur - 8));
#pragma unroll
    for (int nt = 0; nt < 2; ++nt) {
      if (full) {
#pragma unroll
        for (int mt = 0; mt < 4; ++mt)
#pragma unroll
          for (int jj = 0; jj < 4; ++jj) {
            const int key = j * 64 + mt * 16 + fq * 4 + jj;
            bool valid;
            if (branch == 0) valid = (key < 255) && (16 * key + 31 <= tq[nt]);
            else if (branch == 1) valid = ((mk[nt] >> j) & 1ull) && (key <= tq[nt]);
            else valid = (key <= tq[nt]) && (tq[nt] - key < 512);
            s[mt][nt][jj] = valid ? s[mt][nt][jj] : -1e30f;
          }
      } else if (branch == 1) {
        const bool selb = (mk[nt] >> j) & 1ull;
#pragma unroll
        for (int mt = 0; mt < 4; ++mt)
#pragma unroll
          for (int jj = 0; jj < 4; ++jj) s[mt][nt][jj] = selb ? s[mt][nt][jj] : -1e30f;
      }
      float mx = fmaxf(fmaxf(s[0][nt][0], s[0][nt][1]), fmaxf(s[0][nt][2], s[0][nt][3]));
#pragma unroll
      for (int mt = 1; mt < 4; ++mt) mx = fmaxf(mx, fmaxf(fmaxf(s[mt][nt][0], s[mt][nt][1]), fmaxf(s[mt][nt][2], s[mt][nt][3])));
      mx = xr_max(mx);
      const float mold = mrun[nt];
      const float mnew = fmaxf(mold, mx);
      const float msafe = fmaxf(mnew, -1e29f);
      mrun[nt] = mnew;
      float rs = 0.f;
#pragma unroll
      for (int mt = 0; mt < 4; ++mt)
#pragma unroll
        for (int jj = 0; jj < 4; ++jj) { const float pv = __builtin_amdgcn_exp2f(s[mt][nt][jj] - msafe); s[mt][nt][jj] = pv; rs += pv; }
      rs = xr_sum(rs);
      if (__builtin_amdgcn_ballot_w64(mnew > mold) != 0ull) {
        const float alpha = __builtin_amdgcn_exp2f(mold - mnew);
        lrun[nt] = lrun[nt] * alpha + rs;
#pragma unroll
        for (int et = 0; et < 8; ++et) O[et][nt] = O[et][nt] * alpha;
      } else {
        lrun[nt] += rs;
      }
#pragma unroll
      for (int k2 = 0; k2 < 2; ++k2)
#pragma unroll
        for (int jj = 0; jj < 4; ++jj) { pf[nt][k2][jj] = (h16)s[2 * k2][nt][jj]; pf[nt][k2][4 + jj] = (h16)s[2 * k2 + 1][nt][jj]; }
    }
#pragma unroll
    for (int et = 0; et < 8; ++et)
#pragma unroll
      for (int k2 = 0; k2 < 2; ++k2) {
        const LAS char* va = lb + FV_OFF + (et * 16 + fr) * 144 + (k2 * 32 + fq * 4) * 2;
        const h16x4 lo = *(const LAS h16x4*)va, hi = *(const LAS h16x4*)(va + 32);
        h16x8 vf; vf[0] = lo[0]; vf[1] = lo[1]; vf[2] = lo[2]; vf[3] = lo[3]; vf[4] = hi[0]; vf[5] = hi[1]; vf[6] = hi[2]; vf[7] = hi[3];
        O[et][0] = __builtin_amdgcn_mfma_f32_16x16x32_f16(vf, pf[0][k2], O[et][0], 0, 0, 0);
        O[et][1] = __builtin_amdgcn_mfma_f32_16x16x32_f16(vf, pf[1][k2], O[et][1], 0, 0, 0);
      }
    __builtin_amdgcn_sched_group_barrier(0x100, 4, 0);
#pragma unroll
    for (int i = 0; i < 14; ++i) { __builtin_amdgcn_sched_group_barrier(0x100, 2, 0); __builtin_amdgcn_sched_group_barrier(0x008, 2, 0); }
    __builtin_amdgcn_sched_group_barrier(0x008, 4, 0);
    asm volatile("s_waitcnt vmcnt(0)" ::: "memory");
    __syncthreads();
  }
#undef F_STAGE
#pragma unroll
  for (int nt = 0; nt < 2; ++nt) {
    const long tok = (long)b * SEQ + tq[nt];
    const h16* pr = p->proj + tok * NSA_LD;
    const float gt = sigmoidf_((float)pr[9216 + branch * 16 + hd]);
    const float inv = lrun[nt] > 0.f ? gt / lrun[nt] : 0.f;
#pragma unroll
    for (int et = 0; et < 8; ++et) {
      const int e0 = hd * 128 + et * 16 + fq * 4;
      const h16x4 zv = *(const h16x4*)(pr + 3072 + branch * 2048 + e0);
      h16* mp = p->mixed + tok * DM + e0;
      f32x4 r;
#pragma unroll
      for (int jj = 0; jj < 4; ++jj) r[jj] = O[et][nt][jj] * inv * siluf_((float)zv[jj]);
      if (branch != 0) { const h16x4 old = *(const h16x4*)mp; r[0] += (float)old[0]; r[1] += (float)old[1]; r[2] += (float)old[2]; r[3] += (float)old[3]; }
      *(h16x4*)mp = cvt4(r);
    }
  }
}

__device__ __forceinline__ void phase_attn(PP p, LAS char* shm, int bid, int nb) {
  for (int u0 = bid; u0 < 256; u0 += nb) {
    const int u = (nb == 256) ? ((u0 & 7) << 5 | (u0 >> 3)) : u0;
    const int bg = u >> 5, pr = u & 31, b = bg >> 2, gq = bg & 3;
    for (int half = 0; half < 2; ++half) {
      const int tile = half ? 63 - pr : pr, t0 = tile * 64;
      h16x8 qf[2][6];
      { const int tid = opaque_tid(), wid = tid >> 6, lane = tid & 63, fr = lane & 15, fq = lane >> 4, r = wid >> 1, th = wid & 1;
#pragma unroll
        for (int nt = 0; nt < 2; ++nt) {
          const h16* qrow = p->proj + ((long)b * SEQ + t0 + th * 32 + nt * 16 + fr) * NSA_LD + (gq * 4 + r) * 192 + fq * 8;
#pragma unroll
          for (int ks = 0; ks < 6; ++ks) qf[nt][ks] = *(const h16x8*)(qrow + ks * 32);
        } }
      flash_branch(p, shm, 0, b, gq, t0, qf);
      flash_branch(p, shm, 1, b, gq, t0, qf);
      flash_branch(p, shm, 2, b, gq, t0, qf);
    }
  }
}


#define XB_TMO      128
#define XB_XCNT(j)  (256  + 64 * (j))
#define XB_XSUB(j)  (1280 + 64 * (j))
#define XB_XGEN(j)  (2304 + 64 * (j))
#define XB_TOP      3328
#define XB_TOPGEN   3392
#define XCD_BAR_WORDS 3456
#define XB_SPIN_CAP (1u << 18)
__device__ __forceinline__ unsigned xb_ld(unsigned* p)              { return __hip_atomic_load(p, __ATOMIC_RELAXED, __HIP_MEMORY_SCOPE_AGENT); }
__device__ __forceinline__ unsigned xb_add(unsigned* p, unsigned v) { return __hip_atomic_fetch_add(p, v, __ATOMIC_RELAXED, __HIP_MEMORY_SCOPE_AGENT); }
__device__ __forceinline__ unsigned xb_xcc_id() { return (unsigned)__builtin_amdgcn_s_getreg((3 << 11) | 20) & 0xFu; }
#define XB_SPIN(cond, bar) do { unsigned _sp = 0; while (cond) { __builtin_amdgcn_s_sleep(1); \
    if ((++_sp & 255u) == 0u) { if (xb_ld(&(bar)[XB_TMO])) break; if (_sp > XB_SPIN_CAP) { atomicAdd(&(bar)[XB_TMO], 1u); break; } } } } while (0)
struct XcdBarrier { unsigned* bar; unsigned x; volatile LAS unsigned* st; };
__device__ __forceinline__ XcdBarrier xcd_barrier_post(unsigned* bar, volatile LAS unsigned* st) {
  XcdBarrier b; b.bar = bar; b.x = xb_xcc_id(); b.st = st;
  if (threadIdx.x == 0) (void)xb_add(&bar[XB_XCNT(b.x)], 1u);
  return b;
}
__device__ __forceinline__ void xcd_barrier_complete(unsigned* bar, unsigned x, unsigned& nloc, unsigned& nx) {
  const unsigned G = gridDim.x * gridDim.y * gridDim.z;
  unsigned sum, cnt, mine, sp = 0u;
  for (;;) {
    sum = 0u; cnt = 0u; mine = 0u;
#pragma unroll
    for (unsigned j = 0; j < 16; ++j) { const unsigned c = xb_ld(&bar[XB_XCNT(j)]); sum += c; cnt += (c > 0u) ? 1u : 0u; mine = (j == x) ? c : mine; }
    if (sum == G) break;
    __builtin_amdgcn_s_sleep(1);
    if ((++sp & 255u) == 0u) { if (xb_ld(&bar[XB_TMO])) break; if (sp > XB_SPIN_CAP) { atomicAdd(&bar[XB_TMO], 1u); break; } }
  }
  nloc = mine > 0u ? mine : 1u; nx = cnt > 0u ? cnt : 1u;
}
__device__ __forceinline__ void xcd_barrier(const XcdBarrier& b) {
  asm volatile("s_waitcnt vmcnt(0)" ::: "memory");
  __syncthreads();
  if (threadIdx.x == 0) {
    unsigned* bar = b.bar;
    __builtin_amdgcn_s_waitcnt(0);
    unsigned nloc = b.st[0], nx = b.st[1];
    if (nloc == 0u) { xcd_barrier_complete(bar, b.x, nloc, nx); b.st[0] = nloc; b.st[1] = nx; }
    const unsigned old = xb_add(&bar[XB_XSUB(b.x)], 1u);
    const unsigned gen = old / nloc;
    if (old + 1u == (gen + 1u) * nloc) {
      __builtin_amdgcn_fence(__ATOMIC_RELEASE, "agent");
      asm volatile("s_waitcnt vmcnt(0)" ::: "memory");
      const unsigned og = xb_add(&bar[XB_TOP], 1u);
      const unsigned tg = og / nx;
      if (og + 1u == (tg + 1u) * nx) xb_add(&bar[XB_TOPGEN], 1u);
      else XB_SPIN(xb_ld(&bar[XB_TOPGEN]) == tg, bar);
      __builtin_amdgcn_fence(__ATOMIC_ACQUIRE, "agent");
      xb_add(&bar[XB_XGEN(b.x)], 1u);
      asm volatile("s_waitcnt vmcnt(0)" ::: "memory");
    } else {
      XB_SPIN(xb_ld(&bar[XB_XGEN(b.x)]) == gen, bar);
      __builtin_amdgcn_fence(__ATOMIC_ACQUIRE, "agent");
      asm volatile("s_waitcnt vmcnt(0)" ::: "memory");
    }
  }
  __syncthreads();
}

__global__ void __launch_bounds__(NTHR) mega_kernel(Params pk, int ph_lo, int ph_hi) {
  __shared__ __attribute__((aligned(1024))) char shm_raw[SHM_BYTES];
  LAS char* shm = (LAS char*)shm_raw;
  cg::grid_group grid = cg::this_grid();
  const int bid = blockIdx.x, nb = gridDim.x;
  if (threadIdx.x < 4) ((LAS unsigned*)(shm + SHM_BYTES - 16))[threadIdx.x] = 0u;
  __syncthreads();
  XcdBarrier xb;
  { PP p0 = (PP)__builtin_amdgcn_kernarg_segment_ptr(); xb = xcd_barrier_post(p0->xbar, (volatile LAS unsigned*)(shm + SHM_BYTES - 16)); }
#define PH(k, call) if (ph_lo <= (k) && (k) < ph_hi) { PP p = (PP)__builtin_amdgcn_kernarg_segment_ptr(); asm volatile("" : "+s"(p)); call; if ((k) + 1 < ph_hi) xcd_barrier(xb); }
  if (ph_lo < 0) { asm volatile("s_waitcnt vmcnt(0)" ::: "memory"); __syncthreads(); grid.sync(); }
  PH(0, phase_prep(p, shm, bid, nb))
  PH(1, phase_proj<0>(p, 0, shm, bid, nb))
  PH(2, phase_retB(p, shm, bid, nb))
  PH(3, phase_retC(p, bid, nb))
  PH(4, phase_retD(p, shm, bid, nb))
  PH(6, phase_proj<1>(p, 0, shm, bid, nb))
  PH(7, phase_ln(p, 0, shm, bid, nb))
  PH(8, phase_proj<0>(p, 1, shm, bid, nb))
  PH(9, phase_retB(p, shm, bid, nb))
  PH(10, phase_retC(p, bid, nb))
  PH(11, phase_retD(p, shm, bid, nb))
  PH(13, phase_proj<1>(p, 1, shm, bid, nb))
  PH(14, phase_ln(p, 1, shm, bid, nb))
  PH(15, (phase_proj<3>(p, 2, shm, bid, nb), phase_proj<2>(p, 2, shm, bid, nb)))
  PH(16, phase_cmp1(p, shm, bid, nb))
  PH(17, phase_cmp2(p, shm, bid, nb))
  PH(19, phase_select(p, shm, bid, nb))
  PH(20, phase_attn(p, shm, bid, nb))
  PH(21, phase_proj<1>(p, 2, shm, bid, nb))
  PH(22, phase_ln(p, 2, shm, bid, nb))
  PH(23, phase_proj<2>(p, 3, shm, bid, nb))
  PH(24, phase_select(p, shm, bid, nb))
  PH(25, phase_attn(p, shm, bid, nb))
  PH(26, phase_proj<1>(p, 3, shm, bid, nb))
  PH(27, phase_ln(p, 3, shm, bid, nb))
#undef PH
}

extern "C" void kernel_launch(void* const* d_in, const int* in_sizes, int n_in, void* d_out, int out_size, void* d_ws, size_t ws_size, hipStream_t stream) {
  Params p{};
  p.x = (const float*)d_in[0]; p.pos = (const int*)d_in[1];
  p.ret_w_in[0] = (const float*)d_in[2]; p.ret_w_out[0] = (const float*)d_in[3]; p.ln_g[0] = (const float*)d_in[4]; p.ln_b[0] = (const float*)d_in[5];
  p.ret_w_in[1] = (const float*)d_in[6]; p.ret_w_out[1] = (const float*)d_in[7]; p.ln_g[1] = (const float*)d_in[8]; p.ln_b[1] = (const float*)d_in[9];
  p.w_kv = (const float*)d_in[10]; p.pe_k = (const float*)d_in[11]; p.pe_v = (const float*)d_in[12];
  p.w_ck1 = (const float*)d_in[13]; p.w_ck2 = (const float*)d_in[14]; p.w_cv1 = (const float*)d_in[15]; p.w_cv2 = (const float*)d_in[16];
  p.nsa_w_in[0] = (const float*)d_in[17]; p.nsa_w_out[0] = (const float*)d_in[18]; p.ln_g[2] = (const float*)d_in[19]; p.ln_b[2] = (const float*)d_in[20];
  p.nsa_w_in[1] = (const float*)d_in[21]; p.nsa_w_out[1] = (const float*)d_in[22]; p.ln_g[3] = (const float*)d_in[23]; p.ln_b[3] = (const float*)d_in[24];
  p.out = (float*)d_out;
  char* ws = (char*)d_ws; size_t off = 0;
  auto take = [&](size_t bytes) { char* r = ws + off; off += (bytes + 4095) & ~(size_t)4095; return r; };
  p.wA = (h16*)take((size_t)13312 * 2048 * 2);
  p.wB = (h16*)take((size_t)4096 * 2048 * 2);
  p.xres = (float*)take((size_t)NTOK * DM * 4);
  p.xh = (h16*)take((size_t)NTOK * DM * 2);
  p.cs = (float*)take((size_t)NTOK * 256 * 4);
  p.ck1T = (h16*)take((size_t)256 * 6144 * 2);
  p.cv1T = (h16*)take((size_t)256 * 4096 * 2);
  p.biask = (float*)take(1024); p.biasv = (float*)take(1024); p.biasp = (float*)take(65536);
  p.kc = (h16*)take((size_t)8 * 256 * 192 * 2);
  p.vcT = (h16*)take((size_t)8 * 128 * 256 * 2);
  p.masks = (u64*)take((size_t)8 * SEQ * 8);
  const size_t region = off;
  p.kh = (h16*)take((size_t)NTOK * 2048 * 2);
  p.kdT = (h16*)take((size_t)NTOK * 2048 * 2);
  p.Obuf = p.kh;
  p.qh = (h16*)take((size_t)NTOK * 2048 * 2);
  p.vT = (h16*)take((size_t)NTOK * 4096 * 2);
  p.zh = (h16*)take((size_t)NTOK * 4096 * 2);
  p.St = (h16*)take((size_t)16 * 16 * 131072 * 2);
  p.Pbuf = (h16*)take((size_t)16 * SEQ * 256 * 2);
  off = region;
  p.kvh = (h16*)take((size_t)NTOK * KV_LD * 2 + 65536 * 4);
  p.vselT = (h16*)take((size_t)2 * 512 * SEQ * 2);
  p.vwinT = (h16*)take((size_t)2 * 512 * SEQ * 2);
  p.mixed = (h16*)take((size_t)NTOK * DM * 2);
  p.proj = (h16*)take((size_t)NTOK * NSA_LD * 2);
  p.part = (float*)take((size_t)256 * 65536 * 4);
  p.xbar = (unsigned*)take(XCD_BAR_WORDS * 4);

  if (off > ws_size) fprintf(stderr, "workspace too small: need %zu have %zu\n", off, ws_size);
  static int grid_blocks = 0;
  if (!grid_blocks) {
    int dev = 0, cus = 0, per_cu = 0;
    (void)hipGetDevice(&dev);
    (void)hipDeviceGetAttribute(&cus, hipDeviceAttributeMultiprocessorCount, dev);
    (void)hipOccupancyMaxActiveBlocksPerMultiprocessor(&per_cu, mega_kernel, NTHR, 0);
    if (per_cu < 1) per_cu = 1;
    grid_blocks = cus * per_cu;
    if (grid_blocks > 256) grid_blocks = 256;
  }
  (void)hipMemsetAsync(p.xbar, 0, XCD_BAR_WORDS * 4, stream);
#if FUSED
  int lo = 0, hi = 28;
  void* args[] = {&p, &lo, &hi};
  hipError_t e = hipLaunchCooperativeKernel((void*)mega_kernel, dim3(grid_blocks), dim3(NTHR), args, 0, stream);
  if (e != hipSuccess) fprintf(stderr, "cooperative launch failed: %s (grid %d)\n", hipGetErrorString(e), grid_blocks);
#else
  for (int ph = 0; ph < 28; ++ph) hipLaunchKernelGGL(mega_kernel, dim3(256), dim3(NTHR), 0, stream, p, ph, ph + 1);
#endif
}
```

```cpp
#include <hip/hip_runtime.h>
#include <hip/hip_cooperative_groups.h>
#include <cstdio>
namespace cg = cooperative_groups;

#ifndef FUSED
#define FUSED 1
#endif

#define LAS __attribute__((address_space(3)))
typedef _Float16 h16;
typedef _Float16 h16x8 __attribute__((ext_vector_type(8)));
typedef _Float16 h16x4 __attribute__((ext_vector_type(4)));
typedef float f32x4 __attribute__((ext_vector_type(4)));
typedef unsigned long long u64;
typedef unsigned u32x4 __attribute__((ext_vector_type(4)));

constexpr int NTHR = 512;
constexpr int SEQ = 4096, NTOK = 8192, DM = 2048;
constexpr int SHM_BYTES = 147456;
constexpr float ALPHA_F = 1.6817928305074290f;
constexpr float LN_EPS_F = 1e-5f;
constexpr float LOG2E = 1.4426950408889634f;
constexpr int NSA_LD = 9472;
constexpr int KV_LD = 3840;

struct Params {
  const float* x; const int* pos;
  const float* ret_w_in[2]; const float* ret_w_out[2];
  const float* ln_g[4]; const float* ln_b[4];
  const float* w_kv; const float* pe_k; const float* pe_v; const float* w_ck1; const float* w_ck2; const float* w_cv1; const float* w_cv2;
  const float* nsa_w_in[2]; const float* nsa_w_out[2];
  float* out;
  h16* wA; h16* wB; float* xres; h16* xh; float* cs; h16* ck1T; h16* cv1T; float* biask; float* biasv; float* biasp;
  h16* qh; h16* kh; h16* kdT; h16* vT; h16* zh; h16* St; h16* Pbuf; h16* Obuf;
  h16* kvh; h16* vselT; h16* vwinT; h16* kc; h16* vcT; float* part; h16* proj; u64* masks; h16* mixed; unsigned* xbar;
};

typedef const __attribute__((address_space(4))) Params* PP;
#define WAIT_V0() asm volatile("s_waitcnt vmcnt(0)" ::: "memory")
__device__ __forceinline__ int opaque_tid() { int t = threadIdx.x; asm volatile("" : "+v"(t)); return t; }

__device__ __forceinline__ int lds_byte(int r, int c) {
  int st = (r >> 4) * 2 + (c >> 5), ob = (r & 15) * 64 + (c & 31) * 2;
  return st * 1024 + (ob ^ (((ob >> 9) & 1) << 5));
}
__device__ __forceinline__ void stage_rc(int b, int& R, int& C) {
  int st = b >> 10, sb = b & 1023, swz = sb ^ (((sb >> 9) & 1) << 5);
  R = (st >> 1) * 16 + swz / 64;
  C = (st & 1) * 32 + (swz % 64) / 2;
}
__device__ __forceinline__ float lg2gamma(int h) { return log1pf(-exp2f(-5.f - (float)h)) * LOG2E; }
__device__ __forceinline__ float sigmoidf_(float v) { return 1.f / (1.f + __expf(-v)); }
__device__ __forceinline__ float siluf_(float v) { return v / (1.f + __expf(-v)); }
__device__ __forceinline__ h16x4 cvt4(f32x4 v) { h16x4 r; r[0] = (h16)v[0]; r[1] = (h16)v[1]; r[2] = (h16)v[2]; r[3] = (h16)v[3]; return r; }

struct GOp { const h16* P; const h16* Q; long ldp, ldq; int nk, kt0, ksegP; long segP; };

__device__ __forceinline__ void gemm256(LAS char* shm, const GOp g, f32x4 (&acc)[8][4], const int tid) {
  const int wid = tid >> 6, lane = tid & 63, wr = wid >> 2, wc = wid & 3, fr = lane & 15, fq = lane >> 4;
  int offP[4], offQ[4];
#pragma unroll
  for (int i = 0; i < 4; ++i) { int R, C; stage_rc(wid * 1024 + i * 8192 + lane * 16, R, C); offP[i] = R * (int)g.ldp + C; offQ[i] = R * (int)g.ldq + C; }
#define G_STAGE(buf, t) do { const int kk_ = g.kt0 + (t); const long kp_ = (long)(kk_ / g.ksegP) * g.segP + (long)(kk_ % g.ksegP) * 64; const long kq_ = (long)kk_ * 64; \
    _Pragma("unroll") for (int i = 0; i < 4; ++i) { \
      __builtin_amdgcn_global_load_lds((const unsigned*)(g.P + offP[i] + kp_), (LAS unsigned*)(shm + (buf) * 65536 + wid * 1024 + i * 8192), 16, 0, 0); \
      __builtin_amdgcn_global_load_lds((const unsigned*)(g.Q + offQ[i] + kq_), (LAS unsigned*)(shm + (buf) * 65536 + 32768 + wid * 1024 + i * 8192), 16, 0, 0); } } while (0)
  G_STAGE(0, 0); WAIT_V0(); __syncthreads();
#pragma unroll 1
  for (int t = 0; t < g.nk; ++t) {
    const int cur = t & 1;
    if (t + 1 < g.nk) G_STAGE(cur ^ 1, t + 1);
#pragma unroll
    for (int ks = 0; ks < 2; ++ks) {
      h16x8 At[8], Bf[4];
#pragma unroll
      for (int m = 0; m < 8; ++m) At[m] = *(const LAS h16x8*)(shm + cur * 65536 + lds_byte(wr * 128 + m * 16 + fr, ks * 32 + fq * 8));
#pragma unroll
      for (int n = 0; n < 4; ++n) Bf[n] = *(const LAS h16x8*)(shm + cur * 65536 + 32768 + lds_byte(wc * 64 + n * 16 + fr, ks * 32 + fq * 8));
#pragma unroll
      for (int m = 0; m < 8; ++m)
#pragma unroll
        for (int n = 0; n < 4; ++n) acc[m][n] = __builtin_amdgcn_mfma_f32_16x16x32_f16(At[m], Bf[n], acc[m][n], 0, 0, 0);
    }
    WAIT_V0(); __syncthreads();
  }
#undef G_STAGE
}
__device__ __forceinline__ void zero_acc(f32x4 (&acc)[8][4]) {
#pragma unroll
  for (int m = 0; m < 8; ++m)
#pragma unroll
    for (int n = 0; n < 4; ++n) acc[m][n] = (f32x4){0.f, 0.f, 0.f, 0.f};
}


__device__ __forceinline__ void gemm8p(LAS char* shm, const h16* __restrict__ A, const int lda, const h16* __restrict__ Bt, const int ldb, const int nt,
                                        f32x4 (&acc)[2][2][4][2], const int tid) {
  constexpr int HTB = 128 * 64 * 2;
#define SA8(b, h) (shm + ((b) * 2 + (h)) * HTB)
#define SB8(b, h) (shm + (4 + (b) * 2 + (h)) * HTB)
  const int wid = tid >> 6, lane = tid & 63, wr = wid >> 2, wc = wid & 3, fr = lane & 15, fq = lane >> 4;
  int oa[2], ob[2];
#pragma unroll
  for (int i = 0; i < 2; ++i) { int R, C; stage_rc((tid & 511) * 16 + i * 8192, R, C); oa[i] = R * lda + C; ob[i] = R * ldb + C; }
#define STAGE8A(P_, half, kt) do { const h16* g_ = A + (long)(half) * 128 * lda + (long)(kt) * 64; \
    _Pragma("unroll") for (int i_ = 0; i_ < 2; ++i_) __builtin_amdgcn_global_load_lds((const unsigned*)(g_ + oa[i_]), (LAS unsigned*)((P_) + wid * 1024 + i_ * 8192), 16, 0, 0); } while (0)
#define STAGE8B(P_, half, kt) do { const h16* g_ = Bt + (long)(half) * 128 * ldb + (long)(kt) * 64; \
    _Pragma("unroll") for (int i_ = 0; i_ < 2; ++i_) __builtin_amdgcn_global_load_lds((const unsigned*)(g_ + ob[i_]), (LAS unsigned*)((P_) + wid * 1024 + i_ * 8192), 16, 0, 0); } while (0)
#define LDA8(dst, b, h) _Pragma("unroll") for (int m = 0; m < 4; ++m) _Pragma("unroll") for (int k = 0; k < 2; ++k) \
    dst[m][k] = *(const LAS h16x8*)(SA8(b, h) + lds_byte(wr * 64 + m * 16 + fr, k * 32 + fq * 8))
#define LDB8(dst, b, h) _Pragma("unroll") for (int n = 0; n < 2; ++n) _Pragma("unroll") for (int k = 0; k < 2; ++k) \
    dst[n][k] = *(const LAS h16x8*)(SB8(b, h) + lds_byte(wc * 32 + n * 16 + fr, k * 32 + fq * 8))
#define MMA8(ai, bj, At_, Bt_) do { __builtin_amdgcn_s_setprio(1); \
    _Pragma("unroll") for (int m = 0; m < 4; ++m) _Pragma("unroll") for (int n = 0; n < 2; ++n) _Pragma("unroll") for (int k = 0; k < 2; ++k) \
      acc[ai][bj][m][n] = __builtin_amdgcn_mfma_f32_16x16x32_f16(At_[m][k], Bt_[n][k], acc[ai][bj][m][n], 0, 0, 0); \
    __builtin_amdgcn_s_setprio(0); } while (0)
#define WAIT_V8(n) asm volatile("s_waitcnt vmcnt(" #n ")" ::: "memory")
#define WAIT_L8(n) asm volatile("s_waitcnt lgkmcnt(" #n ")" ::: "memory")
#define BAR8 __builtin_amdgcn_s_barrier()
#define SCHED8 __builtin_amdgcn_sched_barrier(0)
  h16x8 At[4][2], B0[2][2], B1[2][2];
  WAIT_V8(0);
  STAGE8B(SB8(0, 0), 0, 0); STAGE8A(SA8(0, 0), 0, 0);
  STAGE8B(SB8(0, 1), 1, 0); STAGE8A(SA8(0, 1), 1, 0);
  if (wr == 1) BAR8;
  WAIT_V8(4); BAR8;
  STAGE8B(SB8(1, 0), 0, 1); STAGE8A(SA8(1, 0), 0, 1); STAGE8B(SB8(1, 1), 1, 1);
  WAIT_V8(6); BAR8;
#pragma unroll 1
  for (int t = 0; t < nt - 2; t += 2) {
    LDB8(B0, 0, 0); SCHED8; LDA8(At, 0, 0); STAGE8A(SA8(1, 1), 1, t + 1);
    WAIT_L8(8); BAR8; WAIT_L8(0); MMA8(0, 0, At, B0); BAR8; SCHED8;
    LDB8(B1, 0, 1); STAGE8B(SB8(0, 0), 0, t + 2);
    BAR8; WAIT_L8(0); MMA8(0, 1, At, B1); BAR8;
    LDA8(At, 0, 1); STAGE8A(SA8(0, 0), 0, t + 2);
    BAR8; WAIT_L8(0); MMA8(1, 0, At, B0); BAR8; SCHED8;
    STAGE8B(SB8(0, 1), 1, t + 2);
    WAIT_V8(6); BAR8; MMA8(1, 1, At, B1); BAR8;
    LDB8(B0, 1, 0); SCHED8; LDA8(At, 1, 0); STAGE8A(SA8(0, 1), 1, t + 2);
    WAIT_L8(8); BAR8; WAIT_L8(0); MMA8(0, 0, At, B0); BAR8; SCHED8;
    LDB8(B1, 1, 1); STAGE8B(SB8(1, 0), 0, t + 3);
    BAR8; WAIT_L8(0); MMA8(0, 1, At, B1); BAR8;
    LDA8(At, 1, 1); STAGE8A(SA8(1, 0), 0, t + 3);
    BAR8; WAIT_L8(0); MMA8(1, 0, At, B0); BAR8; SCHED8;
    STAGE8B(SB8(1, 1), 1, t + 3);
    WAIT_V8(6); BAR8; MMA8(1, 1, At, B1); BAR8;
  }
  { LDB8(B0, 0, 0); LDA8(At, 0, 0); STAGE8A(SA8(1, 1), 1, nt - 1);
    BAR8; WAIT_L8(0); MMA8(0, 0, At, B0); BAR8;
    LDB8(B1, 0, 1); BAR8; WAIT_L8(0); MMA8(0, 1, At, B1); BAR8;
    LDA8(At, 0, 1); WAIT_V8(4); BAR8; WAIT_L8(0); MMA8(1, 0, At, B0); MMA8(1, 1, At, B1); BAR8; }
  { LDB8(B0, 1, 0); LDA8(At, 1, 0); WAIT_V8(2); BAR8; WAIT_L8(0); MMA8(0, 0, At, B0); BAR8;
    LDB8(B1, 1, 1); WAIT_V8(0); BAR8; WAIT_L8(0); MMA8(0, 1, At, B1); BAR8;
    LDA8(At, 1, 1); BAR8; WAIT_L8(0); MMA8(1, 0, At, B0); MMA8(1, 1, At, B1); BAR8; }
  if (wr == 0) BAR8;
#undef SA8
#undef SB8
#undef STAGE8A
#undef STAGE8B
#undef LDA8
#undef LDB8
#undef MMA8
}

__device__ __forceinline__ void conv_job(LAS char* shm, const float* __restrict__ src, int K, int N, int Npad, h16* __restrict__ dst, int& tilebase, int bid, int nb) {
  LAS unsigned* tile = (LAS unsigned*)shm;
  const int tid = threadIdx.x;
  const int nkg = K / 256, nnt = Npad / 64, nunits = nkg * nnt;
  const int n4 = tid & 15, kp = tid >> 4, nn = tid >> 3, kq = tid & 7;
  typedef _Float16 h2 __attribute__((ext_vector_type(2)));
  const int start = (int)((((long)bid - tilebase) % nb + nb) % nb);
  float4 a[4], b[4];
#define CV_LOAD(t_) do { const int k0_ = ((t_) % nkg) * 256, n0_ = ((t_) / nkg) * 64; \
    _Pragma("unroll") for (int q = 0; q < 4; ++q) { a[q] = make_float4(0.f, 0.f, 0.f, 0.f); b[q] = a[q]; \
      if (n0_ + 4 * n4 < N) { a[q] = *(const float4*)(src + (long)(k0_ + q * 64 + 2 * kp) * N + n0_ + 4 * n4); \
                               b[q] = *(const float4*)(src + (long)(k0_ + q * 64 + 2 * kp + 1) * N + n0_ + 4 * n4); } } } while (0)
  if (start < nunits) CV_LOAD(start);
  for (int t = start; t < nunits; t += nb) {
    const int k0 = (t % nkg) * 256, n0 = (t / nkg) * 64;
#pragma unroll
    for (int q = 0; q < 4; ++q) {
      LAS unsigned* tq = tile + q * 2112;
      h2 p0 = {(h16)a[q].x, (h16)b[q].x}, p1 = {(h16)a[q].y, (h16)b[q].y}, p2 = {(h16)a[q].z, (h16)b[q].z}, p3 = {(h16)a[q].w, (h16)b[q].w};
      tq[(4 * n4 + 0) * 33 + kp] = __builtin_bit_cast(unsigned, p0);
      tq[(4 * n4 + 1) * 33 + kp] = __builtin_bit_cast(unsigned, p1);
      tq[(4 * n4 + 2) * 33 + kp] = __builtin_bit_cast(unsigned, p2);
      tq[(4 * n4 + 3) * 33 + kp] = __builtin_bit_cast(unsigned, p3);
    }
    __syncthreads();
    if (t + nb < nunits) CV_LOAD(t + nb);
#pragma unroll
    for (int q = 0; q < 4; ++q) {
      const LAS unsigned* tq = tile + q * 2112 + nn * 33 + kq * 4;
      u32x4 o; o[0] = tq[0]; o[1] = tq[1]; o[2] = tq[2]; o[3] = tq[3];
      *(u32x4*)(dst + (long)(n0 + nn) * K + k0 + q * 64 + kq * 8) = o;
    }
    __syncthreads();
  }
#undef CV_LOAD
  tilebase += nunits;
}

__device__ __forceinline__ void phase_prep(PP p, LAS char* shm, int bid, int nb) {
  const int tid = threadIdx.x;
  int tb = 0;
  conv_job(shm, p->ret_w_in[0], 2048, 12288, 12288, p->wA, tb, bid, nb);
  conv_job(shm, p->ret_w_out[0], 4096, 2048, 2048, p->wB, tb, bid, nb);
  conv_job(shm, p->w_ck1, 6144, 256, 256, p->ck1T, tb, bid, nb);
  conv_job(shm, p->w_cv1, 4096, 256, 256, p->cv1T, tb, bid, nb);
  for (long i = ((long)bid * NTHR + tid) * 8; i < (long)NTOK * DM; i += (long)nb * NTHR * 8) {
    float4 a = *(const float4*)(p->x + i), b = *(const float4*)(p->x + i + 4);
    h16x8 o; o[0] = (h16)a.x; o[1] = (h16)a.y; o[2] = (h16)a.z; o[3] = (h16)a.w; o[4] = (h16)b.x; o[5] = (h16)b.y; o[6] = (h16)b.z; o[7] = (h16)b.w;
    *(h16x8*)(p->xh + i) = o;
  }
  for (int i = bid * NTHR + tid; i < NTOK * 128; i += nb * NTHR) {
    const int tok = i >> 7, f = i & 127;
    const double invf = exp2(-((double)f / 127.0) * 13.287712379549449);
    const float invf32 = (float)invf;
    const float ang = (float)p->pos[tok] * invf32;
    double a = (double)ang;
    const double k = rint(a * 0.63661977236758134308);
    const double r = (a - k * 1.5707963267948966192) - k * 6.123233995736766e-17;
    const double r2 = r * r;
    double sn = r * (1.0 + r2 * (-1.0 / 6 + r2 * (1.0 / 120 + r2 * (-1.0 / 5040 + r2 * (1.0 / 362880 + r2 * (-1.0 / 39916800 + r2 * (1.0 / 6227020800.0)))))));
    double cn = 1.0 + r2 * (-0.5 + r2 * (1.0 / 24 + r2 * (-1.0 / 720 + r2 * (1.0 / 40320 + r2 * (-1.0 / 3628800 + r2 * (1.0 / 479001600.0 + r2 * (-1.0 / 87178291200.0)))))));
    const int q = ((int)k) & 3;
    double c, s;
    if (q == 0) { c = cn; s = sn; } else if (q == 1) { c = -sn; s = cn; } else if (q == 2) { c = -cn; s = -sn; } else { c = sn; s = -cn; }
    p->cs[(long)i * 2] = (float)c; p->cs[(long)i * 2 + 1] = (float)s;
  }
  if (bid < 64) {
    const bool isk = (bid < 32); const int part = bid & 31;
    const float* pe = isk ? p->pe_k : p->pe_v; const float* w1 = isk ? p->w_ck1 : p->w_cv1; const int rng = isk ? 192 : 128;
    LAS float* red = (LAS float*)(shm + 40960);
    const int j = tid & 255, half = tid >> 8;
    float s = 0.f;
    const int i0 = part * rng + half * (rng / 2);
    for (int i = i0; i < i0 + rng / 2; ++i) s += pe[i] * w1[(long)i * 256 + j];
    red[tid] = s;
    __syncthreads();
    if (tid < 256) p->biasp[(bid) * 256 + tid] = red[tid] + red[tid + 256];
    __syncthreads();
  }
}

__device__ __forceinline__ void st_pair16(h16* p0, h16* p1, h16x4 v0, h16x4 v1, int fq) {
  typedef unsigned u32x2_t __attribute__((ext_vector_type(2)));
  const u32x2_t a = __builtin_bit_cast(u32x2_t, v0), b = __builtin_bit_cast(u32x2_t, v1);
  auto lo = __builtin_amdgcn_permlane16_swap(a[0], b[0], false, false);
  auto hi = __builtin_amdgcn_permlane16_swap(a[1], b[1], false, false);
  u32x4 o; o[0] = lo[0]; o[1] = hi[0]; o[2] = lo[1]; o[3] = hi[1];
  h16* dst = (fq & 1) ? (p1 - 4) : p0;
  *(u32x4*)dst = o;
}
template <int WHICH, bool tr>
__device__ __forceinline__ void proj_epi(PP p, int layer, const f32x4 (&acc)[2][2][4][2], const int tn, const int tm) {
  const int K = (WHICH == 1 && layer < 2) ? 4096 : 2048;
  const h16* Wt = (WHICH == 1) ? p->wB : (WHICH == 2) ? (p->wA + (long)3840 * 2048) : p->wA;
  const h16* A = (WHICH == 1) ? (layer < 2 ? p->Obuf : p->mixed) : p->xh;
  const long lda = K;
  {
    const int tid = opaque_tid(), wid = tid >> 6, lane = tid & 63, wr = wid >> 2, wc = wid & 3, fr = lane & 15, fq = lane >> 4;
    const int b = tm >> 4;
    if (tr) {
      h16* outT; long nf; int col0;
      if (WHICH == 0) { outT = p->vT; nf = 4096; col0 = (tn - 16) * 256; }
      else { outT = (tn < 10) ? p->vselT : p->vwinT; nf = 512; col0 = (tn < 10) ? (tn - 8) * 256 : (tn - 13) * 256; }
#pragma unroll
      for (int m = 0; m < 8; ++m)
#pragma unroll
        for (int n2 = 0; n2 < 2; ++n2) {
          const int feat0 = col0 + n2 * 128 + wc * 32 + fr;
          const int tl = (tm & 15) * 256 + (m >> 2) * 128 + wr * 64 + (m & 3) * 16 + fq * 4;
          h16* p0 = outT + ((long)b * nf + feat0) * SEQ + tl;
          st_pair16(p0, p0 + (long)16 * SEQ, cvt4(acc[m >> 2][n2][m & 3][0]), cvt4(acc[m >> 2][n2][m & 3][1]), fq); __builtin_amdgcn_sched_barrier(0);
        }
    } else {
      if (WHICH == 1) {
        const float* xin = (layer == 0) ? p->x : p->xres;
#pragma unroll
        for (int mp = 0; mp < 4; ++mp) {
          float4 xv[2][4];
#pragma unroll
          for (int mi = 0; mi < 2; ++mi)
#pragma unroll
            for (int n = 0; n < 4; ++n) {
              const int m = mp * 2 + mi;
              const long tok = tm * 256 + (n >> 1) * 128 + wc * 32 + (n & 1) * 16 + fr;
              xv[mi][n] = *(const float4*)(xin + tok * DM + tn * 256 + (m >> 2) * 128 + wr * 64 + (m & 3) * 16 + fq * 4);
            }
#pragma unroll
          for (int mi = 0; mi < 2; ++mi)
#pragma unroll
            for (int n = 0; n < 4; ++n) {
              const int m = mp * 2 + mi;
              const long tok = tm * 256 + (n >> 1) * 128 + wc * 32 + (n & 1) * 16 + fr;
              const long o = tok * DM + tn * 256 + (m >> 2) * 128 + wr * 64 + (m & 3) * 16 + fq * 4;
              const f32x4 a = acc[m >> 2][n >> 1][m & 3][n & 1];
              float4 r; r.x = ALPHA_F * xv[mi][n].x + a[0]; r.y = ALPHA_F * xv[mi][n].y + a[1]; r.z = ALPHA_F * xv[mi][n].z + a[2]; r.w = ALPHA_F * xv[mi][n].w + a[3];
              *(float4*)(p->xres + o) = r;
            }
          __builtin_amdgcn_sched_barrier(0);
        }
      } else if (WHICH == 0 && tn < 16) {
        const bool isk = tn >= 8; const int h = tn & 7;
        const float lg = lg2gamma(h);
        h16* outn = isk ? p->kh : p->qh;
        const float sc = isk ? 0.0625f : 1.0f;
#pragma unroll
        for (int m = 0; m < 8; ++m)
#pragma unroll
          for (int n2 = 0; n2 < 2; ++n2) {
            const int f0 = (m >> 2) * 128 + wr * 64 + (m & 3) * 16 + fq * 4;
            f32x4 rr[2];
#pragma unroll
            for (int q = 0; q < 2; ++q) {
              const int idx = n2 * 128 + wc * 32 + q * 16 + fr;
              const long tok = tm * 256 + idx;
              const float4 c = *(const float4*)(p->cs + tok * 256 + f0);
              const f32x4 a = acc[m >> 2][n2][m & 3][q];
              f32x4 r;
              r[0] = (a[0] * c.x - a[1] * c.y) * sc; r[1] = (a[0] * c.y + a[1] * c.x) * sc;
              r[2] = (a[2] * c.z - a[3] * c.w) * sc; r[3] = (a[2] * c.w + a[3] * c.z) * sc;
              rr[q] = r;
              if (isk) {
                const float dk = exp2f(lg * (float)(255 - idx));
                const long tl = (tm & 15) * 256 + idx;
                h16* kd = p->kdT + ((long)b * 2048 + h * 256 + f0) * SEQ + tl;
                kd[0] = (h16)(r[0] * dk); kd[SEQ] = (h16)(r[1] * dk); kd[2 * SEQ] = (h16)(r[2] * dk); kd[3 * SEQ] = (h16)(r[3] * dk);
              }
            }
            h16* p0 = outn + ((long)tm * 256 + n2 * 128 + wc * 32 + fr) * 2048 + h * 256 + f0;
            st_pair16(p0, p0 + 16 * 2048, cvt4(rr[0]), cvt4(rr[1]), fq);
          }
      } else {
        h16* outn; long ldo; int col0; float sc = 1.f;
        if (WHICH == 0) { outn = p->zh; ldo = 4096; col0 = (tn - 32) * 256; }
        else if (WHICH == 2) { outn = p->proj; ldo = NSA_LD; col0 = tn * 256; if (tn < 12) sc = 0.07216878364870322f * LOG2E; }
        else { outn = p->kvh; ldo = KV_LD; col0 = tn * 256; }
#pragma unroll
        for (int m = 0; m < 8; ++m)
#pragma unroll
          for (int n2 = 0; n2 < 2; ++n2) {
            const long tok0 = tm * 256 + n2 * 128 + wc * 32 + fr;
            const int f0 = col0 + (m >> 2) * 128 + wr * 64 + (m & 3) * 16 + fq * 4;
            h16* p0 = outn + tok0 * ldo + f0;
            st_pair16(p0, p0 + 16 * ldo, cvt4(acc[m >> 2][n2][m & 3][0] * sc), cvt4(acc[m >> 2][n2][m & 3][1] * sc), fq); __builtin_amdgcn_sched_barrier(0);
          }
      }
    }
  }
}

template <int WHICH>
__device__ __forceinline__ void proj_unit(PP p, int layer, int i, int& tn, int& tm, bool& tr, const h16*& Pp, const h16*& Qp) {
  const int K = (WHICH == 1 && layer < 2) ? 4096 : 2048;
  const h16* Wt = (WHICH == 1) ? p->wB : (WHICH == 2) ? (p->wA + (long)3840 * 2048) : p->wA;
  const h16* A = (WHICH == 1) ? (layer < 2 ? p->Obuf : p->mixed) : p->xh;
  tm = i % 32;
  if (WHICH == 0) { tn = i / 32; tr = (tn >= 16 && tn < 32); }
  else if (WHICH == 3) { if (i < 352) { const int j = i / 32; tn = j < 8 ? j : j + 2; tr = false; } else { const int j = (i - 352) / 32; tn = j < 2 ? 8 + j : 11 + j; tr = true; } }
  else { tn = i / 32; tr = false; }
  const h16* wt = Wt + (long)tn * 256 * K; const h16* at = A + (long)tm * 256 * K;
  Pp = tr ? at : wt; Qp = tr ? wt : at;
}
template <int WHICH>
__device__ __forceinline__ void phase_proj(PP p, int layer, LAS char* shm, int bid, int nb) {
  constexpr int NU = ((WHICH == 0) ? 48 : (WHICH == 1) ? 8 : (WHICH == 2) ? 37 : 15) * 32;
  const int K = (WHICH == 1 && layer < 2) ? 4096 : 2048;
  const int nt = K / 64;
  if (bid >= NU) return;
  constexpr int HTB = 128 * 64 * 2;
#define SA8(b, h) (shm + ((b) * 2 + (h)) * HTB)
#define SB8(b, h) (shm + (4 + (b) * 2 + (h)) * HTB)
  const int tid = opaque_tid();
  const int wid = tid >> 6, lane = tid & 63, wr = wid >> 2, wc = wid & 3, fr = lane & 15, fq = lane >> 4;
  int oo[2];
#pragma unroll
  for (int i = 0; i < 2; ++i) { int R, C; stage_rc(tid * 16 + i * 8192, R, C); oo[i] = R * K + C; }
  const h16 *cP, *cQ, *nP, *nQ; int tn, tm, ntn, ntm; bool tr, ntr;
  proj_unit<WHICH>(p, layer, bid, tn, tm, tr, cP, cQ);
#define STG(P_, base_c, base_n, half, kt) do { const h16* g_ = (((kt) < nt) ? (base_c) + (long)(kt) * 64 : (base_n) + (long)((kt) - nt) * 64) + (long)(half) * 128 * K; \
    _Pragma("unroll") for (int i_ = 0; i_ < 2; ++i_) __builtin_amdgcn_global_load_lds((const unsigned*)(g_ + oo[i_]), (LAS unsigned*)((P_) + wid * 1024 + i_ * 8192), 16, 0, 0); } while (0)
#define STAGE8A(P_, half, kt) STG(P_, cP, nP, half, kt)
#define STAGE8B(P_, half, kt) STG(P_, cQ, nQ, half, kt)
#define LDA8(dst, b, h) _Pragma("unroll") for (int m = 0; m < 4; ++m) _Pragma("unroll") for (int k = 0; k < 2; ++k) \
    dst[m][k] = *(const LAS h16x8*)(SA8(b, h) + lds_byte(wr * 64 + m * 16 + fr, k * 32 + fq * 8))
#define LDB8(dst, b, h) _Pragma("unroll") for (int n = 0; n < 2; ++n) _Pragma("unroll") for (int k = 0; k < 2; ++k) \
    dst[n][k] = *(const LAS h16x8*)(SB8(b, h) + lds_byte(wc * 32 + n * 16 + fr, k * 32 + fq * 8))
#define MMA8(ai, bj, At_, Bt_) do { __builtin_amdgcn_s_setprio(1); \
    _Pragma("unroll") for (int m = 0; m < 4; ++m) _Pragma("unroll") for (int n = 0; n < 2; ++n) _Pragma("unroll") for (int k = 0; k < 2; ++k) \
      acc[ai][bj][m][n] = __builtin_amdgcn_mfma_f32_16x16x32_f16(At_[m][k], Bt_[n][k], acc[ai][bj][m][n], 0, 0, 0); \
    __builtin_amdgcn_s_setprio(0); } while (0)
#define ZACC() do { _Pragma("unroll") for (int a_ = 0; a_ < 2; ++a_) _Pragma("unroll") for (int b_ = 0; b_ < 2; ++b_) _Pragma("unroll") for (int m_ = 0; m_ < 4; ++m_) { \
    acc[a_][b_][m_][0] = (f32x4){0.f, 0.f, 0.f, 0.f}; acc[a_][b_][m_][1] = (f32x4){0.f, 0.f, 0.f, 0.f}; } } while (0)
  f32x4 acc[2][2][4][2];
  h16x8 At[4][2], B0[2][2], B1[2][2];
  ZACC();
  nP = cP; nQ = cQ;
  WAIT_V8(0);
  STAGE8B(SB8(0, 0), 0, 0); STAGE8A(SA8(0, 0), 0, 0);
  STAGE8B(SB8(0, 1), 1, 0); STAGE8A(SA8(0, 1), 1, 0);
  if (wr == 1) BAR8;
  WAIT_V8(4); BAR8;
  STAGE8B(SB8(1, 0), 0, 1); STAGE8A(SA8(1, 0), 0, 1); STAGE8B(SB8(1, 1), 1, 1);
  WAIT_V8(6); BAR8;
#pragma unroll 1
  for (int u = bid; u < NU; u += nb) {
    if (u + nb < NU) proj_unit<WHICH>(p, layer, u + nb, ntn, ntm, ntr, nP, nQ);
    else { nP = cP; nQ = cQ; ntn = tn; ntm = tm; ntr = tr; }
#pragma unroll 1
    for (int t = 0; t < nt; t += 2) {
      LDB8(B0, 0, 0); SCHED8; LDA8(At, 0, 0); STAGE8A(SA8(1, 1), 1, t + 1);
      WAIT_L8(8); BAR8; WAIT_L8(0); MMA8(0, 0, At, B0); BAR8; SCHED8;
      LDB8(B1, 0, 1); STAGE8B(SB8(0, 0), 0, t + 2);
      BAR8; WAIT_L8(0); MMA8(0, 1, At, B1); BAR8;
      LDA8(At, 0, 1); STAGE8A(SA8(0, 0), 0, t + 2);
      BAR8; WAIT_L8(0); MMA8(1, 0, At, B0); BAR8; SCHED8;
      STAGE8B(SB8(0, 1), 1, t + 2);
      WAIT_V8(6); BAR8; MMA8(1, 1, At, B1); BAR8;
      LDB8(B0, 1, 0); SCHED8; LDA8(At, 1, 0); STAGE8A(SA8(0, 1), 1, t + 2);
      WAIT_L8(8); BAR8; WAIT_L8(0); MMA8(0, 0, At, B0); BAR8; SCHED8;
      LDB8(B1, 1, 1); STAGE8B(SB8(1, 0), 0, t + 3);
      BAR8; WAIT_L8(0); MMA8(0, 1, At, B1); BAR8;
      LDA8(At, 1, 1); STAGE8A(SA8(1, 0), 0, t + 3);
      BAR8; WAIT_L8(0); MMA8(1, 0, At, B0); BAR8; SCHED8;
      STAGE8B(SB8(1, 1), 1, t + 3);
      WAIT_V8(6); BAR8; MMA8(1, 1, At, B1); BAR8;
    }
    if (tr) proj_epi<WHICH, true>(p, layer, acc, tn, tm); else proj_epi<WHICH, false>(p, layer, acc, tn, tm);
    ZACC();
    cP = nP; cQ = nQ; tn = ntn; tm = ntm; tr = ntr;
  }
  WAIT_V8(0);
  if (wr == 0) BAR8;
  __syncthreads();
#undef SA8
#undef SB8
#undef STG
#undef STAGE8A
#undef STAGE8B
#undef LDA8
#undef LDB8
#undef MMA8
#undef ZACC
}

__device__ __forceinline__ void phase_retB(PP p, LAS char* shm, int bid, int nb) {
  for (int t = bid; t < 768; t += nb) {
    const int tid = opaque_tid(), wid = tid >> 6, lane = tid & 63, wr = wid >> 2, wc = wid & 3, fr = lane & 15, fq = lane >> 4;
    f32x4 acc[8][4];
    zero_acc(acc);
    GOp g; g.nk = 4; g.kt0 = 0; g.ksegP = 1 << 28; g.segP = 0;
    if (t < 512) {
      const int et = t & 1, c = (t >> 1) & 15, bh = t >> 5, b = bh >> 3, h = bh & 7;
      g.P = p->kdT + ((long)b * 2048 + h * 256) * SEQ + c * 256; g.ldp = SEQ;
      g.Q = p->vT + ((long)b * 4096 + h * 512 + et * 256) * SEQ + c * 256; g.ldq = SEQ;
      gemm256(shm, g, acc, tid);
      h16* st = p->St + ((long)(bh * 16 + c) * 512 + et * 256) * 256;
#pragma unroll
      for (int m = 0; m < 8; ++m)
#pragma unroll
        for (int n = 0; n < 4; ++n) {
          const int e = wc * 64 + n * 16 + fr, d0 = wr * 128 + m * 16 + fq * 4;
          *(h16x4*)(st + (long)e * 256 + d0) = cvt4(acc[m][n]); __builtin_amdgcn_sched_barrier(0);
        }
    } else {
      const int u = t - 512, c = u & 15, bh = u >> 4, b = bh >> 3, h = bh & 7;
      const float lg = lg2gamma(h);
      g.P = p->kh + ((long)b * SEQ + c * 256) * 2048 + h * 256; g.ldp = 2048;
      g.Q = p->qh + ((long)b * SEQ + c * 256) * 2048 + h * 256; g.ldq = 2048;
      gemm256(shm, g, acc, tid);
      h16* pb = p->Pbuf + ((long)bh * SEQ + c * 256) * 256;
#pragma unroll
      for (int m = 0; m < 8; ++m)
#pragma unroll
        for (int n = 0; n < 4; ++n) {
          const int qi = wc * 64 + n * 16 + fr, k0 = wr * 128 + m * 16 + fq * 4;
          f32x4 r;
#pragma unroll
          for (int j = 0; j < 4; ++j) { const int rel = qi - (k0 + j); r[j] = rel >= 0 ? acc[m][n][j] * exp2f(lg * (float)rel) : 0.f; }
          *(h16x4*)(pb + (long)qi * 256 + k0) = cvt4(r); __builtin_amdgcn_sched_barrier(0);
        }
    }
  }
}

__device__ __forceinline__ void phase_retC(PP p, int bid, int nb) {
  const int tid = threadIdx.x;
  for (int it = bid * NTHR + tid; it < 16 * 16384; it += nb * NTHR) {
    const int bh = it >> 14, idx = (it & 16383) * 8, h = bh & 7;
    const float dc = exp2f(lg2gamma(h) * 256.f);
    h16* base = p->St + (long)bh * 16 * 131072 + idx;
    h16x8 u[16];
#pragma unroll
    for (int c = 0; c < 16; ++c) u[c] = *(const h16x8*)(base + (long)c * 131072);
    float s[8];
#pragma unroll
    for (int j = 0; j < 8; ++j) s[j] = 0.f;
#pragma unroll
    for (int c = 0; c < 16; ++c) {
      h16x8 o;
#pragma unroll
      for (int j = 0; j < 8; ++j) { o[j] = (h16)s[j]; s[j] = s[j] * dc + (float)u[c][j]; }
      *(h16x8*)(base + (long)c * 131072) = o;
    }
  }
}

__device__ __forceinline__ float wave_sum(float v);
__device__ __forceinline__ void phase_retD(PP p, LAS char* shm, int bid, int nb) {
  for (int u = bid; u < 256; u += nb) {
    const int c = u & 15, bh = u >> 4, b = bh >> 3, h = bh & 7;
    const float lg = lg2gamma(h);
    for (int et = 0; et < 2; ++et) {
      const int tid = opaque_tid(), wid = tid >> 6, lane = tid & 63, wr = wid >> 2, wc = wid & 3, fr = lane & 15, fq = lane >> 4;
      f32x4 acc[8][4];
      zero_acc(acc);
      GOp g; g.nk = 4; g.kt0 = 0; g.ksegP = 1 << 28; g.segP = 0;
      g.P = p->St + ((long)(bh * 16 + c) * 512 + et * 256) * 256; g.ldp = 256;
      g.Q = p->qh + ((long)b * SEQ + c * 256) * 2048 + h * 256; g.ldq = 2048;
      gemm256(shm, g, acc, tid);
#pragma unroll
      for (int n = 0; n < 4; ++n) {
        const float dq = exp2f(lg * (float)(wc * 64 + n * 16 + fr + 1));
#pragma unroll
        for (int m = 0; m < 8; ++m) acc[m][n] = acc[m][n] * dq;
      }
      g.P = p->vT + ((long)b * 4096 + h * 512 + et * 256) * SEQ + c * 256; g.ldp = SEQ;
      g.Q = p->Pbuf + ((long)bh * SEQ + c * 256) * 256; g.ldq = 256;
      gemm256(shm, g, acc, tid);
#pragma unroll
      for (int m = 0; m < 8; ++m)
#pragma unroll
        for (int n = 0; n < 4; ++n) {
          const long tok = (long)b * SEQ + c * 256 + wc * 64 + n * 16 + fr;
          const int e0 = h * 512 + et * 256 + wr * 128 + m * 16 + fq * 4;
          *(h16x4*)(p->Obuf + tok * 4096 + e0) = cvt4(acc[m][n]); __builtin_amdgcn_sched_barrier(0);
        }
    }
    asm volatile("s_waitcnt vmcnt(0)" ::: "memory");
    __syncthreads();
    {
      const int tid = opaque_tid(), wid = tid >> 6, lane = tid & 63;
      for (int r0 = wid * 4; r0 < 256; r0 += 32) {
        h16x8 ov[4], zv[4];
#pragma unroll
        for (int q = 0; q < 4; ++q) {
          const long off = ((long)b * SEQ + c * 256 + r0 + q) * 4096 + h * 512 + lane * 8;
          ov[q] = *(const h16x8*)(p->Obuf + off); zv[q] = *(const h16x8*)(p->zh + off);
        }
#pragma unroll
        for (int q = 0; q < 4; ++q) {
          const long off = ((long)b * SEQ + c * 256 + r0 + q) * 4096 + h * 512 + lane * 8;
          float o[8]; float s = 0.f;
#pragma unroll
          for (int j = 0; j < 8; ++j) { o[j] = (float)ov[q][j]; s += o[j]; }
          const float mu = wave_sum(s) * (1.f / 512.f);
          float qq = 0.f;
#pragma unroll
          for (int j = 0; j < 8; ++j) { const float d = o[j] - mu; qq += d * d; }
          const float rstd = rsqrtf(wave_sum(qq) * (1.f / 512.f) + LN_EPS_F);
          h16x8 rr;
#pragma unroll
          for (int j = 0; j < 8; ++j) rr[j] = (h16)((o[j] - mu) * rstd * siluf_((float)zv[q][j]));
          *(h16x8*)(p->Obuf + off) = rr;
        }
      }
    }
    __syncthreads();
  }
}

__device__ __forceinline__ float wave_sum(float v) {
#pragma unroll
  for (int o = 32; o >= 1; o >>= 1) v += __shfl_xor(v, o);
  return v;
}

__device__ __forceinline__ void phase_retE(PP p, int bid, int nb) {
  const int tid = threadIdx.x, wid = tid >> 6, lane = tid & 63;
  for (int row = bid * 8 + wid; row < NTOK * 8; row += nb * 8) {
    const long off = (long)row * 512 + lane * 8;
    h16x8 ov = *(const h16x8*)(p->Obuf + off), zv = *(const h16x8*)(p->zh + off);
    float o[8]; float s = 0.f;
#pragma unroll
    for (int j = 0; j < 8; ++j) { o[j] = (float)ov[j]; s += o[j]; }
    const float mu = wave_sum(s) * (1.f / 512.f);
    float q = 0.f;
#pragma unroll
    for (int j = 0; j < 8; ++j) { const float d = o[j] - mu; q += d * d; }
    const float rstd = rsqrtf(wave_sum(q) * (1.f / 512.f) + LN_EPS_F);
    h16x8 r;
#pragma unroll
    for (int j = 0; j < 8; ++j) r[j] = (h16)((o[j] - mu) * rstd * siluf_((float)zv[j]));
    *(h16x8*)(p->Obuf + off) = r;
  }
}

__device__ __forceinline__ void phase_ln(PP p, int layer, LAS char* shm, int bid, int nb) {
  const int tid = threadIdx.x, wid = tid >> 6, lane = tid & 63;
  const float* gw = p->ln_g[layer]; const float* bw = p->ln_b[layer];
  float* dst = (layer == 3) ? p->out : p->xres;
  float4 gg8[8], bb8[8];
#pragma unroll
  for (int i = 0; i < 8; ++i) { gg8[i] = *(const float4*)(gw + i * 256 + lane * 4); bb8[i] = *(const float4*)(bw + i * 256 + lane * 4); }
  for (int row0 = bid * 8 + wid; row0 < NTOK; row0 += nb * 16) {
    const int row1 = row0 + nb * 8;
    const bool has1 = row1 < NTOK;
    float4 v[2][8];
#pragma unroll
    for (int i = 0; i < 8; ++i) {
      v[0][i] = *(const float4*)(p->xres + (long)row0 * DM + i * 256 + lane * 4);
      v[1][i] = has1 ? *(const float4*)(p->xres + (long)row1 * DM + i * 256 + lane * 4) : make_float4(0.f, 0.f, 0.f, 0.f);
    }
#pragma unroll
    for (int q = 0; q < 2; ++q) {
      const int row = q ? row1 : row0;
      float s = 0.f;
#pragma unroll
      for (int i = 0; i < 8; ++i) s += v[q][i].x + v[q][i].y + v[q][i].z + v[q][i].w;
      const float mu = wave_sum(s) * (1.f / 2048.f);
      float qq = 0.f;
#pragma unroll
      for (int i = 0; i < 8; ++i) { float a = v[q][i].x - mu, b = v[q][i].y - mu, c = v[q][i].z - mu, d = v[q][i].w - mu; qq += a * a + b * b + c * c + d * d; }
      const float rstd = rsqrtf(wave_sum(qq) * (1.f / 2048.f) + LN_EPS_F);
      if (q == 0 || has1) {
#pragma unroll
        for (int i = 0; i < 8; ++i) {
          const int col = i * 256 + lane * 4;
          const float4 gg = gg8[i], bb = bb8[i];
          float4 r; r.x = (v[q][i].x - mu) * rstd * gg.x + bb.x; r.y = (v[q][i].y - mu) * rstd * gg.y + bb.y; r.z = (v[q][i].z - mu) * rstd * gg.z + bb.z; r.w = (v[q][i].w - mu) * rstd * gg.w + bb.w;
          *(float4*)(dst + (long)row * DM + col) = r;
          h16x4 hv; hv[0] = (h16)r.x; hv[1] = (h16)r.y; hv[2] = (h16)r.z; hv[3] = (h16)r.w;
          *(h16x4*)(p->xh + (long)row * DM + col) = hv;
        }
      }
    }
  }
  __syncthreads();
  int tb = 0;
  if (layer == 0) {
    conv_job(shm, p->ret_w_in[1], 2048, 12288, 12288, p->wA, tb, bid, nb);
    conv_job(shm, p->ret_w_out[1], 4096, 2048, 2048, p->wB, tb, bid, nb);
  } else if (layer == 1) {
    conv_job(shm, p->w_kv, 2048, 3840, 3840, p->wA, tb, bid, nb);
    conv_job(shm, p->nsa_w_in[0], 2048, 9264, 9472, p->wA + (long)3840 * 2048, tb, bid, nb);
    conv_job(shm, p->nsa_w_out[0], 2048, 2048, 2048, p->wB, tb, bid, nb);
  } else if (layer == 2) {
    conv_job(shm, p->nsa_w_in[1], 2048, 9264, 9472, p->wA + (long)3840 * 2048, tb, bid, nb);
    conv_job(shm, p->nsa_w_out[1], 2048, 2048, 2048, p->wB, tb, bid, nb);
  }
}

__device__ __forceinline__ void phase_cmp1(PP p, LAS char* shm, int bid, int nb) {
  for (int t = bid; t < 256; t += nb) {
    const int tid = opaque_tid(), wid = tid >> 6, lane = tid & 63, wr = wid >> 2, wc = wid & 3, fr = lane & 15, fq = lane >> 4;
    const int kv = t >> 7, bg = (t >> 4) & 7, sp = t & 15, b = bg >> 2, gq = bg & 3;
    f32x4 acc[8][4];
    zero_acc(acc);
    GOp g;
    g.ldp = 16 * KV_LD; g.segP = KV_LD;
    if (kv == 0) { g.P = p->kvh + (long)b * SEQ * KV_LD + gq * 192; g.ksegP = 3; g.nk = 6; g.kt0 = 6 * sp; g.Q = p->ck1T; g.ldq = 6144; }
    else { g.P = p->kvh + (long)b * SEQ * KV_LD + 768 + gq * 128; g.ksegP = 2; g.nk = 4; g.kt0 = 4 * sp; g.Q = p->cv1T; g.ldq = 4096; }
    gemm256(shm, g, acc, tid);
    float* pt = p->part + (long)t * 65536;
#pragma unroll
    for (int m = 0; m < 8; ++m)
#pragma unroll
      for (int n = 0; n < 4; ++n) {
        *(f32x4*)(pt + (long)(wc * 64 + n * 16 + fr) * 256 + wr * 128 + m * 16 + fq * 4) = acc[m][n]; __builtin_amdgcn_sched_barrier(0);
      }
  }
}

__device__ __forceinline__ void phase_cmp2(PP p, LAS char* shm, int bid, int nb) {
  const int tid = threadIdx.x;
  LAS float* hid = (LAS float*)shm;
  for (int t = bid; t < 512; t += nb) {
    const int kv = t >> 8, bg = (t >> 5) & 7, ng = t & 31;
    const float* pt = p->part + (long)(kv * 128 + bg * 16) * 65536;
    const float* bias = p->biasp + (kv ? 32 * 256 : 0);
#pragma unroll
    for (int i = 0; i < 4; ++i) {
      const int e = tid + i * 512, nl = e & 7, hh = e >> 3;
      float s = 0.f;
      for (int pp = 0; pp < 32; ++pp) s += bias[pp * 256 + hh];
      for (int sp = 0; sp < 16; ++sp) s += pt[(long)sp * 65536 + (long)hh * 256 + ng * 8 + nl];
      hid[nl * 256 + hh] = siluf_(s);
    }
    __syncthreads();
    if (kv == 0) {
#pragma unroll
      for (int i = 0; i < 3; ++i) {
        const int o = tid + i * 512, nl = o / 192, j = o % 192, n = ng * 8 + nl;
        float s = 0.f;
        for (int hh = 0; hh < 256; ++hh) s += hid[nl * 256 + hh] * p->w_ck2[hh * 192 + j];
        p->kc[((long)bg * 256 + n) * 192 + j] = (n < 255) ? (h16)s : (h16)0.f;
      }
    } else {
#pragma unroll
      for (int i = 0; i < 2; ++i) {
        const int o = tid + i * 512, nl = o >> 7, j = o & 127, n = ng * 8 + nl;
        float s = 0.f;
        for (int hh = 0; hh < 256; ++hh) s += hid[nl * 256 + hh] * p->w_cv2[hh * 128 + j];
        p->vcT[((long)bg * 128 + j) * 256 + n] = (n < 255) ? (h16)s : (h16)0.f;
      }
    }
    __syncthreads();
  }
}

__device__ __forceinline__ void phase_select(PP p, LAS char* shm, int bid, int nb) {
  LAS float* psel = (LAS float*)(shm + 102400);
  for (int u = bid; u < 1024; u += nb) {
    const int tid = opaque_tid(), wid = tid >> 6, lane = tid & 63, fr = lane & 15, fq = lane >> 4;
    const int r = wid >> 1, th = wid & 1;
    const int bg = u >> 7, tile = u & 127, b = bg >> 2, gq = bg & 3, t0 = tile * 32;
    const h16* kcb = p->kc + (long)bg * 256 * 192;
    { const int row = tid >> 1, c0 = (tid & 1) * 12;
      const h16* src = kcb + row * 192 + c0 * 8; LAS char* dl = shm + row * 400 + c0 * 16;
#pragma unroll
      for (int i = 0; i < 12; ++i) *(LAS u32x4*)(dl + i * 16) = *(const u32x4*)(src + i * 8); }
    const int tq = t0 + th * 16 + fr;
    const h16* qrow = p->proj + ((long)b * SEQ + tq) * NSA_LD + (gq * 4 + r) * 192 + fq * 8;
    h16x8 qf[6];
#pragma unroll
    for (int ks = 0; ks < 6; ++ks) qf[ks] = *(const h16x8*)(qrow + ks * 32);
    __syncthreads();
    f32x4 s[16];
#pragma unroll
    for (int mt = 0; mt < 16; ++mt) s[mt] = (f32x4){0.f, 0.f, 0.f, 0.f};
#pragma unroll
    for (int ks = 0; ks < 6; ++ks)
#pragma unroll
      for (int mt = 0; mt < 16; ++mt) {
        const h16x8 kf = *(const LAS h16x8*)(shm + (mt * 16 + fr) * 400 + (ks * 32 + fq * 8) * 2);
        s[mt] = __builtin_amdgcn_mfma_f32_16x16x32_f16(kf, qf[ks], s[mt], 0, 0, 0);
      }
    float mx = -1e30f;
#pragma unroll
    for (int mt = 0; mt < 16; ++mt)
#pragma unroll
      for (int j = 0; j < 4; ++j) {
        const int n = mt * 16 + fq * 4 + j;
        const bool valid = (n < 255) && (16 * n + 31 <= tq);
        const float v = valid ? s[mt][j] : -1e30f;
        s[mt][j] = v; mx = fmaxf(mx, v);
      }
    mx = fmaxf(mx, __shfl_xor(mx, 16)); mx = fmaxf(mx, __shfl_xor(mx, 32));
    float l = 0.f;
#pragma unroll
    for (int mt = 0; mt < 16; ++mt)
#pragma unroll
      for (int j = 0; j < 4; ++j) { const float pv = (s[mt][j] > -1e29f) ? __builtin_amdgcn_exp2f(s[mt][j] - mx) : 0.f; s[mt][j] = pv; l += pv; }
    l += __shfl_xor(l, 16); l += __shfl_xor(l, 32);
    const float inv = l > 0.f ? 1.f / l : 0.f;
#pragma unroll
    for (int mt = 0; mt < 16; ++mt) {
      const float own = s[mt][0] + 2.f * (s[mt][1] + s[mt][2] + s[mt][3]);
      const float x1 = __shfl(s[mt][0], (lane + 16) & 63);
      const float nx = (mt < 15) ? s[(mt + 1) & 15][0] : 0.f;
      const float x2 = __shfl(nx, (lane + 16) & 63);
      const float val = (own + (fq < 3 ? x1 : x2)) * inv;
      psel[(r * 32 + th * 16 + fr) * 64 + mt * 4 + fq] = val;
    }
    __syncthreads();
#pragma unroll
    for (int i = 0; i < 4; ++i) {
      const int tl = wid * 4 + i, t = t0 + tl, cur = t >> 6, j = lane;
      const float ps = psel[(0 * 32 + tl) * 64 + j] + psel[(1 * 32 + tl) * 64 + j] + psel[(2 * 32 + tl) * 64 + j] + psel[(3 * 32 + tl) * 64 + j];
      const bool forced = (j == 0) || (j == cur) || (j == cur - 1);
      const float score = forced ? 1e9f : (j <= cur ? ps : -1.0f);
      int rank = 0;
#pragma unroll
      for (int k = 0; k < 64; ++k) { const float sk = __int_as_float(__builtin_amdgcn_readlane(__float_as_int(score), k)); rank += (sk > score || (sk == score && k < j)) ? 1 : 0; }
      const u64 mk = __ballot(rank < 16);
      if (lane == 0) p->masks[(long)bg * SEQ + t] = mk;
    }
    __syncthreads();
  }
}


__device__ __forceinline__ float xr_max(float v) {
  const unsigned u = __float_as_uint(v);
  auto r = __builtin_amdgcn_permlane16_swap(u, u, false, false);
  const float a = fmaxf(__uint_as_float(r[0]), __uint_as_float(r[1]));
  const unsigned ua = __float_as_uint(a);
  auto r2 = __builtin_amdgcn_permlane32_swap(ua, ua, false, false);
  return fmaxf(__uint_as_float(r2[0]), __uint_as_float(r2[1]));
}
__device__ __forceinline__ float xr_sum(float v) {
  const unsigned u = __float_as_uint(v);
  auto r = __builtin_amdgcn_permlane16_swap(u, u, false, false);
  const float a = __uint_as_float(r[0]) + __uint_as_float(r[1]);
  const unsigned ua = __float_as_uint(a);
  auto r2 = __builtin_amdgcn_permlane32_swap(ua, ua, false, false);
  return __uint_as_float(r2[0]) + __uint_as_float(r2[1]);
}
constexpr int FK_OFF = 0, FV_OFF = 25600, FQ_OFF = 44032;
__device__ __forceinline__ void flash_branch(PP p, LAS char* shm, int branch, int b, int gq, int t0, const h16x8 (&qf)[2][6]) {
  const int tid = opaque_tid(), wid = tid >> 6, lane = tid & 63, fr = lane & 15, fq = lane >> 4;
  const int r = wid >> 1, th = wid & 1, bg = b * 4 + gq, hd = gq * 4 + r;
  const int cur = t0 >> 6;
  const h16* Kb; long ldk; const h16* VTb; long ldvt; int jlo, jhi;
  if (branch == 0) { Kb = p->kc + (long)bg * 256 * 192; ldk = 192; VTb = p->vcT + (long)bg * 128 * 256; ldvt = 256; jlo = 0; jhi = (t0 + 32) >> 10; if (jhi > 3) jhi = 3; }
  else if (branch == 1) { Kb = p->kvh + (long)b * SEQ * KV_LD + 1280 + gq * 192; ldk = KV_LD; VTb = p->vselT + ((long)b * 512 + gq * 128) * SEQ; ldvt = SEQ; jlo = 0; jhi = cur; }
  else { Kb = p->kvh + (long)b * SEQ * KV_LD + 2560 + gq * 192; ldk = KV_LD; VTb = p->vwinT + ((long)b * 512 + gq * 128) * SEQ; ldvt = SEQ; jlo = cur - 8 > 0 ? cur - 8 : 0; jhi = cur; }
  int tq[2]; u64 mk[2];
#pragma unroll
  for (int nt = 0; nt < 2; ++nt) { tq[nt] = t0 + th * 32 + nt * 16 + fr; mk[nt] = (branch == 1) ? p->masks[(long)bg * SEQ + tq[nt]] : 0ull; }
  f32x4 O[8][2];
#pragma unroll
  for (int et = 0; et < 8; ++et) { O[et][0] = (f32x4){0.f, 0.f, 0.f, 0.f}; O[et][1] = (f32x4){0.f, 0.f, 0.f, 0.f}; }
  float mrun[2] = {-1e30f, -1e30f}, lrun[2] = {0.f, 0.f};
  int koff[4], voff[3];
#pragma unroll
  for (int i = 0; i < 4; ++i) { const int c = (wid + 8 * i) * 64 + lane, row = c / 25, ch = c % 25; koff[i] = row * (int)ldk + (ch < 24 ? ch : 23) * 8; }
#pragma unroll
  for (int i = 0; i < 3; ++i) { const int c = (wid + 8 * i) * 64 + lane, e = c / 9, ch = c % 9; voff[i] = e * (int)ldvt + (ch < 8 ? ch : 7) * 8; }
#define F_STAGE(j, buf) do { \
    const h16* kb_ = Kb + (long)(j) * 64 * ldk; const h16* vb_ = VTb + (long)(j) * 64; LAS char* lb_ = shm + (buf) * 44032; \
    _Pragma("unroll") for (int i = 0; i < 4; ++i) if (wid + 8 * i < 25) __builtin_amdgcn_global_load_lds((const unsigned*)(kb_ + koff[i]), (LAS unsigned*)(lb_ + FK_OFF + (wid + 8 * i) * 1024), 16, 0, 0); \
    _Pragma("unroll") for (int i = 0; i < 3; ++i) if (wid + 8 * i < 18) __builtin_amdgcn_global_load_lds((const unsigned*)(vb_ + voff[i]), (LAS unsigned*)(lb_ + FV_OFF + (wid + 8 * i) * 1024), 16, 0, 0); } while (0)
  F_STAGE(jlo, 0);
  asm volatile("s_waitcnt vmcnt(0)" ::: "memory");
  __syncthreads();
  for (int j = jlo; j <= jhi; ++j) {
    const int cb = (j - jlo) & 1;
    LAS char* lb = shm + cb * 44032;
    if (j + 1 <= jhi) F_STAGE(j + 1, cb ^ 1);
    f32x4 s[4][2];
#pragma unroll
    for (int mt = 0; mt < 4; ++mt) { s[mt][0] = (f32x4){0.f, 0.f, 0.f, 0.f}; s[mt][1] = (f32x4){0.f, 0.f, 0.f, 0.f}; }
#pragma unroll
    for (int ks = 0; ks < 6; ++ks) {
      const h16x8 q0 = qf[0][ks], q1 = qf[1][ks];
#pragma unroll
      for (int mt = 0; mt < 4; ++mt) {
        const h16x8 kf = *(const LAS h16x8*)(lb + FK_OFF + (mt * 16 + fr) * 400 + (ks * 32 + fq * 8) * 2);
        s[mt][0] = __builtin_amdgcn_mfma_f32_16x16x32_f16(kf, q0, s[mt][0], 0, 0, 0);
        s[mt][1] = __builtin_amdgcn_mfma_f32_16x16x32_f16(kf, q1, s[mt][1], 0, 0, 0);
      }
    }
    __builtin_amdgcn_sched_group_barrier(0x100, 4, 0);
#pragma unroll
    for (int i = 0; i < 20; ++i) { __builtin_amdgcn_sched_group_barrier(0x100, 1, 0); __builtin_amdgcn_sched_group_barrier(0x008, 2, 0); }
    __builtin_amdgcn_sched_group_barrier(0x008, 8, 0);
    h16x8 pf[2][2];
    const bool full = (branch == 0) || (branch == 1 && j == cur) || (branch == 2 && (j == cur || j == cur - 8));
#pragma unroll
    for (int nt = 0; nt < 2; ++nt) {
      if (full) {
#pragma unroll
        for (int mt = 0; mt < 4; ++mt)
#pragma unroll
          for (int jj = 0; jj < 4; ++jj) {
            const int key = j * 64 + mt * 16 + fq * 4 + jj;
            bool valid;
            if (branch == 0) valid = (key < 255) && (16 * key + 31 <= tq[nt]);
            else if (branch == 1) valid = ((mk[nt] >> j) & 1ull) && (key <= tq[nt]);
            else valid = (key <= tq[nt]) && (tq[nt] - key < 512);
            s[mt][nt][jj] = valid ? s[mt][nt][jj] : -1e30f;
          }
      } else if (branch == 1) {
        const bool selb = (mk[nt] >> j) & 1ull;
#pragma unroll
        for (int mt = 0; mt < 4; ++mt)
#pragma unroll
          for (int jj = 0; jj < 4; ++jj) s[mt][nt][jj] = selb ? s[mt][nt][jj] : -1e30f;
      }
      float mx = fmaxf(fmaxf(s[0][nt][0], s[0][nt][1]), fmaxf(s[0][nt][2], s[0][nt][3]));
#pragma unroll
      for (int mt = 1; mt < 4; ++mt) mx = fmaxf(mx, fmaxf(fmaxf(s[mt][nt][0], s[mt][nt][1]), fmaxf(s[mt][nt][2], s[mt][nt][3])));
      mx = xr_max(mx);
      const float mold = mrun[nt];
      const float mnew = fmaxf(mold, mx);
      const float msafe = fmaxf(mnew, -1e29f);
      mrun[nt] = mnew;
      float rs = 0.f;
#pragma unroll
      for (int mt = 0; mt < 4; ++mt)
#pragma unroll
        for (int jj = 0; jj < 4; ++jj) { const float pv = __builtin_amdgcn_exp2f(s[mt][nt][jj] - msafe); s[mt][nt][jj] = pv; rs += pv; }
      rs = xr_sum(rs);
      if (__builtin_amdgcn_ballot_w64(mnew > mold) != 0ull) {
        const float alpha = __builtin_amdgcn_exp2f(mold - mnew);
        lrun[nt] = lrun[nt] * alpha + rs;
#pragma unroll
        for (int et = 0; et < 8; ++et) O[et][nt] = O[et][nt] * alpha;
      } else {
        lrun[nt] += rs;
      }
#pragma unroll
      for (int k2 = 0; k2 < 2; ++k2)
#pragma unroll
        for (int jj = 0; jj < 4; ++jj) { pf[nt][k2][jj] = (h16)s[2 * k2][nt][jj]; pf[nt][k2][4 + jj] = (h16)s[2 * k2 + 1][nt][jj]; }
    }
#pragma unroll
    for (int et = 0; et < 8; ++et)
#pragma unroll
      for (int k2 = 0; k2 < 2; ++k2) {
        const LAS char* va = lb + FV_OFF + (et * 16 + fr) * 144 + (k2 * 32 + fq * 4) * 2;
        const h16x4 lo = *(const LAS h16x4*)va, hi = *(const LAS h16x4*)(va + 32);
        h16x8 vf; vf[0] = lo[0]; vf[1] = lo[1]; vf[2] = lo[2]; vf[3] = lo[3]; vf[4] = hi[0]; vf[5] = hi[1]; vf[6] = hi[2]; vf[7] = hi[3];
        O[et][0] = __builtin_amdgcn_mfma_f32_16x16x32_f16(vf, pf[0][k2], O[et][0], 0, 0, 0);
        O[et][1] = __builtin_amdgcn_mfma_f32_16x16x32_f16(vf, pf[1][k2], O[et][1], 0, 0, 0);
      }
    __builtin_amdgcn_sched_group_barrier(0x100, 4, 0);
#pragma unroll
    for (int i = 0; i < 14; ++i) { __builtin_amdgcn_sched_group_barrier(0x100, 2, 0); __builtin_amdgcn_sched_group_barrier(0x008, 2, 0); }
    __builtin_amdgcn_sched_group_barrier(0x008, 4, 0);
    asm volatile("s_waitcnt vmcnt(0)" ::: "memory");
    __syncthreads();
  }
#undef F_STAGE
#pragma unroll
  for (int nt = 0; nt < 2; ++nt) {
    const long tok = (long)b * SEQ + tq[nt];
    const h16* pr = p->proj + tok * NSA_LD;
    const float gt = sigmoidf_((float)pr[9216 + branch * 16 + hd]);
    const float inv = lrun[nt] > 0.f ? gt / lrun[nt] : 0.f;
#pragma unroll
    for (int et = 0; et < 8; ++et) {
      const int e0 = hd * 128 + et * 16 + fq * 4;
      const h16x4 zv = *(const h16x4*)(pr + 3072 + branch * 2048 + e0);
      h16* mp = p->mixed + tok * DM + e0;
      f32x4 r;
#pragma unroll
      for (int jj = 0; jj < 4; ++jj) r[jj] = O[et][nt][jj] * inv * siluf_((float)zv[jj]);
      if (branch != 0) { const h16x4 old = *(const h16x4*)mp; r[0] += (float)old[0]; r[1] += (float)old[1]; r[2] += (float)old[2]; r[3] += (float)old[3]; }
      *(h16x4*)mp = cvt4(r);
    }
  }
}

__device__ __forceinline__ void phase_attn(PP p, LAS char* shm, int bid, int nb) {
  for (int u0 = bid; u0 < 256; u0 += nb) {
    const int u = (nb == 256) ? ((u0 & 7) << 5 | (u0 >> 3)) : u0;
    const int bg = u >> 5, pr = u & 31, b = bg >> 2, gq = bg & 3;
    for (int half = 0; half < 2; ++half) {
      const int tile = half ? 63 - pr : pr, t0 = tile * 64;
      h16x8 qf[2][6];
      { const int tid = opaque_tid(), wid = tid >> 6, lane = tid & 63, fr = lane & 15, fq = lane >> 4, r = wid >> 1, th = wid & 1;
#pragma unroll
        for (int nt = 0; nt < 2; ++nt) {
          const h16* qrow = p->proj + ((long)b * SEQ + t0 + th * 32 + nt * 16 + fr) * NSA_LD + (gq * 4 + r) * 192 + fq * 8;
#pragma unroll
          for (int ks = 0; ks < 6; ++ks) qf[nt][ks] = *(const h16x8*)(qrow + ks * 32);
        } }
      flash_branch(p, shm, 0, b, gq, t0, qf);
      flash_branch(p, shm, 1, b, gq, t0, qf);
      flash_branch(p, shm, 2, b, gq, t0, qf);
    }
  }
}


#define XB_TMO      128
#define XB_XCNT(j)  (256  + 64 * (j))
#define XB_XSUB(j)  (1280 + 64 * (j))
#define XB_XGEN(j)  (2304 + 64 * (j))
#define XB_TOP      3328
#define XB_TOPGEN   3392
#define XCD_BAR_WORDS 3456
#define XB_SPIN_CAP (1u << 18)
__device__ __forceinline__ unsigned xb_ld(unsigned* p)              { return __hip_atomic_load(p, __ATOMIC_RELAXED, __HIP_MEMORY_SCOPE_AGENT); }
__device__ __forceinline__ unsigned xb_add(unsigned* p, unsigned v) { return __hip_atomic_fetch_add(p, v, __ATOMIC_RELAXED, __HIP_MEMORY_SCOPE_AGENT); }
__device__ __forceinline__ unsigned xb_xcc_id() { return (unsigned)__builtin_amdgcn_s_getreg((3 << 11) | 20) & 0xFu; }
#define XB_SPIN(cond, bar) do { unsigned _sp = 0; while (cond) { __builtin_amdgcn_s_sleep(1); \
    if ((++_sp & 255u) == 0u) { if (xb_ld(&(bar)[XB_TMO])) break; if (_sp > XB_SPIN_CAP) { atomicAdd(&(bar)[XB_TMO], 1u); break; } } } } while (0)
struct XcdBarrier { unsigned* bar; unsigned x; volatile LAS unsigned* st; };
__device__ __forceinline__ XcdBarrier xcd_barrier_post(unsigned* bar, volatile LAS unsigned* st) {
  XcdBarrier b; b.bar = bar; b.x = xb_xcc_id(); b.st = st;
  if (threadIdx.x == 0) (void)xb_add(&bar[XB_XCNT(b.x)], 1u);
  return b;
}
__device__ __forceinline__ void xcd_barrier_complete(unsigned* bar, unsigned x, unsigned& nloc, unsigned& nx) {
  const unsigned G = gridDim.x * gridDim.y * gridDim.z;
  unsigned sum, cnt, mine, sp = 0u;
  for (;;) {
    sum = 0u; cnt = 0u; mine = 0u;
#pragma unroll
    for (unsigned j = 0; j < 16; ++j) { const unsigned c = xb_ld(&bar[XB_XCNT(j)]); sum += c; cnt += (c > 0u) ? 1u : 0u; mine = (j == x) ? c : mine; }
    if (sum == G) break;
    __builtin_amdgcn_s_sleep(1);
    if ((++sp & 255u) == 0u) { if (xb_ld(&bar[XB_TMO])) break; if (sp > XB_SPIN_CAP) { atomicAdd(&bar[XB_TMO], 1u); break; } }
  }
  nloc = mine > 0u ? mine : 1u; nx = cnt > 0u ? cnt : 1u;
}
__device__ __forceinline__ void xcd_barrier(const XcdBarrier& b) {
  asm volatile("s_waitcnt vmcnt(0)" ::: "memory");
  __syncthreads();
  if (threadIdx.x == 0) {
    unsigned* bar = b.bar;
    __builtin_amdgcn_s_waitcnt(0);
    unsigned nloc = b.st[0], nx = b.st[1];
    if (nloc == 0u) { xcd_barrier_complete(bar, b.x, nloc, nx); b.st[0] = nloc; b.st[1] = nx; }
    const unsigned old = xb_add(&bar[XB_XSUB(b.x)], 1u);
    const unsigned gen = old / nloc;
    if (old + 1u == (gen + 1u) * nloc) {
      __builtin_amdgcn_fence(__ATOMIC_RELEASE, "agent");
      asm volatile("s_waitcnt vmcnt(0)" ::: "memory");
      const unsigned og = xb_add(&bar[XB_TOP], 1u);
      const unsigned tg = og / nx;
      if (og + 1u == (tg + 1u) * nx) xb_add(&bar[XB_TOPGEN], 1u);
      else XB_SPIN(xb_ld(&bar[XB_TOPGEN]) == tg, bar);
      __builtin_amdgcn_fence(__ATOMIC_ACQUIRE, "agent");
      xb_add(&bar[XB_XGEN(b.x)], 1u);
      asm volatile("s_waitcnt vmcnt(0)" ::: "memory");
    } else {
      XB_SPIN(xb_ld(&bar[XB_XGEN(b.x)]) == gen, bar);
      __builtin_amdgcn_fence(__ATOMIC_ACQUIRE, "agent");
      asm volatile("s_waitcnt vmcnt(0)" ::: "memory");
    }
  }
  __syncthreads();
}

__global__ void __launch_bounds__(NTHR) mega_kernel(Params pk, int ph_lo, int ph_hi) {
  __shared__ __attribute__((aligned(1024))) char shm_raw[SHM_BYTES];
  LAS char* shm = (LAS char*)shm_raw;
  cg::grid_group grid = cg::this_grid();
  const int bid = blockIdx.x, nb = gridDim.x;
  if (threadIdx.x < 4) ((LAS unsigned*)(shm + SHM_BYTES - 16))[threadIdx.x] = 0u;
  __syncthreads();
  XcdBarrier xb;
  { PP p0 = (PP)__builtin_amdgcn_kernarg_segment_ptr(); xb = xcd_barrier_post(p0->xbar, (volatile LAS unsigned*)(shm + SHM_BYTES - 16)); }
#define PH(k, call) if (ph_lo <= (k) && (k) < ph_hi) { PP p = (PP)__builtin_amdgcn_kernarg_segment_ptr(); asm volatile("" : "+s"(p)); call; if ((k) + 1 < ph_hi) xcd_barrier(xb); }
  if (ph_lo < 0) { asm volatile("s_waitcnt vmcnt(0)" ::: "memory"); __syncthreads(); grid.sync(); }
  PH(0, phase_prep(p, shm, bid, nb))
  PH(1, phase_proj<0>(p, 0, shm, bid, nb))
  PH(2, phase_retB(p, shm, bid, nb))
  PH(3, phase_retC(p, bid, nb))
  PH(4, phase_retD(p, shm, bid, nb))
  PH(6, phase_proj<1>(p, 0, shm, bid, nb))
  PH(7, phase_ln(p, 0, shm, bid, nb))
  PH(8, phase_proj<0>(p, 1, shm, bid, nb))
  PH(9, phase_retB(p, shm, bid, nb))
  PH(10, phase_retC(p, bid, nb))
  PH(11, phase_retD(p, shm, bid, nb))
  PH(13, phase_proj<1>(p, 1, shm, bid, nb))
  PH(14, phase_ln(p, 1, shm, bid, nb))
  PH(15, (phase_proj<3>(p, 2, shm, bid, nb), phase_proj<2>(p, 2, shm, bid, nb)))
  PH(16, phase_cmp1(p, shm, bid, nb))
  PH(17, phase_cmp2(p, shm, bid, nb))
  PH(19, phase_select(p, shm, bid, nb))
  PH(20, phase_attn(p, shm, bid, nb))
  PH(21, phase_proj<1>(p, 2, shm, bid, nb))
  PH(22, phase_ln(p, 2, shm, bid, nb))
  PH(23, phase_proj<2>(p, 3, shm, bid, nb))
  PH(24, phase_select(p, shm, bid, nb))
  PH(25, phase_attn(p, shm, bid, nb))
  PH(26, phase_proj<1>(p, 3, shm, bid, nb))
  PH(27, phase_ln(p, 3, shm, bid, nb))
#undef PH
}

extern "C" void kernel_launch(void* const* d_in, const int* in_sizes, int n_in, void* d_out, int out_size, void* d_ws, size_t ws_size, hipStream_t stream) {
  Params p{};
  p.x = (const float*)d_in[0]; p.pos = (const int*)d_in[1];
  p.ret_w_in[0] = (const float*)d_in[2]; p.ret_w_out[0] = (const float*)d_in[3]; p.ln_g[0] = (const float*)d_in[4]; p.ln_b[0] = (const float*)d_in[5];
  p.ret_w_in[1] = (const float*)d_in[6]; p.ret_w_out[1] = (const float*)d_in[7]; p.ln_g[1] = (const float*)d_in[8]; p.ln_b[1] = (const float*)d_in[9];
  p.w_kv = (const float*)d_in[10]; p.pe_k = (const float*)d_in[11]; p.pe_v = (const float*)d_in[12];
  p.w_ck1 = (const float*)d_in[13]; p.w_ck2 = (const float*)d_in[14]; p.w_cv1 = (const float*)d_in[15]; p.w_cv2 = (const float*)d_in[16];
  p.nsa_w_in[0] = (const float*)d_in[17]; p.nsa_w_out[0] = (const float*)d_in[18]; p.ln_g[2] = (const float*)d_in[19]; p.ln_b[2] = (const float*)d_in[20];
  p.nsa_w_in[1] = (const float*)d_in[21]; p.nsa_w_out[1] = (const float*)d_in[22]; p.ln_g[3] = (const float*)d_in[23]; p.ln_b[3] = (const float*)d_in[24];
  p.out = (float*)d_out;
  char* ws = (char*)d_ws; size_t off = 0;
  auto take = [&](size_t bytes) { char* r = ws + off; off += (bytes + 4095) & ~(size_t)4095; return r; };
  p.wA = (h16*)take((size_t)13312 * 2048 * 2);
  p.wB = (h16*)take((size_t)4096 * 2048 * 2);
  p.xres = (float*)take((size_t)NTOK * DM * 4);
  p.xh = (h16*)take((size_t)NTOK * DM * 2);
  p.cs = (float*)take((size_t)NTOK * 256 * 4);
  p.ck1T = (h16*)take((size_t)256 * 6144 * 2);
  p.cv1T = (h16*)take((size_t)256 * 4096 * 2);
  p.biask = (float*)take(1024); p.biasv = (float*)take(1024); p.biasp = (float*)take(65536);
  p.kc = (h16*)take((size_t)8 * 256 * 192 * 2);
  p.vcT = (h16*)take((size_t)8 * 128 * 256 * 2);
  p.masks = (u64*)take((size_t)8 * SEQ * 8);
  const size_t region = off;
  p.kh = (h16*)take((size_t)NTOK * 2048 * 2);
  p.kdT = (h16*)take((size_t)NTOK * 2048 * 2);
  p.Obuf = p.kh;
  p.qh = (h16*)take((size_t)NTOK * 2048 * 2);
  p.vT = (h16*)take((size_t)NTOK * 4096 * 2);
  p.zh = (h16*)take((size_t)NTOK * 4096 * 2);
  p.St = (h16*)take((size_t)16 * 16 * 131072 * 2);
  p.Pbuf = (h16*)take((size_t)16 * SEQ * 256 * 2);
  off = region;
  p.kvh = (h16*)take((size_t)NTOK * KV_LD * 2 + 65536 * 4);
  p.vselT = (h16*)take((size_t)2 * 512 * SEQ * 2);
  p.vwinT = (h16*)take((size_t)2 * 512 * SEQ * 2);
  p.mixed = (h16*)take((size_t)NTOK * DM * 2);
  p.proj = (h16*)take((size_t)NTOK * NSA_LD * 2);
  p.part = (float*)take((size_t)256 * 65536 * 4);
  p.xbar = (unsigned*)take(XCD_BAR_WORDS * 4);

  if (off > ws_size) fprintf(stderr, "workspace too small: need %zu have %zu\n", off, ws_size);
  static int grid_blocks = 0;
  if (!grid_blocks) {
    int dev = 0, cus = 0, per_cu = 0;
    (void)hipGetDevice(&dev);
    (void)hipDeviceGetAttribute(&cus, hipDeviceAttributeMultiprocessorCount, dev);
    (void)hipOccupancyMaxActiveBlocksPerMultiprocessor(&per_cu, mega_kernel, NTHR, 0);
    if (per_cu < 1) per_cu = 1;
    grid_blocks = cus * per_cu;
    if (grid_blocks > 256) grid_blocks = 256;
  }
  (void)hipMemsetAsync(p.xbar, 0, XCD_BAR_WORDS * 4, stream);
#if FUSED
  int lo = 0, hi = 28;
  void* args[] = {&p, &lo, &hi};
  hipError_t e = hipLaunchCooperativeKernel((void*)mega_kernel, dim3(grid_blocks), dim3(NTHR), args, 0, stream);
  if (e != hipSuccess) fprintf(stderr, "cooperative launch failed: %s (grid %d)\n", hipGetErrorString(e), grid_blocks);
#else
  for (int ph = 0; ph < 28; ++ph) hipLaunchKernelGGL(mega_kernel, dim3(256), dim3(NTHR), 0, stream, p, ph, ph + 1);
#endif
}
```
